# Optimizing an MI355X kernel written in HIP

```python
import math
import jax, jax.numpy as jnp
from jax import lax
import numpy as np


D_MODEL = 2048
BATCH = 2
SEQ = 8192
DEPTH = 2

HEAD_DIM = 128
N_HEADS_SB = 8
N_HEADS_DW = 8
DW_PATTERNS = ((128, 1), (512, 4), (2048, 16))
Q_BLOCK = 128
SSM_WIDTH = 1024
SSM_GROUP = 16
SSM_GROUPS = SSM_WIDTH // SSM_GROUP
SSM_STATE = 64
N_HEADS_GDN = 8
GDN_DK = 128
GDN_DV = 128
GDN_CONV = 4
GDN_CHUNK = 64
D_FF = 5632
N_EXPERTS = 8
TOP_K = 2
D_FF_EXPERT = 7168
DEEPNORM_ALPHA = (2 * DEPTH) ** 0.25
DEEPNORM_BETA = (8 * DEPTH) ** -0.25
LN_EPS = 1e-5
RMS_EPS = 1e-6

W_SB = N_HEADS_SB * HEAD_DIM
W_DW = N_HEADS_DW * HEAD_DIM
IN0 = 3 * W_SB + 3 * W_DW
MIX0 = W_SB + W_DW
GDN_QKV = N_HEADS_GDN * (2 * GDN_DK + GDN_DV)
IN1 = SSM_WIDTH + GDN_QKV + N_HEADS_GDN * GDN_DV + 2 * N_HEADS_GDN
MIX1 = SSM_WIDTH + N_HEADS_GDN * GDN_DV
N_EVEN = (DEPTH + 1) // 2
N_ODD = DEPTH // 2

kernel_name = 'hybrid_sb_dilated_s5_gdn_moe_deepnorm'

F32 = jnp.float32


def layer_norm(x, g, b):
    xf = x.astype(F32)
    mu = jnp.mean(xf, -1, keepdims=True)
    var = jnp.mean(jnp.square(xf - mu), -1, keepdims=True)
    return ((xf - mu) * lax.rsqrt(var + LN_EPS) * g + b).astype(x.dtype)


def split_heads(t, head_dim):
    b, s, _ = t.shape
    return t.reshape(b, s, -1, head_dim).transpose(0, 2, 1, 3)


def stick_breaking_attention(q, k, v):
    b, h, s, hd = q.shape
    nb = s // Q_BLOCK
    scale = hd ** -0.5
    kf = k.astype(F32)
    vf = v.astype(F32)
    qb = q.astype(F32).reshape(b, h, nb, Q_BLOCK, hd).transpose(2, 0, 1, 3, 4)
    starts = jnp.arange(nb, dtype=jnp.int32) * Q_BLOCK
    kpos = jnp.arange(s, dtype=jnp.int32)

    def block(args):
        qblk, q0 = args
        z = jnp.einsum('bhqd,bhkd->bhqk', qblk, kf) * scale
        qpos = q0 + jnp.arange(Q_BLOCK, dtype=jnp.int32)
        past = kpos[None, :] < qpos[:, None]
        log_keep = jnp.where(past, jax.nn.log_sigmoid(-z), 0.0)
        later = lax.cumsum(log_keep, axis=3, reverse=True) - log_keep
        w = jnp.where(past, jnp.exp(jax.nn.log_sigmoid(z) + later), 0.0)
        return jnp.einsum('bhqk,bhkd->bhqd', w, vf)

    out = lax.map(block, (qb, starts))
    return out.transpose(1, 2, 0, 3, 4).reshape(b, h, s, hd)


def dilated_window_attention(q, k, v, window, dilation):
    b, h, s, hd = q.shape
    n_keys = window // dilation
    sub_len = s // dilation
    nb = -(-sub_len // n_keys)
    padded = nb * n_keys
    scale = hd ** -0.5

    def to_sub(t):
        return t.astype(F32).reshape(b, h, sub_len, dilation, hd).transpose(0, 1, 3, 2, 4)

    qs = jnp.pad(to_sub(q), ((0, 0),) * 3 + ((0, padded - sub_len), (0, 0)))
    qs = qs.reshape(b, h, dilation, nb, n_keys, hd)

    def key_blocks(t):
        tp = jnp.pad(to_sub(t), ((0, 0),) * 3 + ((n_keys, padded - sub_len), (0, 0)))
        tp = tp.reshape(b, h, dilation, nb + 1, n_keys, hd)
        return jnp.concatenate([tp[:, :, :, :-1], tp[:, :, :, 1:]], axis=4)

    ks = key_blocks(k)
    vs = key_blocks(v)
    i = jnp.arange(n_keys)[:, None]
    j = jnp.arange(2 * n_keys)[None, :]
    dist = n_keys + i - j
    band = (dist >= 0) & (dist <= n_keys)
    blk = jnp.arange(nb)[:, None, None]
    mask = band[None] & ~((blk == 0) & (j[None] < n_keys))
    sc = jnp.einsum('bhrnqd,bhrnkd->bhrnqk', qs, ks) * scale
    sc = jnp.where(mask, sc, -jnp.inf)
    m = jnp.max(sc, -1, keepdims=True)
    p = jnp.exp(sc - m)
    den = jnp.sum(p, -1, keepdims=True)
    o = jnp.einsum('bhrnqk,bhrnkd->bhrnqd', p, vs) / den
    lse = (m + jnp.log(den))[..., 0]
    o = o.reshape(b, h, dilation, padded, hd)[:, :, :, :sub_len]
    o = o.transpose(0, 1, 3, 2, 4).reshape(b, h, s, hd)
    lse = lse.reshape(b, h, dilation, padded)[..., :sub_len].transpose(0, 1, 3, 2).reshape(b, h, s)
    return o, lse


def dilated_mixture(q, k, v):
    outs, lses = [], []
    for window, dilation in DW_PATTERNS:
        o, l = dilated_window_attention(q, k, v, window, dilation)
        outs.append(o)
        lses.append(l)
    wts = jax.nn.softmax(jnp.stack(lses), axis=0)
    return jnp.einsum('pbhs,pbhsd->bhsd', wts, jnp.stack(outs))


def s5_mixer(u, lam_re, lam_im, log_dt, b_re, b_im, c_re, c_im, d_skip, glu_w, glu_b):
    bsz, s, _ = u.shape
    uf = u.astype(F32)
    lam = lax.complex(lam_re.astype(F32), lam_im.astype(F32))
    dt = jnp.exp(log_dt.astype(F32))[:, None]
    lam_bar = jnp.exp(lam * dt)
    b_mat = lax.complex(b_re.astype(F32), b_im.astype(F32))
    b_bar = ((lam_bar - 1.0) / lam)[..., None] * b_mat
    c_mat = lax.complex(c_re.astype(F32), c_im.astype(F32))
    ug = uf.reshape(bsz, s, SSM_GROUPS, SSM_GROUP).astype(jnp.complex64)
    bu = jnp.einsum('gph,bsgh->bsgp', b_bar, ug)
    a = jnp.broadcast_to(lam_bar, bu.shape)

    def combine(e1, e2):
        a1, x1 = e1
        a2, x2 = e2
        return a1 * a2, a2 * x1 + x2

    _, states = lax.associative_scan(combine, (a, bu), axis=1)
    y = jnp.einsum('ghp,bsgp->bsgh', c_mat, states).real.reshape(bsz, s, SSM_WIDTH)
    y = y + d_skip.astype(F32) * uf
    z = jax.nn.gelu(y)
    return z * jax.nn.sigmoid(z @ glu_w.astype(F32) + glu_b.astype(F32))


def causal_depthwise_conv(x, w):
    return lax.conv_general_dilated(
        x, w[:, None, :].astype(x.dtype), window_strides=(1,),
        padding=((GDN_CONV - 1, 0),), dimension_numbers=('NWC', 'WIO', 'NWC'),
        feature_group_count=x.shape[-1])


def l2norm(t):
    return t * lax.rsqrt(jnp.sum(t * t, -1, keepdims=True) + RMS_EPS)


def gated_delta_rule(q, k, v, g, beta):
    b, s, h, dk = q.shape
    dv = v.shape[-1]
    c = GDN_CHUNK
    nc = s // c

    def chunk(t):
        return jnp.moveaxis(t.reshape((b, nc, c) + t.shape[2:]), 3, 2)

    qc = chunk(q) * dk ** -0.5
    kc = chunk(k)
    vc = chunk(v)
    bc = chunk(beta)
    gc = lax.cumsum(chunk(g), axis=3)
    tri = jnp.tril(jnp.ones((c, c), bool))
    strict = jnp.tril(jnp.ones((c, c), bool), -1)
    decay = jnp.exp(jnp.where(tri, gc[..., :, None] - gc[..., None, :], -jnp.inf))
    kb = kc * bc[..., None]
    lower = jnp.where(strict, jnp.einsum('bnhid,bnhjd->bnhij', kb, kc) * decay, 0.0)
    mat = jnp.eye(c, dtype=F32) + lower

    def solve(rhs):
        return lax.linalg.triangular_solve(mat, rhs, left_side=True, lower=True, unit_diagonal=True)

    u_val = solve(vc * bc[..., None])
    w_key = solve(kb * jnp.exp(gc)[..., None])
    intra = jnp.einsum('bnhid,bnhjd->bnhij', qc, kc) * decay
    q_dec = qc * jnp.exp(gc)[..., None]
    k_dec = kc * jnp.exp(gc[..., -1:] - gc)[..., None]
    g_last = jnp.exp(gc[..., -1])

    def step(state, xs):
        u_c, w_c, qd, kd, att, gl = xs
        v_new = u_c - jnp.einsum('bhck,bhkv->bhcv', w_c, state)
        o = jnp.einsum('bhck,bhkv->bhcv', qd, state) + jnp.einsum('bhij,bhjv->bhiv', att, v_new)
        state = state * gl[..., None, None] + jnp.einsum('bhck,bhcv->bhkv', kd, v_new)
        return state, o

    xs = tuple(jnp.moveaxis(t, 1, 0) for t in (u_val, w_key, q_dec, k_dec, intra, g_last))
    state0 = jnp.zeros((b, h, dk, dv), F32)
    _, o = lax.scan(step, state0, xs)
    return jnp.moveaxis(o, 0, 1).transpose(0, 1, 3, 2, 4).reshape(b, s, h, dv)


def gated_deltanet(qkv, gate, beta_logit, a_logit, conv_w, a_log, dt_bias, norm_w):
    b, s, _ = qkv.shape
    qkv = jax.nn.silu(causal_depthwise_conv(qkv.astype(F32), conv_w.astype(F32)))
    q, k, v = jnp.split(qkv, [N_HEADS_GDN * GDN_DK, 2 * N_HEADS_GDN * GDN_DK], axis=-1)
    q = l2norm(q.reshape(b, s, N_HEADS_GDN, GDN_DK))
    k = l2norm(k.reshape(b, s, N_HEADS_GDN, GDN_DK))
    v = v.reshape(b, s, N_HEADS_GDN, GDN_DV)
    beta = jax.nn.sigmoid(beta_logit.astype(F32))
    g = -jnp.exp(a_log.astype(F32)) * jax.nn.softplus(a_logit.astype(F32) + dt_bias.astype(F32))
    o = gated_delta_rule(q, k, v, g, beta)
    o = o * lax.rsqrt(jnp.mean(o * o, -1, keepdims=True) + RMS_EPS) * norm_w.astype(F32)
    o = o * jax.nn.silu(gate.astype(F32).reshape(b, s, N_HEADS_GDN, GDN_DV))
    return o.reshape(b, s, N_HEADS_GDN * GDN_DV)


def even_mixer(x, w_in, w_out):
    b, s, _ = x.shape
    h = x @ w_in
    cuts = [W_SB, 2 * W_SB, 3 * W_SB, 3 * W_SB + W_DW, 3 * W_SB + 2 * W_DW]
    qa, ka, va, qb, kb, vb = jnp.split(h, cuts, axis=-1)
    oa = stick_breaking_attention(split_heads(qa, HEAD_DIM), split_heads(ka, HEAD_DIM), split_heads(va, HEAD_DIM))
    ob = dilated_mixture(split_heads(qb, HEAD_DIM), split_heads(kb, HEAD_DIM), split_heads(vb, HEAD_DIM))
    o = jnp.concatenate([oa, ob], axis=1).transpose(0, 2, 1, 3).reshape(b, s, MIX0)
    return o.astype(x.dtype) @ w_out


def odd_mixer(x, w_in, lam_re, lam_im, log_dt, b_re, b_im, c_re, c_im, d_skip, glu_w, glu_b,
              conv_w, a_log, dt_bias, norm_w, w_out):
    h = x @ w_in
    c1 = SSM_WIDTH
    c2 = c1 + GDN_QKV
    c3 = c2 + N_HEADS_GDN * GDN_DV
    c4 = c3 + N_HEADS_GDN
    u, qkv, gate, beta_logit, a_logit = jnp.split(h, [c1, c2, c3, c4], axis=-1)
    oc = s5_mixer(u, lam_re, lam_im, log_dt, b_re, b_im, c_re, c_im, d_skip, glu_w, glu_b)
    od = gated_deltanet(qkv, gate, beta_logit, a_logit, conv_w, a_log, dt_bias, norm_w)
    o = jnp.concatenate([oc, od], axis=-1)
    return o.astype(x.dtype) @ w_out


def swiglu(x, w1, w3, w2):
    return (jax.nn.silu(x @ w1) * (x @ w3)) @ w2


def moe_swiglu(x, router_w, w1, w3, w2):
    logits = jnp.einsum('bsd,de->bse', x, router_w).astype(F32)
    top_val, top_idx = lax.top_k(logits, TOP_K)
    top_w = jax.nn.softmax(top_val, axis=-1)
    gates = jnp.sum(jax.nn.one_hot(top_idx, N_EXPERTS, dtype=F32) * top_w[..., None], axis=-2)
    y = jnp.zeros_like(x)
    for e in range(N_EXPERTS):
        y = y + gates[..., e:e + 1].astype(x.dtype) * swiglu(x, w1[e], w3[e], w2[e])
    return y


def setup_inputs(seed: int = 0) -> dict:
    key = jax.random.key(seed)
    ks = list(jax.random.split(key, 40))

    def nrm(shape, std):
        return jax.random.normal(ks.pop(), shape, F32) * std

    def unif(shape, lo, hi):
        return jax.random.uniform(ks.pop(), shape, F32, lo, hi)

    ne, no = N_EVEN, N_ODD
    d = D_MODEL
    inp = {}
    inp['x'] = nrm((BATCH, SEQ, d), 1.0)
    inp['even_w_in'] = nrm((ne, d, IN0), d ** -0.5)
    inp['even_w_out'] = nrm((ne, MIX0, d), MIX0 ** -0.5 * DEEPNORM_BETA)
    inp['even_ln_mix_g'] = 1.0 + nrm((ne, d), 0.02)
    inp['even_ln_mix_b'] = nrm((ne, d), 0.02)
    inp['even_ffn_w1'] = nrm((ne, d, D_FF), d ** -0.5)
    inp['even_ffn_w3'] = nrm((ne, d, D_FF), d ** -0.5)
    inp['even_ffn_w2'] = nrm((ne, D_FF, d), D_FF ** -0.5 * DEEPNORM_BETA)
    inp['even_ln_ffn_g'] = 1.0 + nrm((ne, d), 0.02)
    inp['even_ln_ffn_b'] = nrm((ne, d), 0.02)
    inp['odd_w_in'] = nrm((no, d, IN1), d ** -0.5)
    inp['odd_ssm_lam_re'] = -0.5 + nrm((no, SSM_GROUPS, SSM_STATE), 0.01)
    inp['odd_ssm_lam_im'] = math.pi * jnp.arange(SSM_STATE, dtype=F32) + nrm((no, SSM_GROUPS, SSM_STATE), 0.01)
    inp['odd_ssm_log_dt'] = unif((no, SSM_GROUPS), math.log(1e-3), math.log(1e-1))
    inp['odd_ssm_b_re'] = nrm((no, SSM_GROUPS, SSM_STATE, SSM_GROUP), (2 * SSM_GROUP) ** -0.5)
    inp['odd_ssm_b_im'] = nrm((no, SSM_GROUPS, SSM_STATE, SSM_GROUP), (2 * SSM_GROUP) ** -0.5)
    inp['odd_ssm_c_re'] = nrm((no, SSM_GROUPS, SSM_GROUP, SSM_STATE), SSM_STATE ** -0.5)
    inp['odd_ssm_c_im'] = nrm((no, SSM_GROUPS, SSM_GROUP, SSM_STATE), SSM_STATE ** -0.5)
    inp['odd_ssm_d'] = nrm((no, SSM_WIDTH), 1.0)
    inp['odd_glu_w'] = nrm((no, SSM_WIDTH, SSM_WIDTH), SSM_WIDTH ** -0.5)
    inp['odd_glu_b'] = nrm((no, SSM_WIDTH), 0.02)
    inp['odd_gdn_conv_w'] = nrm((no, GDN_CONV, GDN_QKV), GDN_CONV ** -0.5)
    inp['odd_gdn_a_log'] = jnp.log(unif((no, N_HEADS_GDN), 1.0, 16.0))
    dt0 = jnp.exp(unif((no, N_HEADS_GDN), math.log(1e-3), math.log(1e-1)))
    inp['odd_gdn_dt_bias'] = dt0 + jnp.log(-jnp.expm1(-dt0))
    inp['odd_gdn_norm_w'] = 1.0 + nrm((no, GDN_DV), 0.02)
    inp['odd_w_out'] = nrm((no, MIX1, d), MIX1 ** -0.5 * DEEPNORM_BETA)
    inp['odd_ln_mix_g'] = 1.0 + nrm((no, d), 0.02)
    inp['odd_ln_mix_b'] = nrm((no, d), 0.02)
    inp['odd_router_w'] = nrm((no, d, N_EXPERTS), d ** -0.5)
    inp['odd_moe_w1'] = nrm((no, N_EXPERTS, d, D_FF_EXPERT), d ** -0.5)
    inp['odd_moe_w3'] = nrm((no, N_EXPERTS, d, D_FF_EXPERT), d ** -0.5)
    inp['odd_moe_w2'] = nrm((no, N_EXPERTS, D_FF_EXPERT, d), D_FF_EXPERT ** -0.5 * DEEPNORM_BETA)
    inp['odd_ln_ffn_g'] = 1.0 + nrm((no, d), 0.02)
    inp['odd_ln_ffn_b'] = nrm((no, d), 0.02)
    return inp


def reference(x, even_w_in, even_w_out, even_ln_mix_g, even_ln_mix_b, even_ffn_w1, even_ffn_w3,
              even_ffn_w2, even_ln_ffn_g, even_ln_ffn_b, odd_w_in, odd_ssm_lam_re, odd_ssm_lam_im,
              odd_ssm_log_dt, odd_ssm_b_re, odd_ssm_b_im, odd_ssm_c_re, odd_ssm_c_im, odd_ssm_d,
              odd_glu_w, odd_glu_b, odd_gdn_conv_w, odd_gdn_a_log, odd_gdn_dt_bias, odd_gdn_norm_w,
              odd_w_out, odd_ln_mix_g, odd_ln_mix_b, odd_router_w, odd_moe_w1, odd_moe_w3,
              odd_moe_w2, odd_ln_ffn_g, odd_ln_ffn_b):
    for layer in range(DEPTH):
        i = layer // 2
        if layer % 2 == 0:
            mix = even_mixer(x, even_w_in[i], even_w_out[i])
            x = layer_norm(DEEPNORM_ALPHA * x + mix, even_ln_mix_g[i], even_ln_mix_b[i])
            ffn = swiglu(x, even_ffn_w1[i], even_ffn_w3[i], even_ffn_w2[i])
            x = layer_norm(DEEPNORM_ALPHA * x + ffn, even_ln_ffn_g[i], even_ln_ffn_b[i])
        else:
            mix = odd_mixer(x, odd_w_in[i], odd_ssm_lam_re[i], odd_ssm_lam_im[i], odd_ssm_log_dt[i],
                            odd_ssm_b_re[i], odd_ssm_b_im[i], odd_ssm_c_re[i], odd_ssm_c_im[i],
                            odd_ssm_d[i], odd_glu_w[i], odd_glu_b[i], odd_gdn_conv_w[i],
                            odd_gdn_a_log[i], odd_gdn_dt_bias[i], odd_gdn_norm_w[i], odd_w_out[i])
            x = layer_norm(DEEPNORM_ALPHA * x + mix, odd_ln_mix_g[i], odd_ln_mix_b[i])
            ffn = moe_swiglu(x, odd_router_w[i], odd_moe_w1[i], odd_moe_w3[i], odd_moe_w2[i])
            x = layer_norm(DEEPNORM_ALPHA * x + ffn, odd_ln_ffn_g[i], odd_ln_ffn_b[i])
    return x
```

```cpp
#include <hip/hip_runtime.h>
#include <stdint.h>
#include <stdio.h>

#define LAS __attribute__((address_space(3)))
#define GAS __attribute__((address_space(1)))
#define DI __device__ __forceinline__
typedef _Float16 h16;
typedef _Float16 h16x2 __attribute__((ext_vector_type(2)));
typedef _Float16 h16x4 __attribute__((ext_vector_type(4)));
typedef _Float16 h16x8 __attribute__((ext_vector_type(8)));
typedef float f32x2 __attribute__((ext_vector_type(2)));
typedef float f32x4 __attribute__((ext_vector_type(4)));
typedef unsigned u32x2 __attribute__((ext_vector_type(2)));
typedef unsigned u32x4 __attribute__((ext_vector_type(4)));
typedef short v4i16_t __attribute__((ext_vector_type(4)));

#ifndef N_LAUNCH_MODE
#define N_LAUNCH_MODE 1
#endif
#ifndef DBG_CHECK
#define DBG_CHECK 0
#endif

constexpr int NT = 512, NWAVES = 8;
constexpr int M = 16384, D = 2048, SEQ = 8192;
constexpr int IN0 = 6144, DFF = 5632, IN1 = 5136, IN1P = 5376, DFE = 7168, NEXP = 8;
constexpr float ALPHA = 1.41421356237309515f;
constexpr float QK_SCALE = 0.08838834764831845f;
constexpr int S5L = 32, S5NCH = SEQ / S5L, S5N = 2 * S5NCH  , S5K = 640  ;
constexpr int GDC = 64, GNCH = SEQ / GDC  , GUNITS = 2 * GNCH * 8  ;
constexpr int XG_ROWS = 2 * M + NEXP * 256;

constexpr size_t MiB = 1u << 20;
constexpr size_t WS_CTL = 0, CTL_BYTES = 1 * MiB;
constexpr size_t WS_MOE13 = 1 * MiB;
constexpr size_t WS_MOE2 = 449 * MiB;
constexpr size_t WS_X = 673 * MiB;
constexpr size_t WS_XH = 801 * MiB;
constexpr size_t WS_WIN0 = 865 * MiB;
constexpr size_t WS_WOUT0 = 889 * MiB;
constexpr size_t WS_WFF13 = 897 * MiB;
constexpr size_t WS_WFF2 = 941 * MiB;
constexpr size_t WS_WIN1 = 963 * MiB;
constexpr size_t WS_WGLU = 984 * MiB;
constexpr size_t WS_WOUT1 = 986 * MiB;
constexpr size_t WS_TCAT = 994 * MiB;
constexpr size_t WS_EPAD = 1034 * MiB;
constexpr size_t WS_SCR = 1050 * MiB;
constexpr size_t WS_END = 1792 * MiB;
constexpr size_t WS_H0 = WS_SCR;
constexpr size_t WS_OP = WS_SCR + 192 * MiB;
constexpr size_t WS_LSE = WS_SCR + 288 * MiB;
constexpr size_t WS_O0 = WS_SCR + 290 * MiB;
constexpr size_t WS_HFF = WS_SCR;
constexpr size_t WS_UCAT = WS_SCR;
constexpr size_t WS_QKVG = WS_SCR + 40 * MiB;
constexpr size_t WS_LOGIT = WS_SCR + 168 * MiB;
constexpr size_t WS_EC = WS_SCR + 169 * MiB;
constexpr size_t WS_GU = WS_SCR + 185 * MiB;
constexpr size_t WS_GW = WS_SCR + 217 * MiB;
constexpr size_t WS_GQD = WS_SCR + 249 * MiB;
constexpr size_t WS_GKDT = WS_SCR + 281 * MiB;
constexpr size_t WS_GINTRA = WS_SCR + 313 * MiB;
constexpr size_t WS_GLAST = WS_SCR + 329 * MiB;
constexpr size_t WS_OG = WS_SCR + 330 * MiB;
constexpr size_t WS_Z = WS_SCR + 362 * MiB;
constexpr size_t WS_MIXIN = WS_SCR + 394 * MiB;
constexpr size_t WS_QKVN = WS_SCR + 458 * MiB;
constexpr size_t WS_GB = WS_SCR + 554 * MiB;
constexpr size_t WS_HMOE = WS_SCR;
constexpr size_t WS_XG = WS_SCR + 476 * MiB;
constexpr size_t WS_TOK = WS_SCR + 612 * MiB;
constexpr size_t WS_SLAB = WS_SCR + 614 * MiB;
static_assert((size_t)XG_ROWS * DFE * 2 <= 476 * MiB && (size_t)XG_ROWS * D * 2 <= 136 * MiB && WS_TOK + 1 * MiB <= WS_END, "moe scratch");
static_assert(WS_SLAB + 64 * MiB <= WS_END && WS_MIXIN + 64 * MiB <= WS_END && WS_O0 + 64 * MiB <= WS_END, "scratch");
constexpr int CW_BAR = 0;
constexpr int CW_CNT = 4096;
constexpr int CW_DBG = 8192;

constexpr int MISC_OFF = 155648;
constexpr int LDS_BYTES = MISC_OFF + 1024;
constexpr int TOKTAB_OFF = 131072, TOKTAB_UNITS = 46;
constexpr size_t WS_XQ8 = WS_SCR + 240 * MiB;
constexpr size_t WS_LIST = WS_TOK + 512 * 1024;

DI unsigned pkh(float a, float b) { f32x2 v = {a, b}; return __builtin_bit_cast(unsigned, __builtin_convertvector(v, h16x2)); }
#ifndef WQ_DROP
#define WQ_DROP 4
#endif
#ifndef AQ_DROP
#define AQ_DROP 2
#endif
DI unsigned pka(float a, float b) { const unsigned u = pkh(a, b); if (AQ_DROP == 0) return u; constexpr unsigned H = (1u << (AQ_DROP - 1)) * 0x00010001u, Mk = ~(((1u << AQ_DROP) - 1u) * 0x00010001u); return (u + H) & Mk; }
DI unsigned rnd_drop(unsigned u, int drop) { if (drop <= 0) return u; const unsigned h = (1u << (drop - 1)) * 0x00010001u, mk = ~(((1u << drop) - 1u) * 0x00010001u); return (u + h) & mk; }
#ifndef WQ_MOE
#define WQ_MOE 5
#endif
#ifndef AQ_MOE
#define AQ_MOE 4
#endif
DI unsigned pkw(float a, float b) { const unsigned u = pkh(a, b); if (WQ_DROP == 0) return u; constexpr unsigned H = (1u << (WQ_DROP - 1)) * 0x00010001u, Mk = ~(((1u << WQ_DROP) - 1u) * 0x00010001u); return (u + H) & Mk; }
DI float wave_sum(float v) {
#pragma unroll
    for (int o = 32; o >= 1; o >>= 1) v += __shfl_xor(v, o);
    return v;
}
DI float fast_rcp(float x) { return __builtin_amdgcn_rcpf(x); }
DI float sigmoidf_(float x) { return fast_rcp(1.0f + __expf(-x)); }
DI float siluf_(float x) { return x * sigmoidf_(x); }
DI float softplusf_(float z) { return fmaxf(z, 0.f) + __logf(1.0f + __expf(-fabsf(z))); }
DI h16x8 mk8(h16x4 a, h16x4 b) { return __builtin_shufflevector(a, b, 0, 1, 2, 3, 4, 5, 6, 7); }
DI h16x4 trread(const char* p) { return __builtin_bit_cast(h16x4, __builtin_amdgcn_ds_read_tr16_b64_v4i16((LAS v4i16_t*)p)); }
#define MFMA16(a, b, c) __builtin_amdgcn_mfma_f32_16x16x32_f16((a), (b), (c), 0, 0, 0)
#define LBAR() do { asm volatile("s_waitcnt lgkmcnt(0)" ::: "memory"); __builtin_amdgcn_s_barrier(); asm volatile("" ::: "memory"); } while (0)

#define XB_TMO      128
#define XB_XCNT(j)  (256  + 64 * (j))
#define XB_XSUB(j)  (1280 + 64 * (j))
#define XB_XGEN(j)  (2304 + 64 * (j))
#define XB_TOP      3328
#define XB_TOPGEN   3392
#define XCD_BAR_WORDS 3456
#define XB_SPIN_CAP (1u << 22)
__device__ __forceinline__ unsigned xb_ld(unsigned* p)              { return __hip_atomic_load(p, __ATOMIC_RELAXED, __HIP_MEMORY_SCOPE_AGENT); }
__device__ __forceinline__ unsigned xb_add(unsigned* p, unsigned v) { return __hip_atomic_fetch_add(p, v, __ATOMIC_RELAXED, __HIP_MEMORY_SCOPE_AGENT); }
__device__ __forceinline__ unsigned xb_xcc_id() { return (unsigned)__builtin_amdgcn_s_getreg((3 << 11) | 20) & 0xFu; }
#define XB_SPIN(cond, bar) do { unsigned _sp = 0; while (cond) { __builtin_amdgcn_s_sleep(1); \
    if ((++_sp & 255u) == 0u) { if (xb_ld(&(bar)[XB_TMO])) break; if (_sp > XB_SPIN_CAP) { atomicAdd(&(bar)[XB_TMO], 1u); break; } } } } while (0)
struct XcdBarrier { unsigned* bar; unsigned x; volatile LAS unsigned* st; };
__device__ __forceinline__ XcdBarrier xcd_barrier_post(unsigned* bar, volatile LAS unsigned* st) {
    XcdBarrier b; b.bar = bar; b.x = xb_xcc_id(); b.st = st;
    if (threadIdx.x == 0) (void)xb_add(&bar[XB_XCNT(b.x)], 1u);
    return b;
}
__device__ __forceinline__ void xcd_barrier_complete(unsigned* bar, unsigned x, unsigned& nloc, unsigned& nx) {
    const unsigned G = gridDim.x * gridDim.y * gridDim.z;
    unsigned sum, cnt, mine, sp = 0u;
    for (;;) {
        sum = 0u; cnt = 0u; mine = 0u;
#pragma unroll
        for (unsigned j = 0; j < 16; ++j) { const unsigned c = xb_ld(&bar[XB_XCNT(j)]); sum += c; cnt += (c > 0u) ? 1u : 0u; mine = (j == x) ? c : mine; }
        if (sum == G) break;
        __builtin_amdgcn_s_sleep(1);
        if ((++sp & 255u) == 0u) { if (xb_ld(&bar[XB_TMO])) break; if (sp > XB_SPIN_CAP) { atomicAdd(&bar[XB_TMO], 1u); break; } }
    }
    nloc = mine > 0u ? mine : 1u; nx = cnt > 0u ? cnt : 1u;
}
__device__ __forceinline__ void xcd_barrier(const XcdBarrier& b) {
    asm volatile("s_waitcnt vmcnt(0)" ::: "memory");
    __syncthreads();
    if (threadIdx.x == 0) {
        unsigned* bar = b.bar;
        __builtin_amdgcn_s_waitcnt(0);
        unsigned nloc = b.st[0], nx = b.st[1];
        if (nloc == 0u) { xcd_barrier_complete(bar, b.x, nloc, nx); b.st[0] = nloc; b.st[1] = nx; }
        const unsigned old = xb_add(&bar[XB_XSUB(b.x)], 1u);
        const unsigned gen = old / nloc;
        if (old + 1u == (gen + 1u) * nloc) {
            __builtin_amdgcn_fence(__ATOMIC_RELEASE, "agent");
            asm volatile("s_waitcnt vmcnt(0)" ::: "memory");
            const unsigned og = xb_add(&bar[XB_TOP], 1u);
            const unsigned tg = og / nx;
            if (og + 1u == (tg + 1u) * nx) xb_add(&bar[XB_TOPGEN], 1u);
            else XB_SPIN(xb_ld(&bar[XB_TOPGEN]) == tg, bar);
            __builtin_amdgcn_fence(__ATOMIC_ACQUIRE, "agent");
            xb_add(&bar[XB_XGEN(b.x)], 1u);
            asm volatile("s_waitcnt vmcnt(0)" ::: "memory");
        } else {
            XB_SPIN(xb_ld(&bar[XB_XGEN(b.x)]) == gen, bar);
            __builtin_amdgcn_fence(__ATOMIC_ACQUIRE, "agent");
            asm volatile("s_waitcnt vmcnt(0)" ::: "memory");
        }
    }
    __syncthreads();
}

namespace pg8 {
constexpr int BM = 256, BK = 64, HALF = 128, HTB = HALF * BK * 2, STAGE_BYTES = 8 * HTB, NXCD = 8, WGM = 8;
__host__ __device__ __forceinline__ int lds_byte(int r, int c) { const int st = (r >> 4) * 2 + (c >> 5), rr = r & 15, cc = c & 31, ob = rr * 64 + cc * 2; return st * 1024 + (ob ^ (((ob >> 9) & 1) << 5)); }
__host__ __device__ __forceinline__ void stage_rc(int b, int& R, int& C) { const int st = b / 1024, sb = b % 1024, swz = sb ^ (((sb >> 9) & 1) << 5); R = (st >> 1) * 16 + swz / 64; C = (st & 1) * 32 + (swz % 64) / 2; }
__host__ __device__ __forceinline__ int perm32(int rho) { const int n = rho >> 4, i = rho & 15; return 8 * (i >> 2) + 4 * n + (i & 3); }
struct Unit { int pm, pn, pc, grp, aux; };
typedef __bf16 bf16x8_t __attribute__((ext_vector_type(8)));
typedef int v8i_t __attribute__((ext_vector_type(8)));
typedef int v4i_t __attribute__((ext_vector_type(4)));
DI v8i_t cat8(h16x8 a, h16x8 b) { const v4i_t x = __builtin_bit_cast(v4i_t, a), y = __builtin_bit_cast(v4i_t, b); return __builtin_shufflevector(x, y, 0, 1, 2, 3, 4, 5, 6, 7); }
template <bool BF16> DI f32x4 mma_op(h16x8 a, h16x8 b, f32x4 c) {
    if constexpr (BF16) return __builtin_amdgcn_mfma_f32_16x16x32_bf16(__builtin_bit_cast(bf16x8_t, a), __builtin_bit_cast(bf16x8_t, b), c, 0, 0, 0);
    else return __builtin_amdgcn_mfma_f32_16x16x32_f16(a, b, c, 0, 0, 0); }

DI bool tile_order(int i, int G, int c, int nM, int nN, int& pm, int& pn) {
    const int nwg = nM * nN; const long L = (long)i * G + c; if (L >= nwg) return false;
    int wgid = (int)L; { const int q = nwg / NXCD, r = nwg % NXCD, xcd = wgid % NXCD, off = wgid / NXCD; wgid = (xcd < r ? xcd * (q + 1) : r * (q + 1) + (xcd - r) * q) + off; }
    const int nig = WGM * nN, gid = wgid / nig, fm = gid * WGM, gsz = (nM - fm) < WGM ? (nM - fm) : WGM;
    pm = fm + ((wgid % nig) % gsz); pn = (wgid % nig) / gsz; return true;
}
struct DenseSched {
    static constexpr bool GATHER = false; const h16* A; const h16* Bt; int lda, ldb, nM, nN, G, c;
    DI bool next(int i, Unit& u) const { int pm, pn; if (!tile_order(i, G, c, nM, nN, pm, pn)) return false; u.pm = pm; u.pn = pn; u.pc = pn; u.grp = 0; return true; }
    DI const char* a_base(const Unit& u) const { return (const char*)A + (size_t)u.pm * 256 * lda * 2; }
    DI const char* b_base(const Unit& u) const { return (const char*)Bt + (size_t)u.pn * 256 * ldb * 2; }
};
struct GroupSched {
    static constexpr bool GATHER = false; const h16* A; const h16* Bt; int lda, ldb, nM, nN, ngrp, G, c; size_t strideA, strideB;
    DI bool next(int i, Unit& u) const { const long L = (long)i * G + c; const int per = nM * nN; if (L >= (long)per * ngrp) return false;
        const int g = (int)L / per, r = (int)L % per; u.grp = g; u.pm = r % nM; u.pn = r / nM; u.pc = u.pn; return true; }
    DI const char* a_base(const Unit& u) const { return (const char*)(A + (size_t)u.grp * strideA) + (size_t)u.pm * 256 * lda * 2; }
    DI const char* b_base(const Unit& u) const { return (const char*)(Bt + (size_t)u.grp * strideB) + (size_t)u.pn * 256 * ldb * 2; }
};
struct MoeSched {
    static constexpr bool GATHER = false; const void* A; const void* Bt; int lda, ldb, nN, G, c; int tp1, tp2, tp3, tp4, tp5, tp6, tp7, tp8; int esz;
    DI bool next(int i, Unit& u) const { int pm, pn; if (!tile_order(i, G, c, tp8, nN, pm, pn)) return false;
        const int e = (pm >= tp1) + (pm >= tp2) + (pm >= tp3) + (pm >= tp4) + (pm >= tp5) + (pm >= tp6) + (pm >= tp7);
        u.pm = pm; u.pc = pn; u.grp = e; u.pn = e * nN + pn; return true; }
    DI const char* a_base(const Unit& u) const { return (const char*)A + (size_t)u.pm * 256 * lda * esz; }
    DI const char* b_base(const Unit& u) const { return (const char*)Bt + (size_t)u.pn * 256 * ldb * esz; }
};

struct MoeGatherSched {
    static constexpr bool GATHER = true; const void* A; const void* Bt; int lda, ldb, nN, G, c; int tp1, tp2, tp3, tp4, tp5, tp6, tp7, tp8; int esz;
    DI bool next(int i, Unit& u) const { int pm, pn; if (!tile_order(i, G, c, tp8, nN, pm, pn)) return false;
        const int e = (pm >= tp1) + (pm >= tp2) + (pm >= tp3) + (pm >= tp4) + (pm >= tp5) + (pm >= tp6) + (pm >= tp7);
        u.pm = pm; u.pc = pn; u.grp = e; u.pn = e * nN + pn; return true; }
    DI const char* a_base(const Unit&) const { return (const char*)A; }
    DI const char* b_base(const Unit& u) const { return (const char*)Bt + (size_t)u.pn * 256 * ldb * esz; }
};
struct TailSched {
    static constexpr bool GATHER = false; const void* A; const void* Bt; int lda, ldb, nN, G, c, pm0, R, s, Ks; int tp1, tp2, tp3, tp4, tp5, tp6, tp7; int esz;
    DI bool next(int i, Unit& u) const { const long L = (long)i * G + c; if (L >= (long)R * s) return false; const int tile = (int)L / s, ks = (int)L % s, pm = pm0 + tile / nN, pn = tile % nN;
        const int e = (pm >= tp1) + (pm >= tp2) + (pm >= tp3) + (pm >= tp4) + (pm >= tp5) + (pm >= tp6) + (pm >= tp7);
        u.pm = pm; u.pc = pn; u.grp = e; u.pn = e * nN + pn; u.aux = ks * R + tile; return true; }
    DI const char* a_base(const Unit& u) const { return (const char*)A + (size_t)u.pm * 256 * lda * esz + (size_t)(u.aux / R) * Ks * esz; }
    DI const char* b_base(const Unit& u) const { return (const char*)Bt + (size_t)u.pn * 256 * ldb * esz + (size_t)(u.aux / R) * Ks * esz; }
};
DI int tail_split8(int R) { const int q = R > 0 ? 256 / R : 0; return q >= 14 ? 14 : q >= 7 ? 7 : q >= 4 ? 4 : q >= 2 ? 2 : 1; }
DI int tail_split(int R) { const int q = R > 0 ? 256 / R : 0; return q >= 28 ? 28 : q >= 14 ? 14 : q >= 8 ? 8 : q >= 7 ? 7 : q >= 4 ? 4 : q >= 2 ? 2 : 1; }

template <class Epi, class Sched, bool BF16 = false>
__device__ __forceinline__ void gemm_phase(LAS unsigned char* lds, const int K, const Sched& S, const Epi& E) {
    const int tid = threadIdx.x, wid = __builtin_amdgcn_readfirstlane(tid >> 6), lane = tid & 63, wr = wid >> 2, wc = wid & 3, fr = lane & 15, fq = lane >> 4;
    const int nt = K / BK; const int lda = S.lda, ldb = S.ldb;
    unsigned voffA[2], voffB[2]; int gR[2], gC[2];
#pragma unroll
    for (int i = 0; i < 2; ++i) { int R, C; stage_rc(tid * 16 + i * 8192, R, C); const int Rb = Epi::PERM ? ((R & ~31) + perm32(R & 31)) : R; gR[i] = R; gC[i] = C;
        voffA[i] = (unsigned)(R * lda + C) * 2u; voffB[i] = (unsigned)(Rb * ldb + C) * 2u; }
    const size_t kstep = (size_t)(BK * 2);
    const size_t hstepA = Sched::GATHER ? (size_t)0 : (size_t)HALF * lda * 2, hstepB = (size_t)HALF * ldb * 2;
    unsigned voC[2][2], voN[2][2];
#define PG8_GOFF(dst, unit_) do { if constexpr (Sched::GATHER) { const LAS unsigned short* tt_ = (const LAS unsigned short*)(lds + TOKTAB_OFF) + (unit_) * 256; _Pragma("unroll") for (int h_ = 0; h_ < 2; ++h_) _Pragma("unroll") for (int i_ = 0; i_ < 2; ++i_) \
        dst[h_][i_] = ((unsigned)tt_[128 * h_ + gR[i_]] * (unsigned)lda + (unsigned)gC[i_]) * 2u; } } while (0)
#define PG8_STAGE_A(b, h, gbase, vset) do { if constexpr (Sched::GATHER) { PG8_STAGE(PG8_SA(b, h), gbase, vset[h]); } else { PG8_STAGE(PG8_SA(b, h), (gbase) + (h) * hstepA, voffA); } } while (0)
    const unsigned ldsw = (unsigned)wid * 1024u;
    const int aoff = lds_byte(wr * 64 + fr, fq * 8), boff = lds_byte(wc * 32 + fr, fq * 8);
#define PG8_SA(b, h) (((b) * 2 + (h)) * HTB)
#define PG8_SB(b, h) ((4 + (b) * 2 + (h)) * HTB)
#define PG8_STAGE(bufoff, gbase, voff) do { _Pragma("unroll") for (int _i = 0; _i < 2; ++_i) \
        __builtin_amdgcn_global_load_lds((const unsigned*)((const char*)(gbase) + (voff)[_i]), (LAS unsigned*)(lds + (bufoff) + ldsw + _i * 8192), 16, 0, 0); } while (0)
#define PG8_LDA(dst, b, h) do { _Pragma("unroll") for (int m = 0; m < 4; ++m) _Pragma("unroll") for (int k = 0; k < 2; ++k) dst[m][k] = *(const LAS h16x8*)(lds + PG8_SA(b, h) + aoff + m * 2048 + k * 1024); } while (0)
#define PG8_LDB(dst, b, h) do { _Pragma("unroll") for (int n = 0; n < 2; ++n) _Pragma("unroll") for (int k = 0; k < 2; ++k) dst[n][k] = *(const LAS h16x8*)(lds + PG8_SB(b, h) + boff + n * 2048 + k * 1024); } while (0)
#define PG8_MMA(ai, bj, At, Bt) do { __builtin_amdgcn_s_setprio(1); _Pragma("unroll") for (int m = 0; m < 4; ++m) _Pragma("unroll") for (int n = 0; n < 2; ++n) _Pragma("unroll") for (int k = 0; k < 2; ++k) \
        acc[ai][bj][m][n] = mma_op<BF16>(Bt[n][k], At[m][k], acc[ai][bj][m][n]); __builtin_amdgcn_s_setprio(0); } while (0)
#define PG8_WAIT_V(n) asm volatile("s_waitcnt vmcnt(" #n ")" ::: "memory")
#define PG8_WAIT_L(n) asm volatile("s_waitcnt lgkmcnt(" #n ")" ::: "memory")
#define PG8_BAR __builtin_amdgcn_s_barrier()
#define PG8_SCHED __builtin_amdgcn_sched_barrier(0)
    Unit cur, nxt; int ui = 0;
    if (!S.next(0, cur)) return;
    f32x4 acc[2][2][4][2];
#pragma unroll
    for (int a = 0; a < 2; ++a)
#pragma unroll
        for (int b = 0; b < 2; ++b)
#pragma unroll
            for (int m = 0; m < 4; ++m)
#pragma unroll
                for (int n = 0; n < 2; ++n) acc[a][b][m][n] = (f32x4){0.f, 0.f, 0.f, 0.f};
    h16x8 At[4][2], B0[2][2], B1[2][2];
    const char* cA = S.a_base(cur); const char* cB = S.b_base(cur);
    PG8_GOFF(voC, 0);
    PG8_STAGE(PG8_SB(0, 0), cB, voffB); PG8_STAGE(PG8_SB(0, 1), cB + hstepB, voffB); PG8_STAGE_A(0, 0, cA, voC); PG8_STAGE_A(0, 1, cA, voC);
    if (wr == 1) PG8_BAR;
    PG8_WAIT_V(2); PG8_BAR;
    PG8_STAGE(PG8_SB(1, 0), cB + kstep, voffB); PG8_STAGE_A(1, 0, cA + kstep, voC); PG8_STAGE(PG8_SB(1, 1), cB + hstepB + kstep, voffB);
    PG8_WAIT_V(6); PG8_BAR;
    for (;;) {
        const bool has_next = S.next(ui + 1, nxt);
        const char* nA = has_next ? S.a_base(nxt) : cA; const char* nB = has_next ? S.b_base(nxt) : cB;
        PG8_GOFF(voN, has_next ? ui + 1 : ui);
        for (int t = 0; t < nt; t += 2) {
            const bool last = (t == nt - 2);
            unsigned vo2[2][2];
            if constexpr (Sched::GATHER) {
#pragma unroll
                for (int h_ = 0; h_ < 2; ++h_)
#pragma unroll
                    for (int i_ = 0; i_ < 2; ++i_) vo2[h_][i_] = last ? voN[h_][i_] : voC[h_][i_]; }
            const char* a1 = cA + (size_t)(t + 1) * kstep;
            const char* a2 = last ? nA : cA + (size_t)(t + 2) * kstep; const char* b2 = last ? nB : cB + (size_t)(t + 2) * kstep;
            const char* a3 = a2 + kstep; const char* b3 = b2 + kstep;
            PG8_LDB(B0, 0, 0); PG8_LDB(B1, 0, 1); PG8_SCHED; PG8_LDA(At, 0, 0); PG8_STAGE_A(1, 1, a1, voC);
            PG8_WAIT_V(8); PG8_WAIT_L(0); PG8_BAR; PG8_MMA(0, 0, At, B0); PG8_MMA(0, 1, At, B1); PG8_BAR; PG8_SCHED;
            PG8_LDA(At, 0, 1); PG8_STAGE(PG8_SB(0, 0), b2, voffB); PG8_STAGE(PG8_SB(0, 1), b2 + hstepB, voffB); PG8_STAGE_A(0, 0, a2, vo2);
            PG8_WAIT_V(8); PG8_WAIT_L(0); PG8_BAR; PG8_MMA(1, 0, At, B0); PG8_MMA(1, 1, At, B1); PG8_BAR; PG8_SCHED;
            PG8_LDB(B0, 1, 0); PG8_LDB(B1, 1, 1); PG8_SCHED; PG8_LDA(At, 1, 0); PG8_STAGE_A(0, 1, a2, vo2);
            PG8_WAIT_V(8); PG8_WAIT_L(0); PG8_BAR; PG8_MMA(0, 0, At, B0); PG8_MMA(0, 1, At, B1); PG8_BAR; PG8_SCHED;
            PG8_LDA(At, 1, 1); PG8_STAGE(PG8_SB(1, 0), b3, voffB); PG8_STAGE(PG8_SB(1, 1), b3 + hstepB, voffB); PG8_STAGE_A(1, 0, a3, vo2);
            PG8_WAIT_V(8); PG8_WAIT_L(0); PG8_BAR; PG8_MMA(1, 0, At, B0); PG8_MMA(1, 1, At, B1); PG8_BAR; PG8_SCHED;
        }
        if (wr == 0) PG8_BAR;
        E(acc, cur, wr, wc, fr, fq);
        if (!has_next) break;
#pragma unroll
        for (int a = 0; a < 2; ++a)
#pragma unroll
            for (int b = 0; b < 2; ++b)
#pragma unroll
                for (int m = 0; m < 4; ++m)
#pragma unroll
                    for (int n = 0; n < 2; ++n) acc[a][b][m][n] = (f32x4){0.f, 0.f, 0.f, 0.f};
        cur = nxt; cA = nA; cB = nB; ++ui;
        if constexpr (Sched::GATHER) {
#pragma unroll
            for (int h_ = 0; h_ < 2; ++h_)
#pragma unroll
                for (int i_ = 0; i_ < 2; ++i_) voC[h_][i_] = voN[h_][i_]; }
        if (wr == 1) PG8_BAR;
    }
    PG8_WAIT_V(0);
    PG8_BAR;
#undef PG8_SA
#undef PG8_GOFF
#undef PG8_STAGE_A
#undef PG8_SB
#undef PG8_STAGE
#undef PG8_LDA
#undef PG8_LDB
#undef PG8_MMA
#undef PG8_WAIT_V
#undef PG8_WAIT_L
#undef PG8_BAR
#undef PG8_SCHED
}
template <class Epi, class Sched>
__device__ __forceinline__ void gemm_phase8(LAS unsigned char* lds, const int K, const Sched& S, const Epi& E) {
    const int tid = threadIdx.x, wid = __builtin_amdgcn_readfirstlane(tid >> 6), lane = tid & 63, wr = wid >> 2, wc = wid & 3, fr = lane & 15, fq = lane >> 4;
    const int nt = K / (2 * BK); const int lda = S.lda, ldb = S.ldb;
    unsigned voffA[2], voffB[2]; int gR[2], gC[2];
#pragma unroll
    for (int i = 0; i < 2; ++i) { int R, C; stage_rc(tid * 16 + i * 8192, R, C); const int Rb = Epi::PERM ? ((R & ~31) + perm32(R & 31)) : R; gR[i] = R; gC[i] = C;
        voffA[i] = (unsigned)(R * lda + C * 2); voffB[i] = (unsigned)(Rb * ldb + C * 2); }
    const size_t kstep = (size_t)(BK * 2);
    const size_t hstepA = Sched::GATHER ? (size_t)0 : (size_t)HALF * lda, hstepB = (size_t)HALF * ldb;
    unsigned voC[2][2], voN[2][2];
#define PG8_GOFF(dst, unit_) do { if constexpr (Sched::GATHER) { const LAS unsigned short* tt_ = (const LAS unsigned short*)(lds + TOKTAB_OFF) + (unit_) * 256; _Pragma("unroll") for (int h_ = 0; h_ < 2; ++h_) _Pragma("unroll") for (int i_ = 0; i_ < 2; ++i_) \
        dst[h_][i_] = (unsigned)tt_[128 * h_ + gR[i_]] * (unsigned)lda + (unsigned)gC[i_] * 2u; } } while (0)
#define PG8_STAGE_A(b, h, gbase, vset) do { if constexpr (Sched::GATHER) { PG8_STAGE(PG8_SA(b, h), gbase, vset[h]); } else { PG8_STAGE(PG8_SA(b, h), (gbase) + (h) * hstepA, voffA); } } while (0)
    const unsigned ldsw = (unsigned)wid * 1024u;
    const int aoff = lds_byte(wr * 64 + fr, fq * 8), boff = lds_byte(wc * 32 + fr, fq * 8);
    int sc127 = 127; asm volatile("" : "+v"(sc127));
#define PG8_SA(b, h) (((b) * 2 + (h)) * HTB)
#define PG8_SB(b, h) ((4 + (b) * 2 + (h)) * HTB)
#define PG8_STAGE(bufoff, gbase, voff) do { _Pragma("unroll") for (int _i = 0; _i < 2; ++_i) \
        __builtin_amdgcn_global_load_lds((const unsigned*)((const char*)(gbase) + (voff)[_i]), (LAS unsigned*)(lds + (bufoff) + ldsw + _i * 8192), 16, 0, 0); } while (0)
#define PG8_LDA(dst, b, h) do { _Pragma("unroll") for (int m = 0; m < 4; ++m) _Pragma("unroll") for (int k = 0; k < 2; ++k) dst[m][k] = *(const LAS h16x8*)(lds + PG8_SA(b, h) + aoff + m * 2048 + k * 1024); } while (0)
#define PG8_LDB(dst, b, h) do { _Pragma("unroll") for (int n = 0; n < 2; ++n) _Pragma("unroll") for (int k = 0; k < 2; ++k) dst[n][k] = *(const LAS h16x8*)(lds + PG8_SB(b, h) + boff + n * 2048 + k * 1024); } while (0)
#define PG8_MMA(ai, bj, At, Bt) do { _Pragma("unroll") for (int m = 0; m < 4; ++m) _Pragma("unroll") for (int n = 0; n < 2; ++n) \
        asm volatile("v_mfma_scale_f32_16x16x128_f8f6f4 %0, %1, %2, %0, %3, %3 op_sel_hi:[0,0,0]" : "+v"(acc[ai][bj][m][n]) : "v"(cat8(Bt[n][0], Bt[n][1])), "v"(cat8(At[m][0], At[m][1])), "v"(sc127)); \
        } while (0)
#define PG8_WAIT_V(n) asm volatile("s_waitcnt vmcnt(" #n ")" ::: "memory")
#define PG8_WAIT_L(n) asm volatile("s_waitcnt lgkmcnt(" #n ")" ::: "memory")
#define PG8_BAR __builtin_amdgcn_s_barrier()
#define PG8_SCHED __builtin_amdgcn_sched_barrier(0)
    Unit cur, nxt; int ui = 0;
    if (!S.next(0, cur)) return;
    f32x4 acc[2][2][4][2];
#pragma unroll
    for (int a = 0; a < 2; ++a)
#pragma unroll
        for (int b = 0; b < 2; ++b)
#pragma unroll
            for (int m = 0; m < 4; ++m)
#pragma unroll
                for (int n = 0; n < 2; ++n) acc[a][b][m][n] = (f32x4){0.f, 0.f, 0.f, 0.f};
    h16x8 At[4][2], B0[2][2], B1[2][2];
    const char* cA = S.a_base(cur); const char* cB = S.b_base(cur);
    PG8_GOFF(voC, 0);
    PG8_STAGE(PG8_SB(0, 0), cB, voffB); PG8_STAGE(PG8_SB(0, 1), cB + hstepB, voffB); PG8_STAGE_A(0, 0, cA, voC); PG8_STAGE_A(0, 1, cA, voC);
    if (wr == 1) PG8_BAR;
    PG8_WAIT_V(2); PG8_BAR;
    PG8_STAGE(PG8_SB(1, 0), cB + kstep, voffB); PG8_STAGE_A(1, 0, cA + kstep, voC); PG8_STAGE(PG8_SB(1, 1), cB + hstepB + kstep, voffB);
    PG8_WAIT_V(6); PG8_BAR;
    for (;;) {
        const bool has_next = S.next(ui + 1, nxt);
        const char* nA = has_next ? S.a_base(nxt) : cA; const char* nB = has_next ? S.b_base(nxt) : cB;
        PG8_GOFF(voN, has_next ? ui + 1 : ui);
        for (int t = 0; t < nt; t += 2) {
            const bool last = (t == nt - 2);
            unsigned vo2[2][2];
            if constexpr (Sched::GATHER) {
#pragma unroll
                for (int h_ = 0; h_ < 2; ++h_)
#pragma unroll
                    for (int i_ = 0; i_ < 2; ++i_) vo2[h_][i_] = last ? voN[h_][i_] : voC[h_][i_]; }
            const char* a1 = cA + (size_t)(t + 1) * kstep;
            const char* a2 = last ? nA : cA + (size_t)(t + 2) * kstep; const char* b2 = last ? nB : cB + (size_t)(t + 2) * kstep;
            const char* a3 = a2 + kstep; const char* b3 = b2 + kstep;
            PG8_LDB(B0, 0, 0); PG8_LDB(B1, 0, 1); PG8_SCHED; PG8_LDA(At, 0, 0); PG8_STAGE_A(1, 1, a1, voC);
            PG8_WAIT_V(8); PG8_WAIT_L(0); PG8_BAR; PG8_MMA(0, 0, At, B0); PG8_MMA(0, 1, At, B1); PG8_BAR; PG8_SCHED;
            PG8_LDA(At, 0, 1); PG8_STAGE(PG8_SB(0, 0), b2, voffB); PG8_STAGE(PG8_SB(0, 1), b2 + hstepB, voffB); PG8_STAGE_A(0, 0, a2, vo2);
            PG8_WAIT_V(8); PG8_WAIT_L(0); PG8_BAR; PG8_MMA(1, 0, At, B0); PG8_MMA(1, 1, At, B1); PG8_BAR; PG8_SCHED;
            PG8_LDB(B0, 1, 0); PG8_LDB(B1, 1, 1); PG8_SCHED; PG8_LDA(At, 1, 0); PG8_STAGE_A(0, 1, a2, vo2);
            PG8_WAIT_V(8); PG8_WAIT_L(0); PG8_BAR; PG8_MMA(0, 0, At, B0); PG8_MMA(0, 1, At, B1); PG8_BAR; PG8_SCHED;
            PG8_LDA(At, 1, 1); PG8_STAGE(PG8_SB(1, 0), b3, voffB); PG8_STAGE(PG8_SB(1, 1), b3 + hstepB, voffB); PG8_STAGE_A(1, 0, a3, vo2);
            PG8_WAIT_V(8); PG8_WAIT_L(0); PG8_BAR; PG8_MMA(1, 0, At, B0); PG8_MMA(1, 1, At, B1); PG8_BAR; PG8_SCHED;
        }
        if (wr == 0) PG8_BAR;
        asm volatile("s_nop 15\n\ts_nop 15\n\ts_nop 15" ::: "memory");
#pragma unroll
        for (int ai_ = 0; ai_ < 2; ++ai_)
#pragma unroll
            for (int bj_ = 0; bj_ < 2; ++bj_) asm volatile("" : "+v"(acc[ai_][bj_][0][0]), "+v"(acc[ai_][bj_][0][1]), "+v"(acc[ai_][bj_][1][0]), "+v"(acc[ai_][bj_][1][1]), "+v"(acc[ai_][bj_][2][0]), "+v"(acc[ai_][bj_][2][1]), "+v"(acc[ai_][bj_][3][0]), "+v"(acc[ai_][bj_][3][1]));
        E(acc, cur, wr, wc, fr, fq);
        if (!has_next) break;
#pragma unroll
        for (int a = 0; a < 2; ++a)
#pragma unroll
            for (int b = 0; b < 2; ++b)
#pragma unroll
                for (int m = 0; m < 4; ++m)
#pragma unroll
                    for (int n = 0; n < 2; ++n) acc[a][b][m][n] = (f32x4){0.f, 0.f, 0.f, 0.f};
        cur = nxt; cA = nA; cB = nB; ++ui;
        if constexpr (Sched::GATHER) {
#pragma unroll
            for (int h_ = 0; h_ < 2; ++h_)
#pragma unroll
                for (int i_ = 0; i_ < 2; ++i_) voC[h_][i_] = voN[h_][i_]; }
        if (wr == 1) PG8_BAR;
    }
    PG8_WAIT_V(0);
    PG8_BAR;
#undef PG8_GOFF
#undef PG8_STAGE_A
#undef PG8_SA
#undef PG8_SB
#undef PG8_STAGE
#undef PG8_LDA
#undef PG8_LDB
#undef PG8_MMA
#undef PG8_WAIT_V
#undef PG8_WAIT_L
#undef PG8_BAR
#undef PG8_SCHED
}

#define EPI_ARGS const f32x4 (&acc)[2][2][4][2], const Unit& u, int wr, int wc, int fr, int fq
struct EpiH {
    static constexpr bool PERM = true;
    h16* O; int ldc;
    DI void operator()(EPI_ARGS) const {
        const int row0 = u.pm * 256 + wr * 64 + fr, col0 = u.pc * 256 + wc * 32 + 8 * fq;
#pragma unroll
        for (int ai = 0; ai < 2; ++ai)
#pragma unroll
            for (int m = 0; m < 4; ++m) { h16* rowp = O + (size_t)(row0 + ai * 128 + m * 16) * ldc + col0;
#pragma unroll
                for (int bj = 0; bj < 2; ++bj) { const f32x4 v0 = acc[ai][bj][m][0], v1 = acc[ai][bj][m][1];
                    u32x4 w; w.x = pkh(v0[0], v0[1]); w.y = pkh(v0[2], v0[3]); w.z = pkh(v1[0], v1[1]); w.w = pkh(v1[2], v1[3]);
                    *(u32x4*)(rowp + bj * 128) = w; } }
    }
};
struct EpiRes {
    static constexpr bool PERM = true;
    const h16* R; h16* O; int ldc;
    DI void operator()(EPI_ARGS) const {
        const int row0 = u.pm * 256 + wr * 64 + fr, col0 = u.pc * 256 + wc * 32 + 8 * fq;
#pragma unroll
        for (int ai = 0; ai < 2; ++ai)
#pragma unroll
            for (int m = 0; m < 4; ++m) { const size_t off = (size_t)(row0 + ai * 128 + m * 16) * ldc + col0;
#pragma unroll
                for (int bj = 0; bj < 2; ++bj) { const h16x8 r = *(const h16x8*)(R + off + bj * 128); const f32x4 v0 = acc[ai][bj][m][0], v1 = acc[ai][bj][m][1];
                    u32x4 w; w.x = pkh(ALPHA * (float)r[0] + v0[0], ALPHA * (float)r[1] + v0[1]); w.y = pkh(ALPHA * (float)r[2] + v0[2], ALPHA * (float)r[3] + v0[3]);
                    w.z = pkh(ALPHA * (float)r[4] + v1[0], ALPHA * (float)r[5] + v1[1]); w.w = pkh(ALPHA * (float)r[6] + v1[2], ALPHA * (float)r[7] + v1[3]);
                    *(u32x4*)(O + off + bj * 128) = w; }
                asm volatile("" ::: "memory"); }
    }
};
struct EpiSwiGLU {
    static constexpr bool PERM = true;
    h16* O; int ldc; int drop;
    DI void operator()(EPI_ARGS) const {
        const int row0 = u.pm * 256 + wr * 64 + fr, col0 = u.pc * 128 + wc * 32 + 8 * fq;
#pragma unroll
        for (int ai = 0; ai < 2; ++ai)
#pragma unroll
            for (int m = 0; m < 4; ++m) { h16* rowp = O + (size_t)(row0 + ai * 128 + m * 16) * ldc + col0;
                float r[8];
#pragma unroll
                for (int n = 0; n < 2; ++n)
#pragma unroll
                    for (int j = 0; j < 4; ++j) { const float g = acc[ai][0][m][n][j], up = acc[ai][1][m][n][j]; r[n * 4 + j] = siluf_(g) * up; }
                u32x4 w; w.x = rnd_drop(pkh(r[0], r[1]), drop); w.y = rnd_drop(pkh(r[2], r[3]), drop); w.z = rnd_drop(pkh(r[4], r[5]), drop); w.w = rnd_drop(pkh(r[6], r[7]), drop);
                *(u32x4*)rowp = w; }
    }
};
struct EpiIn1 {
    static constexpr bool PERM = true;
    h16* Ucat; h16* QKVG; float* LOGIT;
    DI void operator()(EPI_ARGS) const {
        const int row0 = u.pm * 256 + wr * 64 + fr;
#pragma unroll
        for (int ai = 0; ai < 2; ++ai)
#pragma unroll
            for (int m = 0; m < 4; ++m) { const int row = row0 + ai * 128 + m * 16;
#pragma unroll
                for (int bj = 0; bj < 2; ++bj) { const int col = u.pc * 256 + bj * 128 + wc * 32 + 8 * fq; const f32x4 v0 = acc[ai][bj][m][0], v1 = acc[ai][bj][m][1];
                    u32x4 w; w.x = pkh(v0[0], v0[1]); w.y = pkh(v0[2], v0[3]); w.z = pkh(v1[0], v1[1]); w.w = pkh(v1[2], v1[3]);
                    if (u.pc < 4) { const int g = col >> 4, hh = col & 15, b = row >> 13, t = row & 8191, ch = t >> 5, sg = t & 31;
                        *(u32x4*)(Ucat + ((size_t)(g * S5N + b * S5NCH + ch) * S5K + sg * 16 + hh)) = w; }
                    else { *(u32x4*)(QKVG + (size_t)row * 4096 + (col - 1024)) = w; } } }
    }
};
struct EpiS5Y {
    static constexpr bool PERM = true;
    const h16* Ucat; const float* Dskip; h16* Z;
    DI void operator()(EPI_ARGS) const {
        const int g = u.grp;
#pragma unroll
        for (int bj = 0; bj < 2; ++bj) { const int col = u.pc * 256 + bj * 128 + wc * 32 + 8 * fq, tau = col >> 4, hh = col & 15;
            const f32x4 d0 = *(const f32x4*)(Dskip + g * 16 + hh), d1 = *(const f32x4*)(Dskip + g * 16 + hh + 4);
#pragma unroll
            for (int ai = 0; ai < 2; ++ai)
#pragma unroll
                for (int m = 0; m < 4; ++m) { const int n = u.pm * 256 + ai * 128 + wr * 64 + m * 16 + fr, b = n >> 8, ch = n & 255;
                    const h16x8 uv = *(const h16x8*)(Ucat + ((size_t)(g * S5N + n) * S5K + col));
                    const f32x4 v0 = acc[ai][bj][m][0], v1 = acc[ai][bj][m][1]; float r[8];
#pragma unroll
                    for (int j = 0; j < 8; ++j) { const float a = (j < 4 ? v0[j & 3] : v1[j & 3]), dd = (j < 4 ? d0[j & 3] : d1[j & 3]); const float y = a + dd * (float)uv[j];
                        r[j] = y * fast_rcp(1.0f + __expf(-1.5957691216057308f * (y + 0.044715f * y * y * y))); }
                    u32x4 w; w.x = pkh(r[0], r[1]); w.y = pkh(r[2], r[3]); w.z = pkh(r[4], r[5]); w.w = pkh(r[6], r[7]);
                    *(u32x4*)(Z + (size_t)(b * SEQ + ch * S5L + tau) * 1024 + g * 16 + hh) = w; } }
    }
};
struct EpiGLU {
    static constexpr bool PERM = true;
    const h16* Z; const float* bias; h16* O;
    DI void operator()(EPI_ARGS) const {
        const int row0 = u.pm * 256 + wr * 64 + fr;
#pragma unroll
        for (int bj = 0; bj < 2; ++bj) { const int col = u.pc * 256 + bj * 128 + wc * 32 + 8 * fq;
            const f32x4 b0 = *(const f32x4*)(bias + col), b1 = *(const f32x4*)(bias + col + 4);
#pragma unroll
            for (int ai = 0; ai < 2; ++ai)
#pragma unroll
                for (int m = 0; m < 4; ++m) { const int row = row0 + ai * 128 + m * 16;
                    const h16x8 zv = *(const h16x8*)(Z + (size_t)row * 1024 + col);
                    const f32x4 v0 = acc[ai][bj][m][0], v1 = acc[ai][bj][m][1]; float r[8];
#pragma unroll
                    for (int j = 0; j < 8; ++j) { const float a = (j < 4 ? v0[j & 3] + b0[j & 3] : v1[j & 3] + b1[j & 3]); r[j] = (float)zv[j] * sigmoidf_(a); }
                    u32x4 w; w.x = pkh(r[0], r[1]); w.y = pkh(r[2], r[3]); w.z = pkh(r[4], r[5]); w.w = pkh(r[6], r[7]);
                    *(u32x4*)(O + (size_t)row * 2048 + col) = w; } }
    }
};
struct EpiEC {
    static constexpr bool PERM = false;
    float* EC;
    DI void operator()(EPI_ARGS) const {
        const int g = u.grp, col0 = wc * 32 + 4 * fq;
#pragma unroll
        for (int ai = 0; ai < 2; ++ai)
#pragma unroll
            for (int m = 0; m < 4; ++m) { const int n = u.pm * 256 + ai * 128 + wr * 64 + m * 16 + fr; float* rowp = EC + ((size_t)(g * S5N + n)) * 128 + col0;
#pragma unroll
                for (int nn = 0; nn < 2; ++nn) *(f32x4*)(rowp + nn * 16) = acc[ai][0][m][nn]; }
    }
};
DI unsigned pk_fp8x4(float a, float b, float c, float d) {
    a = fminf(fmaxf(a, -448.f), 448.f); b = fminf(fmaxf(b, -448.f), 448.f); c = fminf(fmaxf(c, -448.f), 448.f); d = fminf(fmaxf(d, -448.f), 448.f);
    unsigned w = 0u; w = __builtin_amdgcn_cvt_pk_fp8_f32(a, b, w, false); w = __builtin_amdgcn_cvt_pk_fp8_f32(c, d, w, true); return w; }
constexpr float H8_SCALE = 8.0f, W8_SCALE = 256.0f, X8_SCALE = 16.0f;
struct EpiSwiGLU8 {
    static constexpr bool PERM = true;
    unsigned char* O; int ldc; float isc;
    DI void operator()(EPI_ARGS) const {
        const int row0 = u.pm * 256 + wr * 64 + fr, col0 = u.pc * 128 + wc * 32 + 8 * fq;
#pragma unroll
        for (int ai = 0; ai < 2; ++ai)
#pragma unroll
            for (int m = 0; m < 4; ++m) { unsigned char* rowp = O + (size_t)(row0 + ai * 128 + m * 16) * ldc + col0;
                float r[8];
#pragma unroll
                for (int n = 0; n < 2; ++n)
#pragma unroll
                    for (int j = 0; j < 4; ++j) { const float g = acc[ai][0][m][n][j] * isc, up = acc[ai][1][m][n][j] * isc; r[n * 4 + j] = H8_SCALE * siluf_(g) * up; }
                u32x2 w; w.x = pk_fp8x4(r[0], r[1], r[2], r[3]); w.y = pk_fp8x4(r[4], r[5], r[6], r[7]);
                *(u32x2*)rowp = w; }
    }
};
struct EpiHs {
    static constexpr bool PERM = true;
    h16* O; int ldc; float scale;
    DI void operator()(EPI_ARGS) const {
        const int row0 = u.pm * 256 + wr * 64 + fr, col0 = u.pc * 256 + wc * 32 + 8 * fq;
#pragma unroll
        for (int ai = 0; ai < 2; ++ai)
#pragma unroll
            for (int m = 0; m < 4; ++m) { h16* rowp = O + (size_t)(row0 + ai * 128 + m * 16) * ldc + col0;
#pragma unroll
                for (int bj = 0; bj < 2; ++bj) { const f32x4 v0 = acc[ai][bj][m][0] * scale, v1 = acc[ai][bj][m][1] * scale;
                    u32x4 w; w.x = pkh(v0[0], v0[1]); w.y = pkh(v0[2], v0[3]); w.z = pkh(v1[0], v1[1]); w.w = pkh(v1[2], v1[3]);
                    *(u32x4*)(rowp + bj * 128) = w; } }
    }
};
struct EpiSlab {
    static constexpr bool PERM = false;
    float* SL; float scale;
    DI void operator()(EPI_ARGS) const {
        float* base = SL + (size_t)u.aux * 65536 + (size_t)(wr * 64 + fr) * 256 + wc * 32 + 4 * fq;
#pragma unroll
        for (int ai = 0; ai < 2; ++ai)
#pragma unroll
            for (int m = 0; m < 4; ++m)
#pragma unroll
                for (int bj = 0; bj < 2; ++bj)
#pragma unroll
                    for (int n = 0; n < 2; ++n) *(f32x4*)(base + (size_t)(ai * 128 + m * 16) * 256 + bj * 128 + n * 16) = acc[ai][bj][m][n] * scale;
    }
};
}

struct Args { const float* in[34]; float* out; unsigned char* ws; int ph_lo, ph_hi; };
enum { I_X = 0, I_EWIN, I_EWOUT, I_ELNMG, I_ELNMB, I_EW1, I_EW3, I_EW2, I_ELNFG, I_ELNFB, I_OWIN, I_LAMRE, I_LAMIM, I_LOGDT, I_BRE, I_BIM, I_CRE, I_CIM, I_SSMD,
       I_GLUW, I_GLUB, I_CONVW, I_ALOG, I_DTB, I_NORMW, I_OWOUT, I_OLNMG, I_OLNMB, I_ROUTER, I_MW1, I_MW3, I_MW2, I_OLNFG, I_OLNFB };

DI void tr_item(const float* W, int N, int k0, int n0, h16* WT, size_t drow0, int ldd, float* scr, int lane, int drop) {
    const int c4 = (lane & 15) * 4, r4 = lane >> 4;
    f32x4 v[16];
#pragma unroll
    for (int i = 0; i < 16; ++i) { const int kk = 4 * i + r4, col = n0 + c4; v[i] = (col < N) ? *(const f32x4*)(W + (size_t)(k0 + kk) * N + col) : (f32x4){0.f, 0.f, 0.f, 0.f}; }
#pragma unroll
    for (int i = 0; i < 16; ++i) { float* s = scr + (4 * i + r4) * 65 + c4; s[0] = v[i][0]; s[1] = v[i][1]; s[2] = v[i][2]; s[3] = v[i][3]; }
    asm volatile("s_waitcnt lgkmcnt(0)" ::: "memory");
    const int c = lane & 7, nb = lane >> 3;
#pragma unroll
    for (int j = 0; j < 8; ++j) { const int n = nb + 8 * j; const float* s = scr + (8 * c) * 65 + n;
        u32x4 o; o.x = rnd_drop(pkh(s[0], s[65]), drop); o.y = rnd_drop(pkh(s[130], s[195]), drop); o.z = rnd_drop(pkh(s[260], s[325]), drop); o.w = rnd_drop(pkh(s[390], s[455]), drop);
        *(u32x4*)(WT + (drow0 + n) * (size_t)ldd + k0 + 8 * c) = o; }
    asm volatile("s_waitcnt lgkmcnt(0)" ::: "memory");
}
DI void tr_item8(const float* W, int N, int k0, int n0, unsigned char* WT, size_t drow0, int ldd, float* scr, int lane) {
    const int c4 = (lane & 7) * 4, r8 = lane >> 3;
    f32x4 v[16];
#pragma unroll
    for (int i = 0; i < 16; ++i) v[i] = *(const f32x4*)(W + (size_t)(k0 + 8 * i + r8) * N + n0 + c4);
#pragma unroll
    for (int i = 0; i < 16; ++i) { float* s = scr + (8 * i + r8) * 33 + c4; s[0] = v[i][0]; s[1] = v[i][1]; s[2] = v[i][2]; s[3] = v[i][3]; }
    asm volatile("s_waitcnt lgkmcnt(0)" ::: "memory");
    const int c = lane & 7, nb = lane >> 3;
#pragma unroll
    for (int j = 0; j < 4; ++j) { const int n = nb + 8 * j; const float* s = scr + (16 * c) * 33 + n; const float ws_ = pg8::W8_SCALE;
        u32x4 o; o.x = pg8::pk_fp8x4(s[0] * ws_, s[33] * ws_, s[66] * ws_, s[99] * ws_); o.y = pg8::pk_fp8x4(s[132] * ws_, s[165] * ws_, s[198] * ws_, s[231] * ws_);
        o.z = pg8::pk_fp8x4(s[264] * ws_, s[297] * ws_, s[330] * ws_, s[363] * ws_); o.w = pg8::pk_fp8x4(s[396] * ws_, s[429] * ws_, s[462] * ws_, s[495] * ws_);
        *(u32x4*)(WT + (drow0 + n) * (size_t)ldd + k0 + 16 * c) = o; }
    asm volatile("s_waitcnt lgkmcnt(0)" ::: "memory");
}
DI void tr_matrix8(const float* W, int K, int N, unsigned char* WT, int ldd, size_t rowbase, int gw, int ngw, float* scr, int lane, int mode = 0) {
    const int nkb = K / 128, nit = nkb * (N / 32);
    const int nnb = N / 32;
    for (int it = gw; it < nit; it += ngw) { const int kb = it / nnb, n0 = (it % nnb) * 32;     tr_item8(W, N, kb * 128, n0, WT, mode ? rowbase + (size_t)(n0 >> 7) * 256 + (n0 & 127) : rowbase + n0, ldd, scr, lane); }
}
DI void tr_matrix(const float* W, int K, int N, int NP, h16* WT, int ldd, int mode, size_t rowbase, int gw, int ngw, float* scr, int lane, int drop = WQ_DROP) {
    const int nnb = NP / 64, nit = (K / 64) * nnb;
    const int nkb = K / 64;
    for (int it = gw; it < nit; it += ngw) { const int kb = it % nkb, n0 = (it / nkb) * 64;
        const size_t drow0 = mode ? rowbase + (size_t)(n0 >> 7) * 256 + (n0 & 127) : rowbase + n0;
        tr_item(W, N, kb * 64, n0, WT, drow0, ldd, scr, lane, drop); }
}
DI void s5_tables(const Args& a, char* lds, int g, int q4, int nq) {
    const int tid = threadIdx.x;
    f32x2* Lpow = (f32x2*)lds;
    f32x2* Bbar = Lpow + 33 * 64;
    f32x2* Cc = Bbar + 1024;
    f32x2* coef = Cc + 1024;
    float* Kern = (float*)(coef + 64);
    h16* TCAT = (h16*)(a.ws + WS_TCAT) + (size_t)g * 512 * S5K;
    h16* EPAD = (h16*)(a.ws + WS_EPAD) + (size_t)g * 256 * 512;
    __syncthreads();
    if (tid < 64) { const int p = tid; const float dt = expf(a.in[I_LOGDT][g]); const float lre = a.in[I_LAMRE][g * 64 + p], lim = a.in[I_LAMIM][g * 64 + p];
        const float mag = expf(lre * dt); float sn, cs; sincosf(lim * dt, &sn, &cs); const float l1r = mag * cs, l1i = mag * sn;
        float pr = 1.f, pi = 0.f; Lpow[p] = (f32x2){1.f, 0.f};
        for (int j = 1; j <= 32; ++j) { const float nr = pr * l1r - pi * l1i, ni = pr * l1i + pi * l1r; pr = nr; pi = ni; Lpow[j * 64 + p] = (f32x2){pr, pi}; }
        const float nr = l1r - 1.f, ni = l1i, den = lre * lre + lim * lim; coef[p] = (f32x2){(nr * lre + ni * lim) / den, (ni * lre - nr * lim) / den}; }
    __syncthreads();
    for (int i = tid; i < 1024; i += NT) { const int p = i >> 4; const float br = a.in[I_BRE][g * 1024 + i], bi = a.in[I_BIM][g * 1024 + i]; const f32x2 c = coef[p];
        Bbar[i] = (f32x2){c.x * br - c.y * bi, c.x * bi + c.y * br}; Cc[i] = (f32x2){a.in[I_CRE][g * 1024 + i], a.in[I_CIM][g * 1024 + i]}; }
    __syncthreads();
    const int r_lo = 512 * q4 / nq, r_hi = 512 * (q4 + 1) / nq, e_lo = 256 * q4 / nq, e_hi = 256 * (q4 + 1) / nq, nlag = ((r_hi - 1) >> 4) + 1;
    for (int i = tid; i < nlag * 256; i += NT) { const int j = i >> 8, h = (i >> 4) & 15, h2 = i & 15; float s = 0.f;
        for (int p = 0; p < 64; ++p) { const f32x2 c = Cc[h * 64 + p], l = Lpow[j * 64 + p], b = Bbar[p * 16 + h2]; const float mr = c.x * l.x - c.y * l.y, mi = c.x * l.y + c.y * l.x; s += mr * b.x - mi * b.y; }
        Kern[i] = s; }
    __syncthreads();
    for (int i = r_lo * 80 + tid; i < r_hi * 80; i += NT) { const int row = i / 80, ch = i % 80, tau = row >> 4, h = row & 15; float r[8];
        if (ch < 64) { const int sg = ch >> 1, h0 = (ch & 1) * 8, lag = tau - sg;
#pragma unroll
            for (int j = 0; j < 8; ++j) r[j] = lag >= 0 ? Kern[lag * 256 + h * 16 + h0 + j] : 0.f; }
        else { const int p0 = (ch - 64) * 4;
#pragma unroll
            for (int q = 0; q < 4; ++q) { const f32x2 c = Cc[h * 64 + p0 + q], l = Lpow[(tau + 1) * 64 + p0 + q]; r[2 * q] = c.x * l.x - c.y * l.y; r[2 * q + 1] = -(c.x * l.y + c.y * l.x); } }
        u32x4 w; w.x = pkh(r[0], r[1]); w.y = pkh(r[2], r[3]); w.z = pkh(r[4], r[5]); w.w = pkh(r[6], r[7]);
        *(u32x4*)(TCAT + (size_t)row * S5K + ch * 8) = w; }
    for (int i = e_lo * 64 + tid; i < e_hi * 64; i += NT) { const int row = i >> 6, ch = i & 63; float r[8];
        if (row < 128) { const int p = row >> 1, ri = row & 1, sg = ch >> 1, h0 = (ch & 1) * 8; const f32x2 l = Lpow[(31 - sg) * 64 + p];
#pragma unroll
            for (int j = 0; j < 8; ++j) { const f32x2 b = Bbar[p * 16 + h0 + j]; r[j] = ri ? (l.x * b.y + l.y * b.x) : (l.x * b.x - l.y * b.y); } }
        else {
#pragma unroll
            for (int j = 0; j < 8; ++j) r[j] = 0.f; }
        u32x4 w; w.x = pkh(r[0], r[1]); w.y = pkh(r[2], r[3]); w.z = pkh(r[4], r[5]); w.w = pkh(r[6], r[7]);
        *(u32x4*)(EPAD + (size_t)row * 512 + ch * 8) = w; }
}
#ifndef MOE_CONV_LATE
#define MOE_CONV_LATE 6
#endif
DI void moe_convert(const Args& a, char* lds, int e_lo, int e_hi, int gw, int ngw) {
    const int lane = threadIdx.x & 63, wave = threadIdx.x >> 6; float* scr = (float*)(lds + wave * 16896); unsigned char* ws = a.ws;
    for (int e = e_lo; e < e_hi; ++e) {
        tr_matrix8(a.in[I_MW1] + (size_t)e * D * DFE, D, DFE, (unsigned char*)(ws + WS_MOE13), D, (size_t)e * 2 * DFE, gw, ngw, scr, lane, 1);
        tr_matrix8(a.in[I_MW3] + (size_t)e * D * DFE, D, DFE, (unsigned char*)(ws + WS_MOE13), D, (size_t)e * 2 * DFE + 128, gw, ngw, scr, lane, 1);
        tr_matrix8(a.in[I_MW2] + (size_t)e * DFE * D, DFE, D, (unsigned char*)(ws + WS_MOE2), DFE, (size_t)e * D, gw, ngw, scr, lane);
    }
}
DI void phase_prologue(const Args& a, char* lds) {
    const int tid = threadIdx.x, lane = tid & 63, wave = tid >> 6, gw = blockIdx.x * NWAVES + wave, ngw = gridDim.x * NWAVES;
    float* scr = (float*)(lds + wave * 16896);
    unsigned char* ws = a.ws;
    moe_convert(a, lds, 0, MOE_CONV_LATE, gw, ngw);
    tr_matrix(a.in[I_OWOUT], D, D, D, (h16*)(ws + WS_WOUT1), D, 0, 0, gw, ngw, scr, lane);
    tr_matrix(a.in[I_GLUW], 1024, 1024, 1024, (h16*)(ws + WS_WGLU), 1024, 0, 0, gw, ngw, scr, lane);
    tr_matrix(a.in[I_OWIN], D, IN1, IN1P, (h16*)(ws + WS_WIN1), D, 0, 0, gw, ngw, scr, lane);
    tr_matrix(a.in[I_EW2], DFF, D, D, (h16*)(ws + WS_WFF2), DFF, 0, 0, gw, ngw, scr, lane);
    tr_matrix(a.in[I_EW1], D, DFF, DFF, (h16*)(ws + WS_WFF13), D, 1, 0, gw, ngw, scr, lane);
    tr_matrix(a.in[I_EW3], D, DFF, DFF, (h16*)(ws + WS_WFF13), D, 1, 128, gw, ngw, scr, lane);
    tr_matrix(a.in[I_EWOUT], D, D, D, (h16*)(ws + WS_WOUT0), D, 0, 0, gw, ngw, scr, lane);
    tr_matrix(a.in[I_EWIN], D, IN0, IN0, (h16*)(ws + WS_WIN0), D, 0, 0, gw, ngw, scr, lane);
    { const float* x = a.in[I_X]; h16* xh = (h16*)(ws + WS_XH);
      for (size_t i = (size_t)blockIdx.x * NT + tid; i < (size_t)M * D / 8; i += (size_t)gridDim.x * NT) { const f32x4 v0 = *(const f32x4*)(x + i * 8), v1 = *(const f32x4*)(x + i * 8 + 4);
          u32x4 w; w.x = pka(v0[0], v0[1]); w.y = pka(v0[2], v0[3]); w.z = pka(v1[0], v1[1]); w.w = pka(v1[2], v1[3]); *(u32x4*)(xh + i * 8) = w; } }
    __syncthreads();
    if (gridDim.x >= 256) { if (blockIdx.x < 256) s5_tables(a, lds, (int)blockIdx.x >> 2, (int)blockIdx.x & 3, 4); }
    else for (int g = blockIdx.x; g < 64; g += gridDim.x) s5_tables(a, lds, g, 0, 1);
}

DI void ln_normalize(float (&v)[32], const float* gam, const float* bet, int lane) {
    float s = 0.f;
#pragma unroll
    for (int i = 0; i < 32; ++i) s += v[i];
    const float mean = wave_sum(s) * (1.f / D); float s2 = 0.f;
#pragma unroll
    for (int i = 0; i < 32; ++i) { v[i] -= mean; s2 += v[i] * v[i]; }
    const float rstd = 1.0f / sqrtf(wave_sum(s2) * (1.f / D) + 1e-5f);
#pragma unroll
    for (int j = 0; j < 4; ++j) { const f32x4 g0 = *(const f32x4*)(gam + 8 * lane + 512 * j), g1 = *(const f32x4*)(gam + 8 * lane + 512 * j + 4), b0 = *(const f32x4*)(bet + 8 * lane + 512 * j), b1 = *(const f32x4*)(bet + 8 * lane + 512 * j + 4);
#pragma unroll
        for (int q = 0; q < 4; ++q) { v[8 * j + q] = v[8 * j + q] * rstd * g0[q] + b0[q]; v[8 * j + 4 + q] = v[8 * j + 4 + q] * rstd * g1[q] + b1[q]; } }
}
template <bool ROUTER>
DI void phase_ln(const Args& a, char* lds, const h16* Pin, const float* gam, const float* bet) {
    const int tid = threadIdx.x, lane = tid & 63, wave = tid >> 6, gw = blockIdx.x * NWAVES + wave, ngw = gridDim.x * NWAVES;
    h16* XH = (h16*)(a.ws + WS_XH);
    float* WrT = (float*)lds;
    if (ROUTER) { __syncthreads(); const float* rw = a.in[I_ROUTER]; for (int i = tid; i < D * 8; i += NT) WrT[(i & 7) * D + (i >> 3)] = rw[i]; __syncthreads(); }
    h16x8 pn[4];
    if (gw < M) {
#pragma unroll
        for (int j = 0; j < 4; ++j) pn[j] = *(const h16x8*)(Pin + (size_t)gw * D + 8 * lane + 512 * j); }
    for (int row = gw; row < M; row += ngw) {
        float v[32];
#pragma unroll
        for (int j = 0; j < 4; ++j) {
#pragma unroll
            for (int q = 0; q < 8; ++q) v[8 * j + q] = (float)pn[j][q]; }
        { const int nr = row + ngw < M ? row + ngw : row;
#pragma unroll
          for (int j = 0; j < 4; ++j) pn[j] = *(const h16x8*)(Pin + (size_t)nr * D + 8 * lane + 512 * j); }
        ln_normalize(v, gam, bet, lane);
#pragma unroll
        for (int j = 0; j < 4; ++j) { u32x4 w; w.x = pka(v[8 * j], v[8 * j + 1]); w.y = pka(v[8 * j + 2], v[8 * j + 3]); w.z = pka(v[8 * j + 4], v[8 * j + 5]); w.w = pka(v[8 * j + 6], v[8 * j + 7]);
            *(u32x4*)(XH + (size_t)row * D + 8 * lane + 512 * j) = w; }
        if (ROUTER) {
#pragma unroll
            for (int j = 0; j < 4; ++j) { u32x2 q; q.x = pg8::pk_fp8x4(v[8 * j] * pg8::X8_SCALE, v[8 * j + 1] * pg8::X8_SCALE, v[8 * j + 2] * pg8::X8_SCALE, v[8 * j + 3] * pg8::X8_SCALE);
                q.y = pg8::pk_fp8x4(v[8 * j + 4] * pg8::X8_SCALE, v[8 * j + 5] * pg8::X8_SCALE, v[8 * j + 6] * pg8::X8_SCALE, v[8 * j + 7] * pg8::X8_SCALE);
                *(u32x2*)(a.ws + WS_XQ8 + (size_t)row * D + 8 * lane + 512 * j) = q; }
            float lg[8];
#pragma unroll
            for (int e = 0; e < 8; ++e) { float s = 0.f;
#pragma unroll
                for (int j = 0; j < 4; ++j) { const f32x4 w0 = *(const f32x4*)(WrT + e * D + 8 * lane + 512 * j), w1 = *(const f32x4*)(WrT + e * D + 8 * lane + 512 * j + 4);
#pragma unroll
                    for (int q = 0; q < 4; ++q) s += v[8 * j + q] * w0[q] + v[8 * j + 4 + q] * w1[q]; }
                lg[e] = wave_sum(s); asm volatile("" ::: "memory"); }
            int i1 = 0; float v1 = lg[0];
#pragma unroll
            for (int e = 1; e < 8; ++e) if (lg[e] > v1) { v1 = lg[e]; i1 = e; }
            int i2 = -1; float v2 = -3.0e38f;
#pragma unroll
            for (int e = 0; e < 8; ++e) if (e != i1 && lg[e] > v2) { v2 = lg[e]; i2 = e; }
            const float g1 = 1.0f / (1.0f + expf(v2 - v1)), g2 = 1.0f - g1;
            if (lane == 0) { unsigned* cnt = (unsigned*)(a.ws + WS_CTL) + CW_CNT;
                const unsigned p1 = atomicAdd(cnt + i1, 1u), p2 = atomicAdd(cnt + i2, 1u);
                int* tk = (int*)(a.ws + WS_TOK) + (size_t)row * 8; tk[0] = i1; tk[1] = i2; tk[2] = (int)p1; tk[3] = (int)p2; ((float*)tk)[4] = g1; ((float*)tk)[5] = g2;
                int* lst = (int*)(a.ws + WS_LIST); lst[(i1 << 14) + (int)p1] = row; lst[(i2 << 14) + (int)p2] = row; }
        }
    }
}
DI void moe_y8(const h16* Y, const float* SL, int slot, int col, int pm0, int R, int sp, float (&y)[8]) {
    const int pm = slot >> 8;
    if (pm < pm0) { const h16x8 t = *(const h16x8*)(Y + (size_t)slot * D + col);
#pragma unroll
        for (int q = 0; q < 8; ++q) y[q] = (float)t[q]; }
    else { const int tile = (pm - pm0) * 8 + (col >> 8);
#pragma unroll
        for (int q = 0; q < 8; ++q) y[q] = 0.f;
        for (int ks = 0; ks < sp; ++ks) { const float* p = SL + (size_t)(ks * R + tile) * 65536 + (size_t)(slot & 255) * 256 + (col & 255); const f32x4 t0 = *(const f32x4*)p, t1 = *(const f32x4*)(p + 4);
#pragma unroll
            for (int q = 0; q < 4; ++q) { y[q] += t0[q]; y[4 + q] += t1[q]; } } }
}
DI void final_row_slow(const Args& a, int row, int s1, int s2, float g1, float g2, int pm0, int R, int sp, int lane) {
    const h16* XH = (const h16*)(a.ws + WS_XH); const h16* Y = (const h16*)(a.ws + WS_XG); const float* SL = (const float*)(a.ws + WS_SLAB);
    float v[32];
#pragma unroll
    for (int j = 0; j < 4; ++j) { const int col = 8 * lane + 512 * j; const h16x8 x = *(const h16x8*)(XH + (size_t)row * D + col); float y1[8], y2[8];
        moe_y8(Y, SL, s1, col, pm0, R, sp, y1); moe_y8(Y, SL, s2, col, pm0, R, sp, y2);
#pragma unroll
        for (int q = 0; q < 8; ++q) v[8 * j + q] = ALPHA * (float)x[q] + g1 * y1[q] + g2 * y2[q]; }
    ln_normalize(v, a.in[I_OLNFG], a.in[I_OLNFB], lane);
#pragma unroll
    for (int j = 0; j < 4; ++j) { *(f32x4*)(a.out + (size_t)row * D + 8 * lane + 512 * j) = (f32x4){v[8 * j], v[8 * j + 1], v[8 * j + 2], v[8 * j + 3]}; *(f32x4*)(a.out + (size_t)row * D + 8 * lane + 512 * j + 4) = (f32x4){v[8 * j + 4], v[8 * j + 5], v[8 * j + 6], v[8 * j + 7]}; }
}
DI void phase_final(const Args& a, int pm0, int R, int sp, int t1, int t2, int t3, int t4, int t5, int t6, int t7) {
#define FIN_SLOT(e_, p_) ((((e_) == 1 ? t1 : (e_) == 2 ? t2 : (e_) == 3 ? t3 : (e_) == 4 ? t4 : (e_) == 5 ? t5 : (e_) == 6 ? t6 : (e_) == 7 ? t7 : 0) << 8) + (p_))
    const int tid = threadIdx.x, lane = tid & 63, wave = __builtin_amdgcn_readfirstlane(tid >> 6), gw = blockIdx.x * NWAVES + wave, ngw = gridDim.x * NWAVES;
    const h16* XH = (const h16*)(a.ws + WS_XH); const h16* Y = (const h16*)(a.ws + WS_XG);
    for (int rowA = gw; rowA < M; rowA += 2 * ngw) {
        const int rowB = rowA + ngw < M ? rowA + ngw : rowA;
        const int* tkA = (const int*)(a.ws + WS_TOK) + (size_t)rowA * 8; const int* tkB = (const int*)(a.ws + WS_TOK) + (size_t)rowB * 8;
        const int a1 = FIN_SLOT(tkA[0], tkA[2]), a2 = FIN_SLOT(tkA[1], tkA[3]), b1 = FIN_SLOT(tkB[0], tkB[2]), b2 = FIN_SLOT(tkB[1], tkB[3]); const float ga1 = ((const float*)tkA)[4], ga2 = ((const float*)tkA)[5], gb1 = ((const float*)tkB)[4], gb2 = ((const float*)tkB)[5];
        const bool fast = (a1 >> 8) < pm0 && (a2 >> 8) < pm0 && (b1 >> 8) < pm0 && (b2 >> 8) < pm0;
        if (fast) {
            h16x8 xa[4], ya1[4], ya2[4], xb[4], yb1[4], yb2[4];
#pragma unroll
            for (int j = 0; j < 4; ++j) { const int col = 8 * lane + 512 * j; xa[j] = *(const h16x8*)(XH + (size_t)rowA * D + col); ya1[j] = *(const h16x8*)(Y + (size_t)a1 * D + col); ya2[j] = *(const h16x8*)(Y + (size_t)a2 * D + col);
                xb[j] = *(const h16x8*)(XH + (size_t)rowB * D + col); yb1[j] = *(const h16x8*)(Y + (size_t)b1 * D + col); yb2[j] = *(const h16x8*)(Y + (size_t)b2 * D + col); }
            float v[32];
#pragma unroll
            for (int j = 0; j < 4; ++j)
#pragma unroll
                for (int q = 0; q < 8; ++q) v[8 * j + q] = ALPHA * (float)xa[j][q] + ga1 * (float)ya1[j][q] + ga2 * (float)ya2[j][q];
            ln_normalize(v, a.in[I_OLNFG], a.in[I_OLNFB], lane);
#pragma unroll
            for (int j = 0; j < 4; ++j) { *(f32x4*)(a.out + (size_t)rowA * D + 8 * lane + 512 * j) = (f32x4){v[8 * j], v[8 * j + 1], v[8 * j + 2], v[8 * j + 3]}; *(f32x4*)(a.out + (size_t)rowA * D + 8 * lane + 512 * j + 4) = (f32x4){v[8 * j + 4], v[8 * j + 5], v[8 * j + 6], v[8 * j + 7]}; }
#pragma unroll
            for (int j = 0; j < 4; ++j)
#pragma unroll
                for (int q = 0; q < 8; ++q) v[8 * j + q] = ALPHA * (float)xb[j][q] + gb1 * (float)yb1[j][q] + gb2 * (float)yb2[j][q];
            ln_normalize(v, a.in[I_OLNFG], a.in[I_OLNFB], lane);
            if (rowB != rowA) {
#pragma unroll
                for (int j = 0; j < 4; ++j) { *(f32x4*)(a.out + (size_t)rowB * D + 8 * lane + 512 * j) = (f32x4){v[8 * j], v[8 * j + 1], v[8 * j + 2], v[8 * j + 3]}; *(f32x4*)(a.out + (size_t)rowB * D + 8 * lane + 512 * j + 4) = (f32x4){v[8 * j + 4], v[8 * j + 5], v[8 * j + 6], v[8 * j + 7]}; } }
        } else { final_row_slow(a, rowA, a1, a2, ga1, ga2, pm0, R, sp, lane); if (rowB != rowA) final_row_slow(a, rowB, b1, b2, gb1, gb2, pm0, R, sp, lane); }
    }
#undef FIN_SLOT
}

DI void phase_dilated(const Args& a, char* lds) {
    const int tid = threadIdx.x, lane = tid & 63, w = __builtin_amdgcn_readfirstlane(tid >> 6), g = lane >> 4, lq = lane & 15;
    const h16* H0 = (const h16*)(a.ws + WS_H0); h16* OP = (h16*)(a.ws + WS_OP); float* LSE = (float*)(a.ws + WS_LSE);
    char* Ks = lds; char* Vs = lds + 256 * 272;
    const int chunk = tid & 15, rr = tid >> 4;
    u32x4 kv[8], vv[8]; h16x8 qn[4];
#define DIL_LOAD(u_) do { const int pt_ = (u_) >> 10, rem_ = (u_) & 1023, bh_ = rem_ >> 6, blk_ = rem_ & 63, dsh_ = 2 * pt_, d_ = 1 << dsh_, r_ = blk_ >> (6 - dsh_), m0_ = (blk_ & ((64 >> dsh_) - 1)) * 128; \
        const h16* base_ = H0 + (size_t)((bh_ >> 3) * SEQ) * IN0 + (bh_ & 7) * 128; \
        _Pragma("unroll") for (int p = 0; p < 8; ++p) { const int mm = m0_ - 128 + p * 32 + rr; const int mc = mm >= 0 ? mm : 0; const h16* rp = base_ + (size_t)(mc * d_ + r_) * IN0 + chunk * 8; \
            kv[p] = *(const u32x4*)(rp + 4096); vv[p] = *(const u32x4*)(rp + 5120); if (mm < 0) { kv[p] = (u32x4){0u, 0u, 0u, 0u}; vv[p] = kv[p]; } } \
        const int tq_ = (m0_ + 16 * w + lq) * d_ + r_; \
        _Pragma("unroll") for (int kk = 0; kk < 4; ++kk) qn[kk] = *(const h16x8*)(base_ + (size_t)tq_ * IN0 + 3072 + 32 * kk + 8 * g); } while (0)
    const int G_ = gridDim.x, xg = (G_ % 8 == 0 && 3072 % G_ == 0) ? 1 : 0;
    const int ustart = xg ? ((int)blockIdx.x & 7) * (3072 / 8) + ((int)blockIdx.x >> 3) : (int)blockIdx.x, ustep = xg ? G_ / 8 : G_, uend = xg ? (((int)blockIdx.x & 7) + 1) * (3072 / 8) : 3072;
    __syncthreads();
    if (ustart < uend) DIL_LOAD(ustart);
    for (int u = ustart; u < uend; u += ustep) {
        const int pt = u >> 10, rem = u & 1023, bh = rem >> 6, blk = rem & 63, b = bh >> 3, h = bh & 7;
        const int dsh = 2 * pt, d = 1 << dsh, r = blk >> (6 - dsh), m0 = (blk & ((64 >> dsh) - 1)) * 128;
        LBAR();
#pragma unroll
        for (int p = 0; p < 8; ++p) { const int row = p * 32 + rr; *(u32x4*)(Ks + row * 272 + chunk * 16) = kv[p]; *(u32x4*)(Vs + row * 288 + chunk * 16) = vv[p]; }
        h16x8 qf[4];
#pragma unroll
        for (int kk = 0; kk < 4; ++kk) qf[kk] = qn[kk];
        { const int un = u + ustep < uend ? u + ustep : u; DIL_LOAD(un); }
        const int tq = (m0 + 16 * w + lq) * d + r;
        LBAR();
        f32x4 acc[9];
#pragma unroll
        for (int ti = 0; ti < 9; ++ti) { acc[ti] = (f32x4){0.f, 0.f, 0.f, 0.f};
#pragma unroll
            for (int kk = 0; kk < 4; ++kk) { const h16x8 kf = *(const h16x8*)(Ks + (16 * w + 16 * ti + lq) * 272 + (4 * kk + g) * 16); acc[ti] = MFMA16(kf, qf[kk], acc[ti]); } }
        const int kbase = m0 + 16 * w - 128;
        float mx = -1e30f;
#pragma unroll
        for (int ti = 0; ti < 9; ++ti)
#pragma unroll
            for (int i = 0; i < 4; ++i) { const int kr = 16 * ti + 4 * g + i; const bool valid = (kr >= lq) && (kr <= lq + 128) && (kbase + kr >= 0);
                const float sc = valid ? acc[ti][i] * QK_SCALE : -1e30f; acc[ti][i] = sc; mx = fmaxf(mx, sc); }
        mx = fmaxf(mx, __shfl_xor(mx, 16)); mx = fmaxf(mx, __shfl_xor(mx, 32));
        float sum = 0.f;
#pragma unroll
        for (int ti = 0; ti < 9; ++ti)
#pragma unroll
            for (int i = 0; i < 4; ++i) { const float p = __expf(acc[ti][i] - mx); acc[ti][i] = p; sum += p; }
        sum += __shfl_xor(sum, 16); sum += __shfl_xor(sum, 32);
        const float inv = 1.0f / sum;
        f32x4 o[8];
#pragma unroll
        for (int c = 0; c < 8; ++c) o[c] = (f32x4){0.f, 0.f, 0.f, 0.f};
#pragma unroll
        for (int s = 0; s < 5; ++s) {
            h16x8 pf;
#pragma unroll
            for (int j = 0; j < 4; ++j) { pf[j] = (h16)(acc[2 * s][j] * inv); pf[4 + j] = (s < 4) ? (h16)(acc[(s < 4) ? 2 * s + 1 : 0][j] * inv) : (h16)0.f; }
            const char* vb = Vs + (16 * w + 32 * s + 4 * g + (lq >> 2)) * 288 + (4 * (lq & 3)) * 2;
#pragma unroll
            for (int c = 0; c < 8; ++c) { const h16x4 t0 = trread(vb + c * 32); h16x4 t1 = (h16x4){(h16)0.f, (h16)0.f, (h16)0.f, (h16)0.f}; if (s < 4) t1 = trread(vb + 16 * 288 + c * 32);
                o[c] = MFMA16(mk8(t0, t1), pf, o[c]); }
        }
        h16* op = OP + ((size_t)pt * M + (size_t)(b * SEQ + tq)) * 1024 + h * 128 + 4 * g;
#pragma unroll
        for (int c = 0; c < 8; ++c) { u32x2 wv; wv.x = pkh(o[c][0], o[c][1]); wv.y = pkh(o[c][2], o[c][3]); *(u32x2*)(op + 16 * c) = wv; }
        if (g == 0) LSE[(size_t)(pt * 16 + bh) * SEQ + tq] = mx + __logf(sum);
    }
#undef DIL_LOAD
    __syncthreads();
}
DI void phase_combine(const Args& a) {
    const h16* OP = (const h16*)(a.ws + WS_OP); const float* LSE = (const float*)(a.ws + WS_LSE); h16* O0 = (h16*)(a.ws + WS_O0);
#pragma unroll 4
    for (size_t i = (size_t)blockIdx.x * NT + threadIdx.x; i < (size_t)M * 128; i += (size_t)gridDim.x * NT) {
        const int token = (int)(i >> 7), hc = (int)(i & 127), h = hc >> 4, b = token >> 13, t = token & 8191;
        const float l0 = LSE[(size_t)(0 * 16 + b * 8 + h) * SEQ + t], l1 = LSE[(size_t)(1 * 16 + b * 8 + h) * SEQ + t], l2 = LSE[(size_t)(2 * 16 + b * 8 + h) * SEQ + t];
        const float mx = fmaxf(l0, fmaxf(l1, l2)); float w0 = __expf(l0 - mx), w1 = __expf(l1 - mx), w2 = __expf(l2 - mx); const float inv = 1.0f / (w0 + w1 + w2); w0 *= inv; w1 *= inv; w2 *= inv;
        const size_t off = (size_t)token * 1024 + hc * 8;
        const h16x8 a0 = *(const h16x8*)(OP + off), a1 = *(const h16x8*)(OP + (size_t)M * 1024 + off), a2 = *(const h16x8*)(OP + (size_t)2 * M * 1024 + off);
        float r[8];
#pragma unroll
        for (int j = 0; j < 8; ++j) r[j] = w0 * (float)a0[j] + w1 * (float)a1[j] + w2 * (float)a2[j];
        u32x4 wv; wv.x = pkh(r[0], r[1]); wv.y = pkh(r[2], r[3]); wv.z = pkh(r[4], r[5]); wv.w = pkh(r[6], r[7]);
        *(u32x4*)(O0 + (size_t)token * 2048 + 1024 + hc * 8) = wv;
    }
}

DI void sb_tile(const f32x4& acc, int key0, int tq, int g, int lq, float& R, float (&wout)[4]) {
    float lk[4], lsz[4]; bool past[4];
#pragma unroll
    for (int i = 0; i < 4; ++i) { const int key = key0 + 4 * g + i; const float z = acc[i] * QK_SCALE; past[i] = (key < tq) && (key >= 0);
        const float sp = softplusf_(z); lk[i] = past[i] ? -sp : 0.f; lsz[i] = z - sp; }
    const float suf2 = lk[3], suf1 = suf2 + lk[2], suf0 = suf1 + lk[1], T = suf0 + lk[0];
    float IS = T; float t = __shfl_down(IS, 16); if (g < 3) IS += t; t = __shfl_down(IS, 32); if (g < 2) IS += t;
    const float G = IS - T, total = __shfl(IS, lq);
    const float base = R + G;
    wout[0] = past[0] ? __expf(lsz[0] + base + suf0) : 0.f; wout[1] = past[1] ? __expf(lsz[1] + base + suf1) : 0.f;
    wout[2] = past[2] ? __expf(lsz[2] + base + suf2) : 0.f; wout[3] = past[3] ? __expf(lsz[3] + base) : 0.f;
    R += total;
}
DI void phase_sb(const Args& a, char* lds) {
    const int tid = threadIdx.x, lane = tid & 63, w = __builtin_amdgcn_readfirstlane(tid >> 6), g = lane >> 4, lq = lane & 15;
    const h16* H0 = (const h16*)(a.ws + WS_H0); h16* O0 = (h16*)(a.ws + WS_O0);
    char* Vw = lds + w * 9216;
    const int G_ = gridDim.x, xg = (G_ % 8 == 0 && 1024 % G_ == 0) ? 1 : 0;
    const int bstart = xg ? ((int)blockIdx.x & 7) * 128 + ((int)blockIdx.x >> 3) : (int)blockIdx.x, bstep = xg ? G_ / 8 : G_, bend = xg ? (((int)blockIdx.x & 7) + 1) * 128 : 1024;
    for (int bu = bstart; bu < bend; bu += bstep) { const int wu = bu * NWAVES + w;
        const int bh = wu >> 9, qt = wu & 511, b = bh >> 3, h = bh & 7, q0 = 16 * qt, tq = q0 + lq;
        const h16* base = H0 + (size_t)(b * SEQ) * IN0 + h * 128;
        h16x8 qf[4];
#pragma unroll
        for (int kk = 0; kk < 4; ++kk) qf[kk] = *(const h16x8*)(base + (size_t)tq * IN0 + 32 * kk + 8 * g);
        float R = 0.f; f32x4 o[8];
#pragma unroll
        for (int c = 0; c < 8; ++c) o[c] = (f32x4){0.f, 0.f, 0.f, 0.f};
        for (int sb = q0 - 16; sb > -32; sb -= 32) {
            const int ra = max(sb + lq, 0), rb = sb + 16 + lq;
            h16x8 kfa[4], kfb[4];
#pragma unroll
            for (int kk = 0; kk < 4; ++kk) { kfa[kk] = *(const h16x8*)(base + (size_t)ra * IN0 + 1024 + 32 * kk + 8 * g); kfb[kk] = *(const h16x8*)(base + (size_t)rb * IN0 + 1024 + 32 * kk + 8 * g); }
            u32x4 vr[8];
#pragma unroll
            for (int i = 0; i < 8; ++i) { const int idx = lane + 64 * i, row = idx >> 4, chunk = idx & 15; vr[i] = *(const u32x4*)(base + (size_t)max(sb + row, 0) * IN0 + 2048 + chunk * 8); }
#pragma unroll
            for (int i = 0; i < 8; ++i) { const int idx = lane + 64 * i, row = idx >> 4, chunk = idx & 15; *(u32x4*)(Vw + row * 288 + chunk * 16) = vr[i]; }
            f32x4 accA = (f32x4){0.f, 0.f, 0.f, 0.f}, accB = accA;
#pragma unroll
            for (int kk = 0; kk < 4; ++kk) { accA = MFMA16(kfa[kk], qf[kk], accA); accB = MFMA16(kfb[kk], qf[kk], accB); }
            float wa[4], wb[4];
            sb_tile(accB, sb + 16, tq, g, lq, R, wb);
            sb_tile(accA, sb, tq, g, lq, R, wa);
            h16x8 pf;
#pragma unroll
            for (int j = 0; j < 4; ++j) { pf[j] = (h16)wa[j]; pf[4 + j] = (h16)wb[j]; }
            asm volatile("s_waitcnt lgkmcnt(0)" ::: "memory");
            const char* vb = Vw + (4 * g + (lq >> 2)) * 288 + (4 * (lq & 3)) * 2;
#pragma unroll
            for (int c = 0; c < 8; ++c) { const h16x4 t0 = trread(vb + c * 32), t1 = trread(vb + 16 * 288 + c * 32); o[c] = MFMA16(mk8(t0, t1), pf, o[c]); }
            asm volatile("s_waitcnt lgkmcnt(0)" ::: "memory");
            if (__all(R < -50.0f)) break;
        }
        h16* op = O0 + (size_t)(b * SEQ + tq) * 2048 + h * 128 + 4 * g;
#pragma unroll
        for (int c = 0; c < 8; ++c) { u32x2 wv; wv.x = pkh(o[c][0], o[c][1]); wv.y = pkh(o[c][2], o[c][3]); *(u32x2*)(op + 16 * c) = wv; }
    }
}

DI void phase_gdn_pre(const Args& a, char* lds, int row_lo, int row_hi, int first_block) {
    const int tid = threadIdx.x, lane = tid & 63, wave = tid >> 6, gw = ((int)blockIdx.x - first_block) * NWAVES + wave, ngw = ((int)gridDim.x - first_block) * NWAVES;
    if ((int)blockIdx.x < first_block) return;
    const h16* QKVG = (const h16*)(a.ws + WS_QKVG); const float* LOGIT = (const float*)(a.ws + WS_LOGIT); h16* QKVN = (h16*)(a.ws + WS_QKVN); float* GB = (float*)(a.ws + WS_GB);
    float* cw = (float*)lds;
    __syncthreads();
    for (int i = tid; i < 3072; i += NT) ((f32x4*)cw)[i] = ((const f32x4*)a.in[I_CONVW])[i];
    __syncthreads();
    for (int row = row_lo + gw; row < row_hi; row += ngw) { const int t = row & (SEQ - 1);
        float acc[6][8];
#pragma unroll
        for (int j = 0; j < 6; ++j)
#pragma unroll
            for (int q = 0; q < 8; ++q) acc[j][q] = 0.f;
#pragma unroll
        for (int i = 0; i < 4; ++i) { if (t - 3 + i >= 0) {
#pragma unroll
            for (int j = 0; j < 6; ++j) { const int c8 = 8 * (lane + 64 * j); const h16x8 xv = *(const h16x8*)(QKVG + (size_t)(row - 3 + i) * 4096 + c8);
                const f32x4 w0 = *(const f32x4*)(cw + i * 3072 + c8), w1 = *(const f32x4*)(cw + i * 3072 + c8 + 4);
#pragma unroll
                for (int q = 0; q < 8; ++q) acc[j][q] += (q < 4 ? w0[q & 3] : w1[q & 3]) * (float)xv[q]; } } }
#pragma unroll
        for (int j = 0; j < 6; ++j) { float ss = 0.f;
#pragma unroll
            for (int q = 0; q < 8; ++q) { acc[j][q] = siluf_(acc[j][q]); ss += acc[j][q] * acc[j][q]; }
            if (j < 4) { ss += __shfl_xor(ss, 1); ss += __shfl_xor(ss, 2); ss += __shfl_xor(ss, 4); ss += __shfl_xor(ss, 8); float rinv = 1.0f / sqrtf(ss + 1e-6f); if (j < 2) rinv *= QK_SCALE;
#pragma unroll
                for (int q = 0; q < 8; ++q) acc[j][q] *= rinv; }
            u32x4 wv; wv.x = pkh(acc[j][0], acc[j][1]); wv.y = pkh(acc[j][2], acc[j][3]); wv.z = pkh(acc[j][4], acc[j][5]); wv.w = pkh(acc[j][6], acc[j][7]);
            *(u32x4*)(QKVN + (size_t)row * 3072 + 8 * (lane + 64 * j)) = wv; }
        if (lane < 8) { const float bl = LOGIT[(size_t)row * 16 + lane], al = LOGIT[(size_t)row * 16 + 8 + lane];
            GB[(size_t)row * 16 + lane] = sigmoidf_(bl); GB[(size_t)row * 16 + 8 + lane] = -expf(a.in[I_ALOG][lane]) * softplusf_(al + a.in[I_DTB][lane]); }
    }
}
DI void phase_gdn_local(const Args& a, char* lds) {
    const int tid = threadIdx.x, lane = tid & 63, w = __builtin_amdgcn_readfirstlane(tid >> 6), g = lane >> 4, lq = lane & 15;
    const h16* QKVN = (const h16*)(a.ws + WS_QKVN); const float* GB = (const float*)(a.ws + WS_GB);
    constexpr int TB = 52224;
    int off_lm = 2 * TB, off_gc = 2 * TB + 16384; asm volatile("" : "+v"(off_lm)); asm volatile("" : "+v"(off_gc));
    float* Lm = (float*)(lds + off_lm);
    float* gcb = (float*)(lds + off_gc);
    float* Dinv = gcb + 384;
    int t2 = tid - 256;
    u32x4 pre[6]; float pg = 0.f, pb = 0.f;
#define GL_LOAD(un) do { const int b_ = (un) >> 10, n_ = ((un) >> 3) & 127, h_ = (un) & 7; const size_t row0_ = (size_t)b_ * SEQ + n_ * 64; const int tq_ = t2 + 256; \
        _Pragma("unroll") for (int k = 0; k < 6; ++k) { const int idx = tq_ + 512 * k, part = idx >> 10, r = (idx >> 4) & 63, ch = idx & 15; pre[k] = *(const u32x4*)(QKVN + (row0_ + r) * 3072 + part * 1024 + h_ * 128 + ch * 8); } \
        if (tq_ < 64) { pb = GB[(row0_ + tq_) * 16 + h_]; pg = GB[(row0_ + tq_) * 16 + 8 + h_]; } } while (0)
#define GL_STORE(buf) do { char* tb_ = lds + (buf) * TB; const int tq_ = t2 + 256; \
        _Pragma("unroll") for (int k = 0; k < 6; ++k) { const int idx = tq_ + 512 * k, part = idx >> 10, r = (idx >> 4) & 63, ch = idx & 15; *(u32x4*)(tb_ + part * 17408 + r * 272 + ch * 16) = pre[k]; } \
        if (tq_ < 64) { float s_ = pg; _Pragma("unroll") for (int o = 1; o < 64; o <<= 1) { const float t_ = __shfl_up(s_, o); if (lane >= o) s_ += t_; } \
            float* gq_ = gcb + (buf) * 192; gq_[tq_] = s_; gq_[64 + tq_] = pb; gq_[128 + tq_] = __expf(s_); } } while (0)
    __syncthreads();
    if ((int)blockIdx.x < GUNITS) { GL_LOAD((int)blockIdx.x); GL_STORE(0); }
    int cur = 0;
    for (int unit = blockIdx.x; unit < GUNITS; unit += gridDim.x, cur ^= 1) {
        asm volatile("" : "+v"(t2));
        const char* qh = lds + cur * TB; const char* kh = qh + 17408; const char* vh = qh + 34816;
        const float* gc = gcb + cur * 192; const float* bt = gc + 64; const float* eg = gc + 128;
        LBAR();
        { const int nu_ = unit + (int)gridDim.x < GUNITS ? unit + (int)gridDim.x : unit; GL_LOAD(nu_); }
        { const int which = w >> 2, ti = w & 3; const char* Ah = which ? qh : kh; h16* INTRA = (h16*)(a.ws + WS_GINTRA) + (size_t)unit * 4096;
#pragma unroll
          for (int tj = 0; tj < 4; ++tj) {
              if (tj <= ti) { f32x4 acc = (f32x4){0.f, 0.f, 0.f, 0.f};
#pragma unroll
                  for (int kk = 0; kk < 4; ++kk) { const h16x8 af = *(const h16x8*)(Ah + (16 * ti + lq) * 272 + (4 * kk + g) * 16), bf = *(const h16x8*)(kh + (16 * tj + lq) * 272 + (4 * kk + g) * 16); acc = MFMA16(af, bf, acc); }
#pragma unroll
                  for (int e = 0; e < 4; ++e) { const int i = 16 * ti + 4 * g + e, j = 16 * tj + lq; const float dec = (j <= i) ? __expf(gc[i] - gc[j]) : 0.f;
                      if (which == 0) Lm[i * 64 + j] = (j < i) ? -(acc[e] * bt[i] * dec) : 0.f; else INTRA[i * 64 + j] = (h16)(acc[e] * dec); } }
              else if (which) {
#pragma unroll
                  for (int e = 0; e < 4; ++e) INTRA[(16 * ti + 4 * g + e) * 64 + 16 * tj + lq] = (h16)0.f; } } }
        LBAR();
        if (tid < 256) { const int bb = w, c = lq; float nn[16];
#pragma unroll
            for (int i = 0; i < 16; ++i) { float sacc = (i == c) ? 1.f : 0.f;
#pragma unroll
                for (int j4 = 0; j4 < (i + 3) / 4; ++j4) { const f32x4 l = *(const f32x4*)(Lm + (16 * bb + i) * 64 + 16 * bb + 4 * j4);
#pragma unroll
                    for (int q = 0; q < 4; ++q) if (4 * j4 + q < i) sacc += l[q] * nn[4 * j4 + q]; }
                nn[i] = sacc; if (lane < 16) Dinv[bb * 256 + i * 16 + c] = sacc; } }
        else {
            h16* QD = (h16*)(a.ws + WS_GQD) + (size_t)unit * 8192; h16* KDT = (h16*)(a.ws + WS_GKDT) + (size_t)unit * 8192; const float gl = gc[63];
            for (int it = t2; it < 1024; it += 256) { const int i = it >> 4, c8 = (it & 15) * 8; const float e = eg[i]; const h16x8 qv = *(const h16x8*)(qh + i * 272 + c8 * 2);
                u32x4 wv; wv.x = pkh((float)qv[0] * e, (float)qv[1] * e); wv.y = pkh((float)qv[2] * e, (float)qv[3] * e); wv.z = pkh((float)qv[4] * e, (float)qv[5] * e); wv.w = pkh((float)qv[6] * e, (float)qv[7] * e); *(u32x4*)(QD + i * 128 + c8) = wv; }
            for (int it = t2; it < 1024; it += 256) { const int dk = it & 127, c0 = (it >> 7) * 8; float r[8];
#pragma unroll
                for (int j = 0; j < 8; ++j) r[j] = (float)((const h16*)kh)[(c0 + j) * 136 + dk] * __expf(gl - gc[c0 + j]);
                u32x4 wv; wv.x = pkh(r[0], r[1]); wv.y = pkh(r[2], r[3]); wv.z = pkh(r[4], r[5]); wv.w = pkh(r[6], r[7]); *(u32x4*)(KDT + dk * 64 + c0) = wv; }
            if (t2 == 0) ((float*)(a.ws + WS_GLAST))[unit] = __expf(gl); }
        LBAR();
#pragma unroll
        for (int cc = 0; cc < 2; ++cc) { const int ctile = 2 * w + cc, c = 16 * ctile + lq; const bool isv = ctile < 8; const h16* src = (const h16*)(isv ? vh : kh) + (c & 127);
            h16* dst = (h16*)(a.ws + (isv ? WS_GU : WS_GW)) + (size_t)unit * 8192 + (c & 127);
            f32x4 X[4];
#pragma unroll
            for (int bb = 0; bb < 4; ++bb) { f32x4 T;
#pragma unroll
                for (int i = 0; i < 4; ++i) { const int row = 16 * bb + 4 * g + i; float r = (float)src[row * 136] * bt[row]; if (!isv) r *= eg[row]; T[i] = r; }
#pragma unroll
                for (int b2 = 0; b2 < 4; ++b2) if (b2 < bb) { const f32x4 lv = *(const f32x4*)(Lm + (16 * bb + lq) * 64 + 16 * b2 + 4 * g);
#pragma unroll
                    for (int i = 0; i < 4; ++i) T = __builtin_amdgcn_mfma_f32_16x16x4f32(lv[i], X[b2][i], T, 0, 0, 0); }
                const f32x4 dv = *(const f32x4*)(Dinv + bb * 256 + lq * 16 + 4 * g); f32x4 Xb = (f32x4){0.f, 0.f, 0.f, 0.f};
#pragma unroll
                for (int i = 0; i < 4; ++i) Xb = __builtin_amdgcn_mfma_f32_16x16x4f32(dv[i], T[i], Xb, 0, 0, 0);
                X[bb] = Xb;
#pragma unroll
                for (int i = 0; i < 4; ++i) dst[(16 * bb + 4 * g + i) * 128] = (h16)Xb[i]; } }
        GL_STORE(cur ^ 1);
    }
#undef GL_LOAD
#undef GL_STORE
    __syncthreads();
}

struct GdnRegs { u32x4 rW[2], rQ[2], rI, rK[2]; h16 rU[4]; float rGl; };
DI void gdn_recur_job(const Args& a, char* lds, int job) {
    const int tid = threadIdx.x, lane = tid & 63, w = __builtin_amdgcn_readfirstlane(tid >> 6), g = lane >> 4, lq = lane & 15;
    const int bh = job >> 2, dv0 = (job & 3) * 32, b = bh >> 3, h = bh & 7;
    constexpr int OPB = 62464, O_QD = 17408, O_IN = 34816, O_KDT = 44032, O_SH = 2 * OPB, SHB = 8448, O_VN = O_SH + 2 * SHB;
    int zoff = 0; asm volatile("" : "+v"(zoff)); char* L = lds + zoff;
    const h16* GU = (const h16*)(a.ws + WS_GU); const h16* GW = (const h16*)(a.ws + WS_GW); const h16* GQD = (const h16*)(a.ws + WS_GQD);
    const h16* GKDT = (const h16*)(a.ws + WS_GKDT); const h16* GIN = (const h16*)(a.ws + WS_GINTRA); const float* GLAST = (const float*)(a.ws + WS_GLAST);
    h16* OG = (h16*)(a.ws + WS_OG);
    const int ct = w >> 1, dt = w & 1;
    f32x4 S0 = (f32x4){0.f, 0.f, 0.f, 0.f}, S1 = S0;
    GdnRegs RA, RB;
#define GDN_LOAD(R, nn) do { const size_t un = (size_t)((b * GNCH + (nn)) * 8 + h); \
        _Pragma("unroll") for (int k = 0; k < 2; ++k) { const int idx = tid + 512 * k; R.rW[k] = *(const u32x4*)(GW + un * 8192 + idx * 8); R.rQ[k] = *(const u32x4*)(GQD + un * 8192 + idx * 8); R.rK[k] = *(const u32x4*)(GKDT + un * 8192 + idx * 8); } \
        R.rI = *(const u32x4*)(GIN + un * 4096 + tid * 8); \
        _Pragma("unroll") for (int i = 0; i < 4; ++i) R.rU[i] = GU[un * 8192 + (16 * ct + 4 * g + i) * 128 + dv0 + 16 * dt + lq]; \
        R.rGl = GLAST[un + zoff]; } while (0)
#define GDN_STORE(R, buf) do { char* ob_ = L + (buf) * OPB; \
        _Pragma("unroll") for (int k = 0; k < 2; ++k) { const int idx = tid + 512 * k; *(u32x4*)(ob_ + (idx >> 4) * 272 + (idx & 15) * 16) = R.rW[k]; *(u32x4*)(ob_ + O_QD + (idx >> 4) * 272 + (idx & 15) * 16) = R.rQ[k]; \
            *(u32x4*)(ob_ + O_KDT + (idx >> 3) * 144 + (idx & 7) * 16) = R.rK[k]; } \
        *(u32x4*)(ob_ + O_IN + (tid >> 3) * 144 + (tid & 7) * 16) = R.rI; } while (0)
#define FR8(p) mk8(*(const h16x4*)(p), *(const h16x4*)((p) + 32))
#define GDN_STEP(n, cur, RN, RF) do { \
        const char* ob = L + (cur) * OPB; const char* sh = L + O_SH + (cur) * SHB; char* shn = L + O_SH + ((cur) ^ 1) * SHB; char* VN = L + O_VN; \
        GDN_LOAD(RF, ((n) + 2 < GNCH ? (n) + 2 : GNCH - 1));     \
        f32x4 a0 = (f32x4){0.f, 0.f, 0.f, 0.f}, a1 = a0; \
        _Pragma("unroll") for (int kk = 0; kk < 4; kk += 2) { const char* ap = ob + (16 * ct + lq) * 272 + (32 * kk + 4 * g) * 2; const char* bp = sh + (16 * dt + lq) * 264 + (32 * kk + 4 * g) * 2; \
            a0 = MFMA16(FR8(ap), FR8(bp), a0); a1 = MFMA16(FR8(ap + 64), FR8(bp + 64), a1); } \
        { h16x4 vn; _Pragma("unroll") for (int i = 0; i < 4; ++i) vn[i] = (h16)(uv[i] - (a0[i] + a1[i])); \
          *(h16x4*)(VN + (16 * dt + lq) * 136 + (16 * ct + 4 * g) * 2) = vn; } \
        f32x4 o0 = (f32x4){0.f, 0.f, 0.f, 0.f}, o1 = o0; \
        _Pragma("unroll") for (int kk = 0; kk < 4; kk += 2) { const char* ap = ob + O_QD + (16 * ct + lq) * 272 + (32 * kk + 4 * g) * 2; const char* bp = sh + (16 * dt + lq) * 264 + (32 * kk + 4 * g) * 2; \
            o0 = MFMA16(FR8(ap), FR8(bp), o0); o1 = MFMA16(FR8(ap + 64), FR8(bp + 64), o1); } \
        LBAR(); \
        { const char* ap = ob + O_IN + (16 * ct + lq) * 144 + (4 * g) * 2; const char* bp = VN + (16 * dt + lq) * 136 + (4 * g) * 2; \
          o0 = MFMA16(FR8(ap), FR8(bp), o0); o1 = MFMA16(FR8(ap + 64), FR8(bp + 64), o1); } \
        S0 = S0 * gl; S1 = S1 * gl; \
        _Pragma("unroll") for (int kk = 0; kk < 2; ++kk) { const char* ap = ob + O_KDT + (16 * w + lq) * 144 + (32 * kk + 4 * g) * 2; const h16x8 af = FR8(ap); \
            const char* b0 = VN + (lq) * 136 + (32 * kk + 4 * g) * 2; const char* b1 = VN + (16 + lq) * 136 + (32 * kk + 4 * g) * 2; \
            S0 = MFMA16(af, FR8(b0), S0); S1 = MFMA16(af, FR8(b1), S1); } \
        { h16* op = OG + (size_t)(b * SEQ + (n) * 64 + 16 * ct + 4 * g) * 1024 + h * 128 + dv0 + 16 * dt + lq; \
          _Pragma("unroll") for (int i = 0; i < 4; ++i) op[(size_t)i * 1024] = (h16)(o0[i] + o1[i]); } \
        { h16x4 s0, s1; _Pragma("unroll") for (int i = 0; i < 4; ++i) { s0[i] = (h16)S0[i]; s1[i] = (h16)S1[i]; } \
          *(h16x4*)(shn + (lq) * 264 + (16 * w + 4 * g) * 2) = s0; *(h16x4*)(shn + (16 + lq) * 264 + (16 * w + 4 * g) * 2) = s1; } \
        { GDN_STORE(RN, (cur) ^ 1); _Pragma("unroll") for (int i = 0; i < 4; ++i) uv[i] = (float)RN.rU[i]; gl = RN.rGl; } \
        LBAR(); } while (0)
    __syncthreads();
    GDN_LOAD(RA, 0); GDN_LOAD(RB, 1);
    { const h16x4 z = (h16x4){(h16)0.f, (h16)0.f, (h16)0.f, (h16)0.f}; *(h16x4*)(L + O_SH + (lq) * 264 + (16 * w + 4 * g) * 2) = z; *(h16x4*)(L + O_SH + (16 + lq) * 264 + (16 * w + 4 * g) * 2) = z; }
    GDN_STORE(RA, 0);
    float uv[4];
#pragma unroll
    for (int i = 0; i < 4; ++i) uv[i] = (float)RA.rU[i];
    float gl = RA.rGl;
    LBAR();
    for (int n = 0; n < GNCH; n += 2) { GDN_STEP(n, 0, RB, RA); GDN_STEP(n + 1, 1, RA, RB); }
#undef GDN_LOAD
#undef GDN_STORE
#undef GDN_STEP
#undef FR8
    __syncthreads();
}
DI void s5_scan_job(const Args& a, int j) {
    const int T = j * NT + threadIdx.x, b = T >> 12, g = (T >> 6) & 63, p = T & 63;
    const float dt = expf(a.in[I_LOGDT][g]); const float lre = a.in[I_LAMRE][g * 64 + p], lim = a.in[I_LAMIM][g * 64 + p];
    const float mag = expf(lre * dt); float sn, cs; sincosf(lim * dt, &sn, &cs); float lr = mag * cs, li = mag * sn;
#pragma unroll
    for (int i = 0; i < 5; ++i) { const float nr = lr * lr - li * li, ni = 2.f * lr * li; lr = nr; li = ni; }
    const float* EC = (const float*)(a.ws + WS_EC) + ((size_t)(g * S5N + b * S5NCH)) * 128 + 2 * p;
    h16* UC = (h16*)(a.ws + WS_UCAT) + ((size_t)(g * S5N + b * S5NCH)) * S5K + 512 + 2 * p;
    float cr = 0.f, ci = 0.f;
    for (int c0 = 0; c0 < S5NCH; c0 += 16) { f32x2 e[16];
#pragma unroll
        for (int k = 0; k < 16; ++k) e[k] = *(const f32x2*)(EC + (size_t)(c0 + k) * 128);
#pragma unroll
        for (int k = 0; k < 16; ++k) { *(unsigned*)(UC + (size_t)(c0 + k) * S5K) = pkh(cr, ci); const float nr = lr * cr - li * ci + e[k].x, ni = lr * ci + li * cr + e[k].y; cr = nr; ci = ni; } }
}
DI void phase_gdn_final(const Args& a) {
    const int tid = threadIdx.x, lane = tid & 63, wave = tid >> 6, gw = blockIdx.x * NWAVES + wave, ngw = gridDim.x * NWAVES;
    const h16* OG = (const h16*)(a.ws + WS_OG); const h16* QKVG = (const h16*)(a.ws + WS_QKVG); h16* MIX = (h16*)(a.ws + WS_MIXIN); const float* nw = a.in[I_NORMW] + ((16 * lane) & 127);
    float nwv[16];
#pragma unroll
    for (int j = 0; j < 16; ++j) nwv[j] = nw[j];
    for (int tA = gw; tA < M; tA += 2 * ngw) { const int tB = tA + ngw < M ? tA + ngw : tA;
        h16x8 o[2][2], gt[2][2];
#pragma unroll
        for (int r = 0; r < 2; ++r) { const size_t t = r ? tB : tA;
#pragma unroll
            for (int q = 0; q < 2; ++q) { o[r][q] = *(const h16x8*)(OG + t * 1024 + 16 * lane + 8 * q); gt[r][q] = *(const h16x8*)(QKVG + t * 4096 + 3072 + 16 * lane + 8 * q); } }
#pragma unroll
        for (int r = 0; r < 2; ++r) { const size_t t = r ? tB : tA; float ss = 0.f;
#pragma unroll
            for (int q = 0; q < 2; ++q)
#pragma unroll
                for (int j = 0; j < 8; ++j) { const float v = (float)o[r][q][j]; ss += v * v; }
            ss += __shfl_xor(ss, 1); ss += __shfl_xor(ss, 2); ss += __shfl_xor(ss, 4);
            const float rinv = 1.0f / sqrtf(ss * (1.f / 128.f) + 1e-6f);
            if (r == 0 || tB != tA) {
#pragma unroll
                for (int q = 0; q < 2; ++q) { float y[8];
#pragma unroll
                    for (int j = 0; j < 8; ++j) y[j] = (float)o[r][q][j] * rinv * nwv[8 * q + j] * siluf_((float)gt[r][q][j]);
                    u32x4 wv; wv.x = pkh(y[0], y[1]); wv.y = pkh(y[2], y[3]); wv.z = pkh(y[4], y[5]); wv.w = pkh(y[6], y[7]);
                    *(u32x4*)(MIX + t * 2048 + 1024 + 16 * lane + 8 * q) = wv; } } }
    }
}

DI void phase_logits(const Args& a) {
    const int tid = threadIdx.x, lane = tid & 63, wave = tid >> 6, g = lane >> 4, lq = lane & 15;
    const h16* XH = (const h16*)(a.ws + WS_XH); const h16* WT = (const h16*)(a.ws + WS_WIN1) + (size_t)5120 * D; float* LOGIT = (float*)(a.ws + WS_LOGIT);
    for (int wu = blockIdx.x * NWAVES + wave; wu < M / 16; wu += gridDim.x * NWAVES) {
        const h16* ap = XH + (size_t)(wu * 16 + lq) * D + 8 * g; const h16* bp = WT + (size_t)lq * D + 8 * g;
        f32x4 c0 = (f32x4){0.f, 0.f, 0.f, 0.f}, c1 = c0;
#pragma unroll 2
        for (int k8 = 0; k8 < 64; k8 += 8) { h16x8 af[8], bf[8];
#pragma unroll
            for (int j = 0; j < 8; ++j) { af[j] = *(const h16x8*)(ap + 32 * (k8 + j)); bf[j] = *(const h16x8*)(bp + 32 * (k8 + j)); }
#pragma unroll
            for (int j = 0; j < 8; j += 2) { c0 = MFMA16(af[j], bf[j], c0); c1 = MFMA16(af[j + 1], bf[j + 1], c1); } }
#pragma unroll
        for (int i = 0; i < 4; ++i) LOGIT[(size_t)(wu * 16 + 4 * g + i) * 16 + lq] = c0[i] + c1[i];
    }
}

struct MoeTiles { int tp[9]; int cnt[8]; };
DI MoeTiles moe_tiles(const Args& a) { MoeTiles t; const unsigned* cnt = (const unsigned*)(a.ws + WS_CTL) + CW_CNT; t.tp[0] = 0;
#pragma unroll
    for (int e = 0; e < 8; ++e) { const int c = (int)__builtin_amdgcn_readfirstlane((int)cnt[e]); t.cnt[e] = c; t.tp[e + 1] = t.tp[e] + ((c + 255) >> 8); }
    return t; }
template <class Sched>
DI void moe_fill_toktab(const Args& a, LAS unsigned char* lds, const Sched& S, const MoeTiles& mt) {
    const int tid = threadIdx.x;
    LAS unsigned short* tt = (LAS unsigned short*)(lds + TOKTAB_OFF); LAS int* info = (LAS int*)(lds + TOKTAB_OFF + TOKTAB_UNITS * 512);
    const int* lst = (const int*)(a.ws + WS_LIST);
    __syncthreads();
    if (tid < TOKTAB_UNITS) { pg8::Unit u; int base = 0, rem = 0;
        if (S.next(tid, u)) { int st = 0, cn = 0;
#pragma unroll
            for (int q = 0; q < 8; ++q) if (q == u.grp) { st = mt.tp[q]; cn = mt.cnt[q]; }
            base = (u.grp << 14) + (u.pm - st) * 256; rem = cn - (u.pm - st) * 256; }
        info[2 * tid] = base; info[2 * tid + 1] = rem; }
    __syncthreads();
    int tok[TOKTAB_UNITS / 2];
#pragma unroll
    for (int k = 0; k < TOKTAB_UNITS / 2; ++k) { const int q = tid + NT * k, i = q >> 8, r = q & 255; const int base = info[2 * i], rem = info[2 * i + 1]; tok[k] = lst[base + (r < rem ? r : 0)]; if (r >= rem) tok[k] = 0; }
#pragma unroll
    for (int k = 0; k < TOKTAB_UNITS / 2; ++k) tt[tid + NT * k] = (unsigned short)tok[k];
    __syncthreads();
}

enum { PH_PRO, PH_H0, PH_DIL, PH_SB, PH_WOUT0, PH_LN1, PH_FFUP, PH_FFDN, PH_LN2, PH_WIN1, PH_GPRE, PH_GLOC, PH_REC, PH_S5Y, PH_GLU, PH_WOUT1, PH_LN3, PH_MUP, PH_MDN, PH_FINAL, N_PHASES };
#ifndef SKIP_EC
#define SKIP_EC 0
#endif
#ifndef SKIP_GL
#define SKIP_GL 0
#endif
__global__ void __launch_bounds__(NT, 2) hybrid_fwd(Args args) {
    extern __shared__ __attribute__((aligned(16))) unsigned char lds_raw[];
    char* lds = (char*)lds_raw;
    LAS unsigned char* ldsl = (LAS unsigned char*)lds_raw;
    const int tid = threadIdx.x;
    volatile LAS unsigned* MISC = (volatile LAS unsigned*)(ldsl + MISC_OFF);
    if (tid < 64) MISC[tid] = 0u;
    __syncthreads();
    unsigned char* ws = args.ws;
    XcdBarrier bar; bar.bar = (unsigned*)(ws + WS_CTL) + CW_BAR; bar.x = 0; bar.st = nullptr;
    if (N_LAUNCH_MODE == 1) bar = xcd_barrier_post((unsigned*)(ws + WS_CTL) + CW_BAR, MISC + 8);
    const int lo = args.ph_lo, hi = args.ph_hi, G = gridDim.x, bx = blockIdx.x;
#ifndef PH_MASK
#define PH_MASK 0xFFFFFFFu
#endif
#define IN(k) (((PH_MASK >> (k)) & 1u) && lo <= (k) && (k) < hi)
#define SEAM(k) do { if (IN(k) && IN((k) + 1)) xcd_barrier(bar); } while (0)
#ifndef PROBE_PHASE
#define PROBE_PHASE (-1)
#endif
#ifndef PROBE_REPS
#define PROBE_REPS 2
#endif
#define REP(k) _Pragma("unroll 1") for (int _r = 0; _r < ((PROBE_PHASE == (k)) ? PROBE_REPS : 1); ++_r)
    using namespace pg8;
    h16* XH = (h16*)(ws + WS_XH); h16* P = (h16*)args.out;

    if (IN(PH_PRO)) { REP(PH_PRO) phase_prologue(args, lds); } SEAM(PH_PRO);
    if (IN(PH_H0)) { DenseSched S{XH, (const h16*)(ws + WS_WIN0), D, D, M / 256, IN0 / 256, G, bx}; EpiH E{(h16*)(ws + WS_H0), IN0}; gemm_phase(ldsl, D, S, E); if (PROBE_PHASE == PH_H0) gemm_phase(ldsl, D, S, E); } SEAM(PH_H0);
    if (IN(PH_DIL)) { phase_dilated(args, lds); if (PROBE_PHASE == PH_DIL) phase_dilated(args, lds); } SEAM(PH_DIL);
    if (IN(PH_SB)) { REP(PH_SB) phase_sb(args, lds); phase_combine(args); } SEAM(PH_SB);
    if (IN(PH_WOUT0)) { DenseSched S{(const h16*)(ws + WS_O0), (const h16*)(ws + WS_WOUT0), D, D, M / 256, D / 256, G, bx}; EpiRes E{XH, P, D}; gemm_phase(ldsl, D, S, E); } SEAM(PH_WOUT0);
    if (IN(PH_LN1)) { phase_ln<false>(args, lds, P, args.in[I_ELNMG], args.in[I_ELNMB]); if (PROBE_PHASE == PH_LN1) phase_ln<false>(args, lds, P, args.in[I_ELNMG], args.in[I_ELNMB]); } SEAM(PH_LN1);
    if (IN(PH_FFUP)) { DenseSched S{XH, (const h16*)(ws + WS_WFF13), D, D, M / 256, 2 * DFF / 256, G, bx}; EpiSwiGLU E{(h16*)(ws + WS_HFF), DFF, AQ_DROP}; gemm_phase(ldsl, D, S, E); if (PROBE_PHASE == PH_FFUP) gemm_phase(ldsl, D, S, E); } SEAM(PH_FFUP);
    if (IN(PH_FFDN)) { DenseSched S{(const h16*)(ws + WS_HFF), (const h16*)(ws + WS_WFF2), DFF, DFF, M / 256, D / 256, G, bx}; EpiRes E{XH, P, D}; gemm_phase(ldsl, DFF, S, E); if (PROBE_PHASE == PH_FFDN) { EpiRes E{XH, P, D}; gemm_phase(ldsl, DFF, S, E); } } SEAM(PH_FFDN);
    if (IN(PH_LN2)) { phase_ln<false>(args, lds, P, args.in[I_ELNFG], args.in[I_ELNFB]); } SEAM(PH_LN2);
    if (IN(PH_WIN1)) { DenseSched S{XH, (const h16*)(ws + WS_WIN1), D, D, M / 256, 20, G, bx}; EpiIn1 E{(h16*)(ws + WS_UCAT), (h16*)(ws + WS_QKVG), (float*)(ws + WS_LOGIT)}; gemm_phase(ldsl, D, S, E); phase_logits(args); if (PROBE_PHASE == PH_WIN1) gemm_phase(ldsl, D, S, E); phase_logits(args); } SEAM(PH_WIN1);
    if (IN(PH_GPRE)) { GroupSched S{(const h16*)(ws + WS_UCAT), (const h16*)(ws + WS_EPAD), S5K, 512, 2, 1, 64, G, bx, (size_t)S5N * S5K, (size_t)256 * 512}; EpiEC E{(float*)(ws + WS_EC)}; gemm_phase(ldsl, 512, S, E);
                  if (G == 256) { phase_gdn_pre(args, lds, 0, 10752, 0); phase_gdn_pre(args, lds, 10752, M, 128); }
                  else phase_gdn_pre(args, lds, 0, M, 0); } SEAM(PH_GPRE);
    if (IN(PH_GLOC)) { REP(PH_GLOC) phase_gdn_local(args, lds); } SEAM(PH_GLOC);
    if (IN(PH_REC)) { REP(PH_REC) for (int job = bx; job < 80; job += G) { if (job < 64) gdn_recur_job(args, lds, job); else s5_scan_job(args, job - 64); }
                      if (G > 80) { if (bx >= 80) moe_convert(args, lds, MOE_CONV_LATE, NEXP, (bx - 80) * NWAVES + (tid >> 6), (G - 80) * NWAVES); }
                      else moe_convert(args, lds, MOE_CONV_LATE, NEXP, bx * NWAVES + (tid >> 6), G * NWAVES); } SEAM(PH_REC);
    if (IN(PH_S5Y)) { GroupSched S{(const h16*)(ws + WS_UCAT), (const h16*)(ws + WS_TCAT), S5K, S5K, 2, 2, 64, G, bx, (size_t)S5N * S5K, (size_t)512 * S5K}; EpiS5Y E{(const h16*)(ws + WS_UCAT), args.in[I_SSMD], (h16*)(ws + WS_Z)}; gemm_phase(ldsl, S5K, S, E); if (PROBE_PHASE == PH_S5Y) gemm_phase(ldsl, S5K, S, E);
                  phase_gdn_final(args); } SEAM(PH_S5Y);
    if (IN(PH_GLU)) { DenseSched S{(const h16*)(ws + WS_Z), (const h16*)(ws + WS_WGLU), 1024, 1024, M / 256, 4, G, bx}; EpiGLU E{(const h16*)(ws + WS_Z), args.in[I_GLUB], (h16*)(ws + WS_MIXIN)}; gemm_phase(ldsl, 1024, S, E); if (PROBE_PHASE == PH_S5Y) gemm_phase(ldsl, 1024, S, E); } SEAM(PH_GLU);
    if (IN(PH_WOUT1)) { DenseSched S{(const h16*)(ws + WS_MIXIN), (const h16*)(ws + WS_WOUT1), D, D, M / 256, D / 256, G, bx}; EpiRes E{XH, P, D}; gemm_phase(ldsl, D, S, E); } SEAM(PH_WOUT1);
    if (IN(PH_LN3)) { phase_ln<true>(args, lds, P, args.in[I_OLNMG], args.in[I_OLNMB]); } SEAM(PH_LN3);
    if (IN(PH_MUP)) { const MoeTiles mt = moe_tiles(args); MoeGatherSched S{ws + WS_XQ8, ws + WS_MOE13, D, D, 2 * DFE / 256, G, bx, mt.tp[1], mt.tp[2], mt.tp[3], mt.tp[4], mt.tp[5], mt.tp[6], mt.tp[7], mt.tp[8], 1};
                  moe_fill_toktab(args, ldsl, S, mt);
                  EpiSwiGLU8 E{(unsigned char*)(ws + WS_HMOE), DFE, 1.0f / (X8_SCALE * W8_SCALE)}; gemm_phase8(ldsl, D, S, E); if (PROBE_PHASE == PH_MUP) gemm_phase8(ldsl, D, S, E); } SEAM(PH_MUP);
    if (IN(PH_MDN)) { const MoeTiles mt = moe_tiles(args); const int nMt = mt.tp[8], R = (nMt * 8) % 256, pm0 = nMt - R / 8, sp = tail_split8(R); const float ysc = 1.0f / (H8_SCALE * W8_SCALE);
                  MoeSched S{ws + WS_HMOE, ws + WS_MOE2, DFE, DFE, D / 256, G, bx, mt.tp[1], mt.tp[2], mt.tp[3], mt.tp[4], mt.tp[5], mt.tp[6], mt.tp[7], pm0, 1};
                  EpiHs E{(h16*)(ws + WS_XG), D, ysc}; gemm_phase8(ldsl, DFE, S, E); if (PROBE_PHASE == PH_MDN) gemm_phase8(ldsl, DFE, S, E);
                  TailSched T{ws + WS_HMOE, ws + WS_MOE2, DFE, DFE, D / 256, G, bx, pm0, R, sp, DFE / sp, mt.tp[1], mt.tp[2], mt.tp[3], mt.tp[4], mt.tp[5], mt.tp[6], mt.tp[7], 1};
                  EpiSlab ES{(float*)(ws + WS_SLAB), ysc}; gemm_phase8(ldsl, DFE / sp, T, ES); if (PROBE_PHASE == PH_MDN) gemm_phase8(ldsl, DFE / sp, T, ES); } SEAM(PH_MDN);
    if (IN(PH_FINAL)) { const MoeTiles mt = moe_tiles(args); const int nMt = mt.tp[8], R = (nMt * 8) % 256; phase_final(args, nMt - R / 8, R, tail_split8(R), mt.tp[1], mt.tp[2], mt.tp[3], mt.tp[4], mt.tp[5], mt.tp[6], mt.tp[7]); }
#undef IN
#undef SEAM
}

extern "C" void kernel_launch(void* const* d_in, const int* in_sizes, int n_in, void* d_out, int out_size, void* d_ws, size_t ws_size, hipStream_t stream) {
    static int grid = 0;
    if (grid == 0) {
        if (n_in != 34 || out_size != M * D || ws_size < WS_END) { fprintf(stderr, "kernel_launch: unexpected shapes (n_in %d out %d ws %zu need %zu)\n", n_in, out_size, ws_size, (size_t)WS_END); grid = -1; return; }
        int dev = 0, cus = 0, per_cu = 0;
        if (hipGetDevice(&dev) != hipSuccess || hipDeviceGetAttribute(&cus, hipDeviceAttributeMultiprocessorCount, dev) != hipSuccess) { grid = -1; return; }
        if (hipFuncSetAttribute((const void*)hybrid_fwd, hipFuncAttributeMaxDynamicSharedMemorySize, LDS_BYTES) != hipSuccess) { fprintf(stderr, "kernel_launch: hipFuncSetAttribute failed\n"); grid = -1; return; }
        if (hipOccupancyMaxActiveBlocksPerMultiprocessor(&per_cu, (const void*)hybrid_fwd, NT, LDS_BYTES) != hipSuccess || per_cu < 1) fprintf(stderr, "kernel_launch: occupancy query says %d\n", per_cu);
        (void)hipGetLastError();
        grid = cus;
    }
    if (grid < 0) return;
    (void)hipMemsetAsync((char*)d_ws + WS_CTL, 0, CTL_BYTES, stream);
    Args a{};
    for (int i = 0; i < 34; ++i) a.in[i] = (const float*)d_in[i];
    a.out = (float*)d_out; a.ws = (unsigned char*)d_ws;
#if N_LAUNCH_MODE == 1
    a.ph_lo = 0; a.ph_hi = N_PHASES;
    hipLaunchKernelGGL(hybrid_fwd, dim3(grid), dim3(NT), LDS_BYTES, stream, a);
#else
    for (int p = 0; p < N_PHASES; ++p) { a.ph_lo = p; a.ph_hi = p + 1; hipLaunchKernelGGL(hybrid_fwd, dim3(grid), dim3(NT), LDS_BYTES, stream, a); }
#endif
}
```

```cpp
#include <hip/hip_runtime.h>
#include <stdint.h>
#include <stdio.h>

#define LAS __attribute__((address_space(3)))
#define GAS __attribute__((address_space(1)))
#define DI __device__ __forceinline__
typedef _Float16 h16;
typedef _Float16 h16x2 __attribute__((ext_vector_type(2)));
typedef _Float16 h16x4 __attribute__((ext_vector_type(4)));
typedef _Float16 h16x8 __attribute__((ext_vector_type(8)));
typedef float f32x2 __attribute__((ext_vector_type(2)));
typedef float f32x4 __attribute__((ext_vector_type(4)));
typedef unsigned u32x2 __attribute__((ext_vector_type(2)));
typedef unsigned u32x4 __attribute__((ext_vector_type(4)));
typedef short v4i16_t __attribute__((ext_vector_type(4)));

#ifndef N_LAUNCH_MODE
#define N_LAUNCH_MODE 1
#endif
#ifndef DBG_CHECK
#define DBG_CHECK 0
#endif

constexpr int NT = 512, NWAVES = 8;
constexpr int M = 16384, D = 2048, SEQ = 8192;
constexpr int IN0 = 6144, DFF = 5632, IN1 = 5136, IN1P = 5376, DFE = 7168, NEXP = 8;
constexpr float ALPHA = 1.41421356237309515f;
constexpr float QK_SCALE = 0.08838834764831845f;
constexpr int S5L = 32, S5NCH = SEQ / S5L, S5N = 2 * S5NCH  , S5K = 640  ;
constexpr int GDC = 64, GNCH = SEQ / GDC  , GUNITS = 2 * GNCH * 8  ;
constexpr int XG_ROWS = 2 * M + NEXP * 256;

constexpr size_t MiB = 1u << 20;
constexpr size_t WS_CTL = 0, CTL_BYTES = 1 * MiB;
constexpr size_t WS_MOE13 = 1 * MiB;
constexpr size_t WS_MOE2 = 449 * MiB;
constexpr size_t WS_X = 673 * MiB;
constexpr size_t WS_XH = 801 * MiB;
constexpr size_t WS_WIN0 = 865 * MiB;
constexpr size_t WS_WOUT0 = 889 * MiB;
constexpr size_t WS_WFF13 = 897 * MiB;
constexpr size_t WS_WFF2 = 941 * MiB;
constexpr size_t WS_WIN1 = 963 * MiB;
constexpr size_t WS_WGLU = 984 * MiB;
constexpr size_t WS_WOUT1 = 986 * MiB;
constexpr size_t WS_TCAT = 994 * MiB;
constexpr size_t WS_EPAD = 1034 * MiB;
constexpr size_t WS_SCR = 1050 * MiB;
constexpr size_t WS_END = 1792 * MiB;
constexpr size_t WS_H0 = WS_SCR;
constexpr size_t WS_OP = WS_SCR + 192 * MiB;
constexpr size_t WS_LSE = WS_SCR + 288 * MiB;
constexpr size_t WS_O0 = WS_SCR + 290 * MiB;
constexpr size_t WS_HFF = WS_SCR;
constexpr size_t WS_UCAT = WS_SCR;
constexpr size_t WS_QKVG = WS_SCR + 40 * MiB;
constexpr size_t WS_LOGIT = WS_SCR + 168 * MiB;
constexpr size_t WS_EC = WS_SCR + 169 * MiB;
constexpr size_t WS_GU = WS_SCR + 185 * MiB;
constexpr size_t WS_GW = WS_SCR + 217 * MiB;
constexpr size_t WS_GQD = WS_SCR + 249 * MiB;
constexpr size_t WS_GKDT = WS_SCR + 281 * MiB;
constexpr size_t WS_GINTRA = WS_SCR + 313 * MiB;
constexpr size_t WS_GLAST = WS_SCR + 329 * MiB;
constexpr size_t WS_OG = WS_SCR + 330 * MiB;
constexpr size_t WS_Z = WS_SCR + 362 * MiB;
constexpr size_t WS_MIXIN = WS_SCR + 394 * MiB;
constexpr size_t WS_QKVN = WS_SCR + 458 * MiB;
constexpr size_t WS_GB = WS_SCR + 554 * MiB;
constexpr size_t WS_HMOE = WS_SCR;
constexpr size_t WS_XG = WS_SCR + 476 * MiB;
constexpr size_t WS_TOK = WS_SCR + 612 * MiB;
constexpr size_t WS_SLAB = WS_SCR + 614 * MiB;
static_assert((size_t)XG_ROWS * DFE * 2 <= 476 * MiB && (size_t)XG_ROWS * D * 2 <= 136 * MiB && WS_TOK + 1 * MiB <= WS_END, "moe scratch");
static_assert(WS_SLAB + 64 * MiB <= WS_END && WS_MIXIN + 64 * MiB <= WS_END && WS_O0 + 64 * MiB <= WS_END, "scratch");
constexpr int CW_BAR = 0;
constexpr int CW_CNT = 4096;
constexpr int CW_DBG = 8192;

constexpr int MISC_OFF = 155648;
constexpr int LDS_BYTES = MISC_OFF + 1024;
constexpr int TOKTAB_OFF = 131072, TOKTAB_UNITS = 46;
constexpr size_t WS_XQ8 = WS_SCR + 240 * MiB;
constexpr size_t WS_LIST = WS_TOK + 512 * 1024;

DI unsigned pkh(float a, float b) { f32x2 v = {a, b}; return __builtin_bit_cast(unsigned, __builtin_convertvector(v, h16x2)); }
#ifndef WQ_DROP
#define WQ_DROP 4
#endif
#ifndef AQ_DROP
#define AQ_DROP 2
#endif
DI unsigned pka(float a, float b) { const unsigned u = pkh(a, b); if (AQ_DROP == 0) return u; constexpr unsigned H = (1u << (AQ_DROP - 1)) * 0x00010001u, Mk = ~(((1u << AQ_DROP) - 1u) * 0x00010001u); return (u + H) & Mk; }
DI unsigned rnd_drop(unsigned u, int drop) { if (drop <= 0) return u; const unsigned h = (1u << (drop - 1)) * 0x00010001u, mk = ~(((1u << drop) - 1u) * 0x00010001u); return (u + h) & mk; }
#ifndef WQ_MOE
#define WQ_MOE 5
#endif
#ifndef AQ_MOE
#define AQ_MOE 4
#endif
DI unsigned pkw(float a, float b) { const unsigned u = pkh(a, b); if (WQ_DROP == 0) return u; constexpr unsigned H = (1u << (WQ_DROP - 1)) * 0x00010001u, Mk = ~(((1u << WQ_DROP) - 1u) * 0x00010001u); return (u + H) & Mk; }
DI float wave_sum(float v) {
#pragma unroll
    for (int o = 32; o >= 1; o >>= 1) v += __shfl_xor(v, o);
    return v;
}
DI float fast_rcp(float x) { return __builtin_amdgcn_rcpf(x); }
DI float sigmoidf_(float x) { return fast_rcp(1.0f + __expf(-x)); }
DI float siluf_(float x) { return x * sigmoidf_(x); }
DI float softplusf_(float z) { return fmaxf(z, 0.f) + __logf(1.0f + __expf(-fabsf(z))); }
DI h16x8 mk8(h16x4 a, h16x4 b) { return __builtin_shufflevector(a, b, 0, 1, 2, 3, 4, 5, 6, 7); }
DI h16x4 trread(const char* p) { return __builtin_bit_cast(h16x4, __builtin_amdgcn_ds_read_tr16_b64_v4i16((LAS v4i16_t*)p)); }
#define MFMA16(a, b, c) __builtin_amdgcn_mfma_f32_16x16x32_f16((a), (b), (c), 0, 0, 0)
#define LBAR() do { asm volatile("s_waitcnt lgkmcnt(0)" ::: "memory"); __builtin_amdgcn_s_barrier(); asm volatile("" ::: "memory"); } while (0)

#define XB_TMO      128
#define XB_XCNT(j)  (256  + 64 * (j))
#define XB_XSUB(j)  (1280 + 64 * (j))
#define XB_XGEN(j)  (2304 + 64 * (j))
#define XB_TOP      3328
#define XB_TOPGEN   3392
#define XCD_BAR_WORDS 3456
#define XB_SPIN_CAP (1u << 22)
__device__ __forceinline__ unsigned xb_ld(unsigned* p)              { return __hip_atomic_load(p, __ATOMIC_RELAXED, __HIP_MEMORY_SCOPE_AGENT); }
__device__ __forceinline__ unsigned xb_add(unsigned* p, unsigned v) { return __hip_atomic_fetch_add(p, v, __ATOMIC_RELAXED, __HIP_MEMORY_SCOPE_AGENT); }
__device__ __forceinline__ unsigned xb_xcc_id() { return (unsigned)__builtin_amdgcn_s_getreg((3 << 11) | 20) & 0xFu; }
#define XB_SPIN(cond, bar) do { unsigned _sp = 0; while (cond) { __builtin_amdgcn_s_sleep(1); \
    if ((++_sp & 255u) == 0u) { if (xb_ld(&(bar)[XB_TMO])) break; if (_sp > XB_SPIN_CAP) { atomicAdd(&(bar)[XB_TMO], 1u); break; } } } } while (0)
struct XcdBarrier { unsigned* bar; unsigned x; volatile LAS unsigned* st; };
__device__ __forceinline__ XcdBarrier xcd_barrier_post(unsigned* bar, volatile LAS unsigned* st) {
    XcdBarrier b; b.bar = bar; b.x = xb_xcc_id(); b.st = st;
    if (threadIdx.x == 0) (void)xb_add(&bar[XB_XCNT(b.x)], 1u);
    return b;
}
__device__ __forceinline__ void xcd_barrier_complete(unsigned* bar, unsigned x, unsigned& nloc, unsigned& nx) {
    const unsigned G = gridDim.x * gridDim.y * gridDim.z;
    unsigned sum, cnt, mine, sp = 0u;
    for (;;) {
        sum = 0u; cnt = 0u; mine = 0u;
#pragma unroll
        for (unsigned j = 0; j < 16; ++j) { const unsigned c = xb_ld(&bar[XB_XCNT(j)]); sum += c; cnt += (c > 0u) ? 1u : 0u; mine = (j == x) ? c : mine; }
        if (sum == G) break;
        __builtin_amdgcn_s_sleep(1);
        if ((++sp & 255u) == 0u) { if (xb_ld(&bar[XB_TMO])) break; if (sp > XB_SPIN_CAP) { atomicAdd(&bar[XB_TMO], 1u); break; } }
    }
    nloc = mine > 0u ? mine : 1u; nx = cnt > 0u ? cnt : 1u;
}
__device__ __forceinline__ void xcd_barrier(const XcdBarrier& b) {
    asm volatile("s_waitcnt vmcnt(0)" ::: "memory");
    __syncthreads();
    if (threadIdx.x == 0) {
        unsigned* bar = b.bar;
        __builtin_amdgcn_s_waitcnt(0);
        unsigned nloc = b.st[0], nx = b.st[1];
        if (nloc == 0u) { xcd_barrier_complete(bar, b.x, nloc, nx); b.st[0] = nloc; b.st[1] = nx; }
        const unsigned old = xb_add(&bar[XB_XSUB(b.x)], 1u);
        const unsigned gen = old / nloc;
        if (old + 1u == (gen + 1u) * nloc) {
            __builtin_amdgcn_fence(__ATOMIC_RELEASE, "agent");
            asm volatile("s_waitcnt vmcnt(0)" ::: "memory");
            const unsigned og = xb_add(&bar[XB_TOP], 1u);
            const unsigned tg = og / nx;
            if (og + 1u == (tg + 1u) * nx) xb_add(&bar[XB_TOPGEN], 1u);
            else XB_SPIN(xb_ld(&bar[XB_TOPGEN]) == tg, bar);
            __builtin_amdgcn_fence(__ATOMIC_ACQUIRE, "agent");
            xb_add(&bar[XB_XGEN(b.x)], 1u);
            asm volatile("s_waitcnt vmcnt(0)" ::: "memory");
        } else {
            XB_SPIN(xb_ld(&bar[XB_XGEN(b.x)]) == gen, bar);
            __builtin_amdgcn_fence(__ATOMIC_ACQUIRE, "agent");
            asm volatile("s_waitcnt vmcnt(0)" ::: "memory");
        }
    }
    __syncthreads();
}

namespace pg8 {
constexpr int BM = 256, BK = 64, HALF = 128, HTB = HALF * BK * 2, STAGE_BYTES = 8 * HTB, NXCD = 8, WGM = 8;
__host__ __device__ __forceinline__ int lds_byte(int r, int c) { const int st = (r >> 4) * 2 + (c >> 5), rr = r & 15, cc = c & 31, ob = rr * 64 + cc * 2; return st * 1024 + (ob ^ (((ob >> 9) & 1) << 5)); }
__host__ __device__ __forceinline__ void stage_rc(int b, int& R, int& C) { const int st = b / 1024, sb = b % 1024, swz = sb ^ (((sb >> 9) & 1) << 5); R = (st >> 1) * 16 + swz / 64; C = (st & 1) * 32 + (swz % 64) / 2; }
__host__ __device__ __forceinline__ int perm32(int rho) { const int n = rho >> 4, i = rho & 15; return 8 * (i >> 2) + 4 * n + (i & 3); }
struct Unit { int pm, pn, pc, grp, aux; };
typedef __bf16 bf16x8_t __attribute__((ext_vector_type(8)));
typedef int v8i_t __attribute__((ext_vector_type(8)));
typedef int v4i_t __attribute__((ext_vector_type(4)));
DI v8i_t cat8(h16x8 a, h16x8 b) { const v4i_t x = __builtin_bit_cast(v4i_t, a), y = __builtin_bit_cast(v4i_t, b); return __builtin_shufflevector(x, y, 0, 1, 2, 3, 4, 5, 6, 7); }
template <bool BF16> DI f32x4 mma_op(h16x8 a, h16x8 b, f32x4 c) {
    if constexpr (BF16) return __builtin_amdgcn_mfma_f32_16x16x32_bf16(__builtin_bit_cast(bf16x8_t, a), __builtin_bit_cast(bf16x8_t, b), c, 0, 0, 0);
    else return __builtin_amdgcn_mfma_f32_16x16x32_f16(a, b, c, 0, 0, 0); }

DI bool tile_order(int i, int G, int c, int nM, int nN, int& pm, int& pn) {
    const int nwg = nM * nN; const long L = (long)i * G + c; if (L >= nwg) return false;
    int wgid = (int)L; { const int q = nwg / NXCD, r = nwg % NXCD, xcd = wgid % NXCD, off = wgid / NXCD; wgid = (xcd < r ? xcd * (q + 1) : r * (q + 1) + (xcd - r) * q) + off; }
    const int nig = WGM * nN, gid = wgid / nig, fm = gid * WGM, gsz = (nM - fm) < WGM ? (nM - fm) : WGM;
    pm = fm + ((wgid % nig) % gsz); pn = (wgid % nig) / gsz; return true;
}
struct DenseSched {
    static constexpr bool GATHER = false; const h16* A; const h16* Bt; int lda, ldb, nM, nN, G, c;
    DI bool next(int i, Unit& u) const { int pm, pn; if (!tile_order(i, G, c, nM, nN, pm, pn)) return false; u.pm = pm; u.pn = pn; u.pc = pn; u.grp = 0; return true; }
    DI const char* a_base(const Unit& u) const { return (const char*)A + (size_t)u.pm * 256 * lda * 2; }
    DI const char* b_base(const Unit& u) const { return (const char*)Bt + (size_t)u.pn * 256 * ldb * 2; }
};
struct GroupSched {
    static constexpr bool GATHER = false; const h16* A; const h16* Bt; int lda, ldb, nM, nN, ngrp, G, c; size_t strideA, strideB;
    DI bool next(int i, Unit& u) const { const long L = (long)i * G + c; const int per = nM * nN; if (L >= (long)per * ngrp) return false;
        const int g = (int)L / per, r = (int)L % per; u.grp = g; u.pm = r % nM; u.pn = r / nM; u.pc = u.pn; return true; }
    DI const char* a_base(const Unit& u) const { return (const char*)(A + (size_t)u.grp * strideA) + (size_t)u.pm * 256 * lda * 2; }
    DI const char* b_base(const Unit& u) const { return (const char*)(Bt + (size_t)u.grp * strideB) + (size_t)u.pn * 256 * ldb * 2; }
};
struct MoeSched {
    static constexpr bool GATHER = false; const void* A; const void* Bt; int lda, ldb, nN, G, c; int tp1, tp2, tp3, tp4, tp5, tp6, tp7, tp8; int esz;
    DI bool next(int i, Unit& u) const { int pm, pn; if (!tile_order(i, G, c, tp8, nN, pm, pn)) return false;
        const int e = (pm >= tp1) + (pm >= tp2) + (pm >= tp3) + (pm >= tp4) + (pm >= tp5) + (pm >= tp6) + (pm >= tp7);
        u.pm = pm; u.pc = pn; u.grp = e; u.pn = e * nN + pn; return true; }
    DI const char* a_base(const Unit& u) const { return (const char*)A + (size_t)u.pm * 256 * lda * esz; }
    DI const char* b_base(const Unit& u) const { return (const char*)Bt + (size_t)u.pn * 256 * ldb * esz; }
};

struct MoeGatherSched {
    static constexpr bool GATHER = true; const void* A; const void* Bt; int lda, ldb, nN, G, c; int tp1, tp2, tp3, tp4, tp5, tp6, tp7, tp8; int esz;
    DI bool next(int i, Unit& u) const { int pm, pn; if (!tile_order(i, G, c, tp8, nN, pm, pn)) return false;
        const int e = (pm >= tp1) + (pm >= tp2) + (pm >= tp3) + (pm >= tp4) + (pm >= tp5) + (pm >= tp6) + (pm >= tp7);
        u.pm = pm; u.pc = pn; u.grp = e; u.pn = e * nN + pn; return true; }
    DI const char* a_base(const Unit&) const { return (const char*)A; }
    DI const char* b_base(const Unit& u) const { return (const char*)Bt + (size_t)u.pn * 256 * ldb * esz; }
};
struct TailSched {
    static constexpr bool GATHER = false; const void* A; const void* Bt; int lda, ldb, nN, G, c, pm0, R, s, Ks; int tp1, tp2, tp3, tp4, tp5, tp6, tp7; int esz;
    DI bool next(int i, Unit& u) const { const long L = (long)i * G + c; if (L >= (long)R * s) return false; const int tile = (int)L / s, ks = (int)L % s, pm = pm0 + tile / nN, pn = tile % nN;
        const int e = (pm >= tp1) + (pm >= tp2) + (pm >= tp3) + (pm >= tp4) + (pm >= tp5) + (pm >= tp6) + (pm >= tp7);
        u.pm = pm; u.pc = pn; u.grp = e; u.pn = e * nN + pn; u.aux = ks * R + tile; return true; }
    DI const char* a_base(const Unit& u) const { return (const char*)A + (size_t)u.pm * 256 * lda * esz + (size_t)(u.aux / R) * Ks * esz; }
    DI const char* b_base(const Unit& u) const { return (const char*)Bt + (size_t)u.pn * 256 * ldb * esz + (size_t)(u.aux / R) * Ks * esz; }
};
DI int tail_split8(int R) { const int q = R > 0 ? 256 / R : 0; return q >= 14 ? 14 : q >= 7 ? 7 : q >= 4 ? 4 : q >= 2 ? 2 : 1; }
DI int tail_split(int R) { const int q = R > 0 ? 256 / R : 0; return q >= 28 ? 28 : q >= 14 ? 14 : q >= 8 ? 8 : q >= 7 ? 7 : q >= 4 ? 4 : q >= 2 ? 2 : 1; }

template <class Epi, class Sched, bool BF16 = false>
__device__ __forceinline__ void gemm_phase(LAS unsigned char* lds, const int K, const Sched& S, const Epi& E) {
    const int tid = threadIdx.x, wid = __builtin_amdgcn_readfirstlane(tid >> 6), lane = tid & 63, wr = wid >> 2, wc = wid & 3, fr = lane & 15, fq = lane >> 4;
    const int nt = K / BK; const int lda = S.lda, ldb = S.ldb;
    unsigned voffA[2], voffB[2]; int gR[2], gC[2];
#pragma unroll
    for (int i = 0; i < 2; ++i) { int R, C; stage_rc(tid * 16 + i * 8192, R, C); const int Rb = Epi::PERM ? ((R & ~31) + perm32(R & 31)) : R; gR[i] = R; gC[i] = C;
        voffA[i] = (unsigned)(R * lda + C) * 2u; voffB[i] = (unsigned)(Rb * ldb + C) * 2u; }
    const size_t kstep = (size_t)(BK * 2);
    const size_t hstepA = Sched::GATHER ? (size_t)0 : (size_t)HALF * lda * 2, hstepB = (size_t)HALF * ldb * 2;
    unsigned voC[2][2], voN[2][2];
#define PG8_GOFF(dst, unit_) do { if constexpr (Sched::GATHER) { const LAS unsigned short* tt_ = (const LAS unsigned short*)(lds + TOKTAB_OFF) + (unit_) * 256; _Pragma("unroll") for (int h_ = 0; h_ < 2; ++h_) _Pragma("unroll") for (int i_ = 0; i_ < 2; ++i_) \
        dst[h_][i_] = ((unsigned)tt_[128 * h_ + gR[i_]] * (unsigned)lda + (unsigned)gC[i_]) * 2u; } } while (0)
#define PG8_STAGE_A(b, h, gbase, vset) do { if constexpr (Sched::GATHER) { PG8_STAGE(PG8_SA(b, h), gbase, vset[h]); } else { PG8_STAGE(PG8_SA(b, h), (gbase) + (h) * hstepA, voffA); } } while (0)
    const unsigned ldsw = (unsigned)wid * 1024u;
    const int aoff = lds_byte(wr * 64 + fr, fq * 8), boff = lds_byte(wc * 32 + fr, fq * 8);
#define PG8_SA(b, h) (((b) * 2 + (h)) * HTB)
#define PG8_SB(b, h) ((4 + (b) * 2 + (h)) * HTB)
#define PG8_STAGE(bufoff, gbase, voff) do { _Pragma("unroll") for (int _i = 0; _i < 2; ++_i) \
        __builtin_amdgcn_global_load_lds((const unsigned*)((const char*)(gbase) + (voff)[_i]), (LAS unsigned*)(lds + (bufoff) + ldsw + _i * 8192), 16, 0, 0); } while (0)
#define PG8_LDA(dst, b, h) do { _Pragma("unroll") for (int m = 0; m < 4; ++m) _Pragma("unroll") for (int k = 0; k < 2; ++k) dst[m][k] = *(const LAS h16x8*)(lds + PG8_SA(b, h) + aoff + m * 2048 + k * 1024); } while (0)
#define PG8_LDB(dst, b, h) do { _Pragma("unroll") for (int n = 0; n < 2; ++n) _Pragma("unroll") for (int k = 0; k < 2; ++k) dst[n][k] = *(const LAS h16x8*)(lds + PG8_SB(b, h) + boff + n * 2048 + k * 1024); } while (0)
#define PG8_MMA(ai, bj, At, Bt) do { __builtin_amdgcn_s_setprio(1); _Pragma("unroll") for (int m = 0; m < 4; ++m) _Pragma("unroll") for (int n = 0; n < 2; ++n) _Pragma("unroll") for (int k = 0; k < 2; ++k) \
        acc[ai][bj][m][n] = mma_op<BF16>(Bt[n][k], At[m][k], acc[ai][bj][m][n]); __builtin_amdgcn_s_setprio(0); } while (0)
#define PG8_WAIT_V(n) asm volatile("s_waitcnt vmcnt(" #n ")" ::: "memory")
#define PG8_WAIT_L(n) asm volatile("s_waitcnt lgkmcnt(" #n ")" ::: "memory")
#define PG8_BAR __builtin_amdgcn_s_barrier()
#define PG8_SCHED __builtin_amdgcn_sched_barrier(0)
    Unit cur, nxt; int ui = 0;
    if (!S.next(0, cur)) return;
    f32x4 acc[2][2][4][2];
#pragma unroll
    for (int a = 0; a < 2; ++a)
#pragma unroll
        for (int b = 0; b < 2; ++b)
#pragma unroll
            for (int m = 0; m < 4; ++m)
#pragma unroll
                for (int n = 0; n < 2; ++n) acc[a][b][m][n] = (f32x4){0.f, 0.f, 0.f, 0.f};
    h16x8 At[4][2], B0[2][2], B1[2][2];
    const char* cA = S.a_base(cur); const char* cB = S.b_base(cur);
    PG8_GOFF(voC, 0);
    PG8_STAGE(PG8_SB(0, 0), cB, voffB); PG8_STAGE(PG8_SB(0, 1), cB + hstepB, voffB); PG8_STAGE_A(0, 0, cA, voC); PG8_STAGE_A(0, 1, cA, voC);
    if (wr == 1) PG8_BAR;
    PG8_WAIT_V(2); PG8_BAR;
    PG8_STAGE(PG8_SB(1, 0), cB + kstep, voffB); PG8_STAGE_A(1, 0, cA + kstep, voC); PG8_STAGE(PG8_SB(1, 1), cB + hstepB + kstep, voffB);
    PG8_WAIT_V(6); PG8_BAR;
    for (;;) {
        const bool has_next = S.next(ui + 1, nxt);
        const char* nA = has_next ? S.a_base(nxt) : cA; const char* nB = has_next ? S.b_base(nxt) : cB;
        PG8_GOFF(voN, has_next ? ui + 1 : ui);
        for (int t = 0; t < nt; t += 2) {
            const bool last = (t == nt - 2);
            unsigned vo2[2][2];
            if constexpr (Sched::GATHER) {
#pragma unroll
                for (int h_ = 0; h_ < 2; ++h_)
#pragma unroll
                    for (int i_ = 0; i_ < 2; ++i_) vo2[h_][i_] = last ? voN[h_][i_] : voC[h_][i_]; }
            const char* a1 = cA + (size_t)(t + 1) * kstep;
            const char* a2 = last ? nA : cA + (size_t)(t + 2) * kstep; const char* b2 = last ? nB : cB + (size_t)(t + 2) * kstep;
            const char* a3 = a2 + kstep; const char* b3 = b2 + kstep;
            PG8_LDB(B0, 0, 0); PG8_LDB(B1, 0, 1); PG8_SCHED; PG8_LDA(At, 0, 0); PG8_STAGE_A(1, 1, a1, voC);
            PG8_WAIT_V(8); PG8_WAIT_L(0); PG8_BAR; PG8_MMA(0, 0, At, B0); PG8_MMA(0, 1, At, B1); PG8_BAR; PG8_SCHED;
            PG8_LDA(At, 0, 1); PG8_STAGE(PG8_SB(0, 0), b2, voffB); PG8_STAGE(PG8_SB(0, 1), b2 + hstepB, voffB); PG8_STAGE_A(0, 0, a2, vo2);
            PG8_WAIT_V(8); PG8_WAIT_L(0); PG8_BAR; PG8_MMA(1, 0, At, B0); PG8_MMA(1, 1, At, B1); PG8_BAR; PG8_SCHED;
            PG8_LDB(B0, 1, 0); PG8_LDB(B1, 1, 1); PG8_SCHED; PG8_LDA(At, 1, 0); PG8_STAGE_A(0, 1, a2, vo2);
            PG8_WAIT_V(8); PG8_WAIT_L(0); PG8_BAR; PG8_MMA(0, 0, At, B0); PG8_MMA(0, 1, At, B1); PG8_BAR; PG8_SCHED;
            PG8_LDA(At, 1, 1); PG8_STAGE(PG8_SB(1, 0), b3, voffB); PG8_STAGE(PG8_SB(1, 1), b3 + hstepB, voffB); PG8_STAGE_A(1, 0, a3, vo2);
            PG8_WAIT_V(8); PG8_WAIT_L(0); PG8_BAR; PG8_MMA(1, 0, At, B0); PG8_MMA(1, 1, At, B1); PG8_BAR; PG8_SCHED;
        }
        if (wr == 0) PG8_BAR;
        E(acc, cur, wr, wc, fr, fq);
        if (!has_next) break;
#pragma unroll
        for (int a = 0; a < 2; ++a)
#pragma unroll
            for (int b = 0; b < 2; ++b)
#pragma unroll
                for (int m = 0; m < 4; ++m)
#pragma unroll
                    for (int n = 0; n < 2; ++n) acc[a][b][m][n] = (f32x4){0.f, 0.f, 0.f, 0.f};
        cur = nxt; cA = nA; cB = nB; ++ui;
        if constexpr (Sched::GATHER) {
#pragma unroll
            for (int h_ = 0; h_ < 2; ++h_)
#pragma unroll
                for (int i_ = 0; i_ < 2; ++i_) voC[h_][i_] = voN[h_][i_]; }
        if (wr == 1) PG8_BAR;
    }
    PG8_WAIT_V(0);
    PG8_BAR;
#undef PG8_SA
#undef PG8_GOFF
#undef PG8_STAGE_A
#undef PG8_SB
#undef PG8_STAGE
#undef PG8_LDA
#undef PG8_LDB
#undef PG8_MMA
#undef PG8_WAIT_V
#undef PG8_WAIT_L
#undef PG8_BAR
#undef PG8_SCHED
}
template <class Epi, class Sched>
__device__ __forceinline__ void gemm_phase8(LAS unsigned char* lds, const int K, const Sched& S, const Epi& E) {
    const int tid = threadIdx.x, wid = __builtin_amdgcn_readfirstlane(tid >> 6), lane = tid & 63, wr = wid >> 2, wc = wid & 3, fr = lane & 15, fq = lane >> 4;
    const int nt = K / (2 * BK); const int lda = S.lda, ldb = S.ldb;
    unsigned voffA[2], voffB[2]; int gR[2], gC[2];
#pragma unroll
    for (int i = 0; i < 2; ++i) { int R, C; stage_rc(tid * 16 + i * 8192, R, C); const int Rb = Epi::PERM ? ((R & ~31) + perm32(R & 31)) : R; gR[i] = R; gC[i] = C;
        voffA[i] = (unsigned)(R * lda + C * 2); voffB[i] = (unsigned)(Rb * ldb + C * 2); }
    const size_t kstep = (size_t)(BK * 2);
    const size_t hstepA = Sched::GATHER ? (size_t)0 : (size_t)HALF * lda, hstepB = (size_t)HALF * ldb;
    unsigned voC[2][2], voN[2][2];
#define PG8_GOFF(dst, unit_) do { if constexpr (Sched::GATHER) { const LAS unsigned short* tt_ = (const LAS unsigned short*)(lds + TOKTAB_OFF) + (unit_) * 256; _Pragma("unroll") for (int h_ = 0; h_ < 2; ++h_) _Pragma("unroll") for (int i_ = 0; i_ < 2; ++i_) \
        dst[h_][i_] = (unsigned)tt_[128 * h_ + gR[i_]] * (unsigned)lda + (unsigned)gC[i_] * 2u; } } while (0)
#define PG8_STAGE_A(b, h, gbase, vset) do { if constexpr (Sched::GATHER) { PG8_STAGE(PG8_SA(b, h), gbase, vset[h]); } else { PG8_STAGE(PG8_SA(b, h), (gbase) + (h) * hstepA, voffA); } } while (0)
    const unsigned ldsw = (unsigned)wid * 1024u;
    const int aoff = lds_byte(wr * 64 + fr, fq * 8), boff = lds_byte(wc * 32 + fr, fq * 8);
    int sc127 = 127; asm volatile("" : "+v"(sc127));
#define PG8_SA(b, h) (((b) * 2 + (h)) * HTB)
#define PG8_SB(b, h) ((4 + (b) * 2 + (h)) * HTB)
#define PG8_STAGE(bufoff, gbase, voff) do { _Pragma("unroll") for (int _i = 0; _i < 2; ++_i) \
        __builtin_amdgcn_global_load_lds((const unsigned*)((const char*)(gbase) + (voff)[_i]), (LAS unsigned*)(lds + (bufoff) + ldsw + _i * 8192), 16, 0, 0); } while (0)
#define PG8_LDA(dst, b, h) do { _Pragma("unroll") for (int m = 0; m < 4; ++m) _Pragma("unroll") for (int k = 0; k < 2; ++k) dst[m][k] = *(const LAS h16x8*)(lds + PG8_SA(b, h) + aoff + m * 2048 + k * 1024); } while (0)
#define PG8_LDB(dst, b, h) do { _Pragma("unroll") for (int n = 0; n < 2; ++n) _Pragma("unroll") for (int k = 0; k < 2; ++k) dst[n][k] = *(const LAS h16x8*)(lds + PG8_SB(b, h) + boff + n * 2048 + k * 1024); } while (0)
#define PG8_MMA(ai, bj, At, Bt) do { __builtin_amdgcn_s_setprio(1); _Pragma("unroll") for (int m = 0; m < 4; ++m) _Pragma("unroll") for (int n = 0; n < 2; ++n) \
        asm volatile("v_mfma_scale_f32_16x16x128_f8f6f4 %0, %1, %2, %0, %3, %3 op_sel_hi:[0,0,0]" : "+v"(acc[ai][bj][m][n]) : "v"(cat8(Bt[n][0], Bt[n][1])), "v"(cat8(At[m][0], At[m][1])), "v"(sc127)); \
        __builtin_amdgcn_s_setprio(0); } while (0)
#define PG8_WAIT_V(n) asm volatile("s_waitcnt vmcnt(" #n ")" ::: "memory")
#define PG8_WAIT_L(n) asm volatile("s_waitcnt lgkmcnt(" #n ")" ::: "memory")
#define PG8_BAR __builtin_amdgcn_s_barrier()
#define PG8_SCHED __builtin_amdgcn_sched_barrier(0)
    Unit cur, nxt; int ui = 0;
    if (!S.next(0, cur)) return;
    f32x4 acc[2][2][4][2];
#pragma unroll
    for (int a = 0; a < 2; ++a)
#pragma unroll
        for (int b = 0; b < 2; ++b)
#pragma unroll
            for (int m = 0; m < 4; ++m)
#pragma unroll
                for (int n = 0; n < 2; ++n) acc[a][b][m][n] = (f32x4){0.f, 0.f, 0.f, 0.f};
    h16x8 At[4][2], B0[2][2], B1[2][2];
    const char* cA = S.a_base(cur); const char* cB = S.b_base(cur);
    PG8_GOFF(voC, 0);
    PG8_STAGE(PG8_SB(0, 0), cB, voffB); PG8_STAGE(PG8_SB(0, 1), cB + hstepB, voffB); PG8_STAGE_A(0, 0, cA, voC); PG8_STAGE_A(0, 1, cA, voC);
    if (wr == 1) PG8_BAR;
    PG8_WAIT_V(2); PG8_BAR;
    PG8_STAGE(PG8_SB(1, 0), cB + kstep, voffB); PG8_STAGE_A(1, 0, cA + kstep, voC); PG8_STAGE(PG8_SB(1, 1), cB + hstepB + kstep, voffB);
    PG8_WAIT_V(6); PG8_BAR;
    for (;;) {
        const bool has_next = S.next(ui + 1, nxt);
        const char* nA = has_next ? S.a_base(nxt) : cA; const char* nB = has_next ? S.b_base(nxt) : cB;
        PG8_GOFF(voN, has_next ? ui + 1 : ui);
        for (int t = 0; t < nt; t += 2) {
            const bool last = (t == nt - 2);
            unsigned vo2[2][2];
            if constexpr (Sched::GATHER) {
#pragma unroll
                for (int h_ = 0; h_ < 2; ++h_)
#pragma unroll
                    for (int i_ = 0; i_ < 2; ++i_) vo2[h_][i_] = last ? voN[h_][i_] : voC[h_][i_]; }
            const char* a1 = cA + (size_t)(t + 1) * kstep;
            const char* a2 = last ? nA : cA + (size_t)(t + 2) * kstep; const char* b2 = last ? nB : cB + (size_t)(t + 2) * kstep;
            const char* a3 = a2 + kstep; const char* b3 = b2 + kstep;
            PG8_LDB(B0, 0, 0); PG8_LDB(B1, 0, 1); PG8_SCHED; PG8_LDA(At, 0, 0); PG8_STAGE_A(1, 1, a1, voC);
            PG8_WAIT_V(8); PG8_WAIT_L(0); PG8_BAR; PG8_MMA(0, 0, At, B0); PG8_MMA(0, 1, At, B1); PG8_BAR; PG8_SCHED;
            PG8_LDA(At, 0, 1); PG8_STAGE(PG8_SB(0, 0), b2, voffB); PG8_STAGE(PG8_SB(0, 1), b2 + hstepB, voffB); PG8_STAGE_A(0, 0, a2, vo2);
            PG8_WAIT_V(8); PG8_WAIT_L(0); PG8_BAR; PG8_MMA(1, 0, At, B0); PG8_MMA(1, 1, At, B1); PG8_BAR; PG8_SCHED;
            PG8_LDB(B0, 1, 0); PG8_LDB(B1, 1, 1); PG8_SCHED; PG8_LDA(At, 1, 0); PG8_STAGE_A(0, 1, a2, vo2);
            PG8_WAIT_V(8); PG8_WAIT_L(0); PG8_BAR; PG8_MMA(0, 0, At, B0); PG8_MMA(0, 1, At, B1); PG8_BAR; PG8_SCHED;
            PG8_LDA(At, 1, 1); PG8_STAGE(PG8_SB(1, 0), b3, voffB); PG8_STAGE(PG8_SB(1, 1), b3 + hstepB, voffB); PG8_STAGE_A(1, 0, a3, vo2);
            PG8_WAIT_V(8); PG8_WAIT_L(0); PG8_BAR; PG8_MMA(1, 0, At, B0); PG8_MMA(1, 1, At, B1); PG8_BAR; PG8_SCHED;
        }
        if (wr == 0) PG8_BAR;
        asm volatile("s_nop 15\n\ts_nop 15\n\ts_nop 15" ::: "memory");
#pragma unroll
        for (int ai_ = 0; ai_ < 2; ++ai_)
#pragma unroll
            for (int bj_ = 0; bj_ < 2; ++bj_) asm volatile("" : "+v"(acc[ai_][bj_][0][0]), "+v"(acc[ai_][bj_][0][1]), "+v"(acc[ai_][bj_][1][0]), "+v"(acc[ai_][bj_][1][1]), "+v"(acc[ai_][bj_][2][0]), "+v"(acc[ai_][bj_][2][1]), "+v"(acc[ai_][bj_][3][0]), "+v"(acc[ai_][bj_][3][1]));
        E(acc, cur, wr, wc, fr, fq);
        if (!has_next) break;
#pragma unroll
        for (int a = 0; a < 2; ++a)
#pragma unroll
            for (int b = 0; b < 2; ++b)
#pragma unroll
                for (int m = 0; m < 4; ++m)
#pragma unroll
                    for (int n = 0; n < 2; ++n) acc[a][b][m][n] = (f32x4){0.f, 0.f, 0.f, 0.f};
        cur = nxt; cA = nA; cB = nB; ++ui;
        if constexpr (Sched::GATHER) {
#pragma unroll
            for (int h_ = 0; h_ < 2; ++h_)
#pragma unroll
                for (int i_ = 0; i_ < 2; ++i_) voC[h_][i_] = voN[h_][i_]; }
        if (wr == 1) PG8_BAR;
    }
    PG8_WAIT_V(0);
    PG8_BAR;
#undef PG8_GOFF
#undef PG8_STAGE_A
#undef PG8_SA
#undef PG8_SB
#undef PG8_STAGE
#undef PG8_LDA
#undef PG8_LDB
#undef PG8_MMA
#undef PG8_WAIT_V
#undef PG8_WAIT_L
#undef PG8_BAR
#undef PG8_SCHED
}

#define EPI_ARGS const f32x4 (&acc)[2][2][4][2], const Unit& u, int wr, int wc, int fr, int fq
struct EpiH {
    static constexpr bool PERM = true;
    h16* O; int ldc;
    DI void operator()(EPI_ARGS) const {
        const int row0 = u.pm * 256 + wr * 64 + fr, col0 = u.pc * 256 + wc * 32 + 8 * fq;
#pragma unroll
        for (int ai = 0; ai < 2; ++ai)
#pragma unroll
            for (int m = 0; m < 4; ++m) { h16* rowp = O + (size_t)(row0 + ai * 128 + m * 16) * ldc + col0;
#pragma unroll
                for (int bj = 0; bj < 2; ++bj) { const f32x4 v0 = acc[ai][bj][m][0], v1 = acc[ai][bj][m][1];
                    u32x4 w; w.x = pkh(v0[0], v0[1]); w.y = pkh(v0[2], v0[3]); w.z = pkh(v1[0], v1[1]); w.w = pkh(v1[2], v1[3]);
                    *(u32x4*)(rowp + bj * 128) = w; } }
    }
};
struct EpiRes {
    static constexpr bool PERM = true;
    const h16* R; h16* O; int ldc;
    DI void operator()(EPI_ARGS) const {
        const int row0 = u.pm * 256 + wr * 64 + fr, col0 = u.pc * 256 + wc * 32 + 8 * fq;
#pragma unroll
        for (int ai = 0; ai < 2; ++ai)
#pragma unroll
            for (int m = 0; m < 4; ++m) { const size_t off = (size_t)(row0 + ai * 128 + m * 16) * ldc + col0;
#pragma unroll
                for (int bj = 0; bj < 2; ++bj) { const h16x8 r = *(const h16x8*)(R + off + bj * 128); const f32x4 v0 = acc[ai][bj][m][0], v1 = acc[ai][bj][m][1];
                    u32x4 w; w.x = pkh(ALPHA * (float)r[0] + v0[0], ALPHA * (float)r[1] + v0[1]); w.y = pkh(ALPHA * (float)r[2] + v0[2], ALPHA * (float)r[3] + v0[3]);
                    w.z = pkh(ALPHA * (float)r[4] + v1[0], ALPHA * (float)r[5] + v1[1]); w.w = pkh(ALPHA * (float)r[6] + v1[2], ALPHA * (float)r[7] + v1[3]);
                    *(u32x4*)(O + off + bj * 128) = w; }
                asm volatile("" ::: "memory"); }
    }
};
struct EpiSwiGLU {
    static constexpr bool PERM = true;
    h16* O; int ldc; int drop;
    DI void operator()(EPI_ARGS) const {
        const int row0 = u.pm * 256 + wr * 64 + fr, col0 = u.pc * 128 + wc * 32 + 8 * fq;
#pragma unroll
        for (int ai = 0; ai < 2; ++ai)
#pragma unroll
            for (int m = 0; m < 4; ++m) { h16* rowp = O + (size_t)(row0 + ai * 128 + m * 16) * ldc + col0;
                float r[8];
#pragma unroll
                for (int n = 0; n < 2; ++n)
#pragma unroll
                    for (int j = 0; j < 4; ++j) { const float g = acc[ai][0][m][n][j], up = acc[ai][1][m][n][j]; r[n * 4 + j] = siluf_(g) * up; }
                u32x4 w; w.x = rnd_drop(pkh(r[0], r[1]), drop); w.y = rnd_drop(pkh(r[2], r[3]), drop); w.z = rnd_drop(pkh(r[4], r[5]), drop); w.w = rnd_drop(pkh(r[6], r[7]), drop);
                *(u32x4*)rowp = w; }
    }
};
struct EpiIn1 {
    static constexpr bool PERM = true;
    h16* Ucat; h16* QKVG; float* LOGIT;
    DI void operator()(EPI_ARGS) const {
        const int row0 = u.pm * 256 + wr * 64 + fr;
#pragma unroll
        for (int ai = 0; ai < 2; ++ai)
#pragma unroll
            for (int m = 0; m < 4; ++m) { const int row = row0 + ai * 128 + m * 16;
#pragma unroll
                for (int bj = 0; bj < 2; ++bj) { const int col = u.pc * 256 + bj * 128 + wc * 32 + 8 * fq; const f32x4 v0 = acc[ai][bj][m][0], v1 = acc[ai][bj][m][1];
                    u32x4 w; w.x = pkh(v0[0], v0[1]); w.y = pkh(v0[2], v0[3]); w.z = pkh(v1[0], v1[1]); w.w = pkh(v1[2], v1[3]);
                    if (u.pc < 4) { const int g = col >> 4, hh = col & 15, b = row >> 13, t = row & 8191, ch = t >> 5, sg = t & 31;
                        *(u32x4*)(Ucat + ((size_t)(g * S5N + b * S5NCH + ch) * S5K + sg * 16 + hh)) = w; }
                    else { *(u32x4*)(QKVG + (size_t)row * 4096 + (col - 1024)) = w; } } }
    }
};
struct EpiS5Y {
    static constexpr bool PERM = true;
    const h16* Ucat; const float* Dskip; h16* Z;
    DI void operator()(EPI_ARGS) const {
        const int g = u.grp;
#pragma unroll
        for (int bj = 0; bj < 2; ++bj) { const int col = u.pc * 256 + bj * 128 + wc * 32 + 8 * fq, tau = col >> 4, hh = col & 15;
            const f32x4 d0 = *(const f32x4*)(Dskip + g * 16 + hh), d1 = *(const f32x4*)(Dskip + g * 16 + hh + 4);
#pragma unroll
            for (int ai = 0; ai < 2; ++ai)
#pragma unroll
                for (int m = 0; m < 4; ++m) { const int n = u.pm * 256 + ai * 128 + wr * 64 + m * 16 + fr, b = n >> 8, ch = n & 255;
                    const h16x8 uv = *(const h16x8*)(Ucat + ((size_t)(g * S5N + n) * S5K + col));
                    const f32x4 v0 = acc[ai][bj][m][0], v1 = acc[ai][bj][m][1]; float r[8];
#pragma unroll
                    for (int j = 0; j < 8; ++j) { const float a = (j < 4 ? v0[j & 3] : v1[j & 3]), dd = (j < 4 ? d0[j & 3] : d1[j & 3]); const float y = a + dd * (float)uv[j];
                        r[j] = y * fast_rcp(1.0f + __expf(-1.5957691216057308f * (y + 0.044715f * y * y * y))); }
                    u32x4 w; w.x = pkh(r[0], r[1]); w.y = pkh(r[2], r[3]); w.z = pkh(r[4], r[5]); w.w = pkh(r[6], r[7]);
                    *(u32x4*)(Z + (size_t)(b * SEQ + ch * S5L + tau) * 1024 + g * 16 + hh) = w; } }
    }
};
struct EpiGLU {
    static constexpr bool PERM = true;
    const h16* Z; const float* bias; h16* O;
    DI void operator()(EPI_ARGS) const {
        const int row0 = u.pm * 256 + wr * 64 + fr;
#pragma unroll
        for (int bj = 0; bj < 2; ++bj) { const int col = u.pc * 256 + bj * 128 + wc * 32 + 8 * fq;
            const f32x4 b0 = *(const f32x4*)(bias + col), b1 = *(const f32x4*)(bias + col + 4);
#pragma unroll
            for (int ai = 0; ai < 2; ++ai)
#pragma unroll
                for (int m = 0; m < 4; ++m) { const int row = row0 + ai * 128 + m * 16;
                    const h16x8 zv = *(const h16x8*)(Z + (size_t)row * 1024 + col);
                    const f32x4 v0 = acc[ai][bj][m][0], v1 = acc[ai][bj][m][1]; float r[8];
#pragma unroll
                    for (int j = 0; j < 8; ++j) { const float a = (j < 4 ? v0[j & 3] + b0[j & 3] : v1[j & 3] + b1[j & 3]); r[j] = (float)zv[j] * sigmoidf_(a); }
                    u32x4 w; w.x = pkh(r[0], r[1]); w.y = pkh(r[2], r[3]); w.z = pkh(r[4], r[5]); w.w = pkh(r[6], r[7]);
                    *(u32x4*)(O + (size_t)row * 2048 + col) = w; } }
    }
};
struct EpiEC {
    static constexpr bool PERM = false;
    float* EC;
    DI void operator()(EPI_ARGS) const {
        const int g = u.grp, col0 = wc * 32 + 4 * fq;
#pragma unroll
        for (int ai = 0; ai < 2; ++ai)
#pragma unroll
            for (int m = 0; m < 4; ++m) { const int n = u.pm * 256 + ai * 128 + wr * 64 + m * 16 + fr; float* rowp = EC + ((size_t)(g * S5N + n)) * 128 + col0;
#pragma unroll
                for (int nn = 0; nn < 2; ++nn) *(f32x4*)(rowp + nn * 16) = acc[ai][0][m][nn]; }
    }
};
DI unsigned pk_fp8x4(float a, float b, float c, float d) {
    a = fminf(fmaxf(a, -448.f), 448.f); b = fminf(fmaxf(b, -448.f), 448.f); c = fminf(fmaxf(c, -448.f), 448.f); d = fminf(fmaxf(d, -448.f), 448.f);
    unsigned w = 0u; w = __builtin_amdgcn_cvt_pk_fp8_f32(a, b, w, false); w = __builtin_amdgcn_cvt_pk_fp8_f32(c, d, w, true); return w; }
constexpr float H8_SCALE = 8.0f, W8_SCALE = 256.0f, X8_SCALE = 16.0f;
struct EpiSwiGLU8 {
    static constexpr bool PERM = true;
    unsigned char* O; int ldc; float isc;
    DI void operator()(EPI_ARGS) const {
        const int row0 = u.pm * 256 + wr * 64 + fr, col0 = u.pc * 128 + wc * 32 + 8 * fq;
#pragma unroll
        for (int ai = 0; ai < 2; ++ai)
#pragma unroll
            for (int m = 0; m < 4; ++m) { unsigned char* rowp = O + (size_t)(row0 + ai * 128 + m * 16) * ldc + col0;
                float r[8];
#pragma unroll
                for (int n = 0; n < 2; ++n)
#pragma unroll
                    for (int j = 0; j < 4; ++j) { const float g = acc[ai][0][m][n][j] * isc, up = acc[ai][1][m][n][j] * isc; r[n * 4 + j] = H8_SCALE * siluf_(g) * up; }
                u32x2 w; w.x = pk_fp8x4(r[0], r[1], r[2], r[3]); w.y = pk_fp8x4(r[4], r[5], r[6], r[7]);
                *(u32x2*)rowp = w; }
    }
};
struct EpiHs {
    static constexpr bool PERM = true;
    h16* O; int ldc; float scale;
    DI void operator()(EPI_ARGS) const {
        const int row0 = u.pm * 256 + wr * 64 + fr, col0 = u.pc * 256 + wc * 32 + 8 * fq;
#pragma unroll
        for (int ai = 0; ai < 2; ++ai)
#pragma unroll
            for (int m = 0; m < 4; ++m) { h16* rowp = O + (size_t)(row0 + ai * 128 + m * 16) * ldc + col0;
#pragma unroll
                for (int bj = 0; bj < 2; ++bj) { const f32x4 v0 = acc[ai][bj][m][0] * scale, v1 = acc[ai][bj][m][1] * scale;
                    u32x4 w; w.x = pkh(v0[0], v0[1]); w.y = pkh(v0[2], v0[3]); w.z = pkh(v1[0], v1[1]); w.w = pkh(v1[2], v1[3]);
                    *(u32x4*)(rowp + bj * 128) = w; } }
    }
};
struct EpiSlab {
    static constexpr bool PERM = false;
    float* SL; float scale;
    DI void operator()(EPI_ARGS) const {
        float* base = SL + (size_t)u.aux * 65536 + (size_t)(wr * 64 + fr) * 256 + wc * 32 + 4 * fq;
#pragma unroll
        for (int ai = 0; ai < 2; ++ai)
#pragma unroll
            for (int m = 0; m < 4; ++m)
#pragma unroll
                for (int bj = 0; bj < 2; ++bj)
#pragma unroll
                    for (int n = 0; n < 2; ++n) *(f32x4*)(base + (size_t)(ai * 128 + m * 16) * 256 + bj * 128 + n * 16) = acc[ai][bj][m][n] * scale;
    }
};
}

struct Args { const float* in[34]; float* out; unsigned char* ws; int ph_lo, ph_hi; };
enum { I_X = 0, I_EWIN, I_EWOUT, I_ELNMG, I_ELNMB, I_EW1, I_EW3, I_EW2, I_ELNFG, I_ELNFB, I_OWIN, I_LAMRE, I_LAMIM, I_LOGDT, I_BRE, I_BIM, I_CRE, I_CIM, I_SSMD,
       I_GLUW, I_GLUB, I_CONVW, I_ALOG, I_DTB, I_NORMW, I_OWOUT, I_OLNMG, I_OLNMB, I_ROUTER, I_MW1, I_MW3, I_MW2, I_OLNFG, I_OLNFB };

DI void tr_item(const float* W, int N, int k0, int n0, h16* WT, size_t drow0, int ldd, float* scr, int lane, int drop) {
    const int c4 = (lane & 15) * 4, r4 = lane >> 4;
    f32x4 v[16];
#pragma unroll
    for (int i = 0; i < 16; ++i) { const int kk = 4 * i + r4, col = n0 + c4; v[i] = (col < N) ? *(const f32x4*)(W + (size_t)(k0 + kk) * N + col) : (f32x4){0.f, 0.f, 0.f, 0.f}; }
#pragma unroll
    for (int i = 0; i < 16; ++i) { float* s = scr + (4 * i + r4) * 65 + c4; s[0] = v[i][0]; s[1] = v[i][1]; s[2] = v[i][2]; s[3] = v[i][3]; }
    asm volatile("s_waitcnt lgkmcnt(0)" ::: "memory");
    const int c = lane & 7, nb = lane >> 3;
#pragma unroll
    for (int j = 0; j < 8; ++j) { const int n = nb + 8 * j; const float* s = scr + (8 * c) * 65 + n;
        u32x4 o; o.x = rnd_drop(pkh(s[0], s[65]), drop); o.y = rnd_drop(pkh(s[130], s[195]), drop); o.z = rnd_drop(pkh(s[260], s[325]), drop); o.w = rnd_drop(pkh(s[390], s[455]), drop);
        *(u32x4*)(WT + (drow0 + n) * (size_t)ldd + k0 + 8 * c) = o; }
    asm volatile("s_waitcnt lgkmcnt(0)" ::: "memory");
}
DI void tr_item8(const float* W, int N, int k0, int n0, unsigned char* WT, size_t drow0, int ldd, float* scr, int lane) {
    const int c4 = (lane & 7) * 4, r8 = lane >> 3;
    f32x4 v[16];
#pragma unroll
    for (int i = 0; i < 16; ++i) v[i] = *(const f32x4*)(W + (size_t)(k0 + 8 * i + r8) * N + n0 + c4);
#pragma unroll
    for (int i = 0; i < 16; ++i) { float* s = scr + (8 * i + r8) * 33 + c4; s[0] = v[i][0]; s[1] = v[i][1]; s[2] = v[i][2]; s[3] = v[i][3]; }
    asm volatile("s_waitcnt lgkmcnt(0)" ::: "memory");
    const int c = lane & 7, nb = lane >> 3;
#pragma unroll
    for (int j = 0; j < 4; ++j) { const int n = nb + 8 * j; const float* s = scr + (16 * c) * 33 + n; const float ws_ = pg8::W8_SCALE;
        u32x4 o; o.x = pg8::pk_fp8x4(s[0] * ws_, s[33] * ws_, s[66] * ws_, s[99] * ws_); o.y = pg8::pk_fp8x4(s[132] * ws_, s[165] * ws_, s[198] * ws_, s[231] * ws_);
        o.z = pg8::pk_fp8x4(s[264] * ws_, s[297] * ws_, s[330] * ws_, s[363] * ws_); o.w = pg8::pk_fp8x4(s[396] * ws_, s[429] * ws_, s[462] * ws_, s[495] * ws_);
        *(u32x4*)(WT + (drow0 + n) * (size_t)ldd + k0 + 16 * c) = o; }
    asm volatile("s_waitcnt lgkmcnt(0)" ::: "memory");
}
DI void tr_matrix8(const float* W, int K, int N, unsigned char* WT, int ldd, size_t rowbase, int gw, int ngw, float* scr, int lane, int mode = 0) {
    const int nkb = K / 128, nnb = N / 32, nit = nkb * nnb;
    if (gw >= nit) return;
    const int c4 = (lane & 7) * 4, r8 = lane >> 3, c = lane & 7, nb = lane >> 3;
    f32x4 v[16];
    { const int kb = gw / nnb, n0 = (gw % nnb) * 32;
#pragma unroll
      for (int i = 0; i < 16; ++i) v[i] = *(const f32x4*)(W + (size_t)(kb * 128 + 8 * i + r8) * N + n0 + c4); }
    for (int it = gw; it < nit; it += ngw) { const int kb = it / nnb, n0 = (it % nnb) * 32, k0 = kb * 128;
        const size_t drow0 = mode ? rowbase + (size_t)(n0 >> 7) * 256 + (n0 & 127) : rowbase + n0;
#pragma unroll
        for (int i = 0; i < 16; ++i) { float* s = scr + (8 * i + r8) * 33 + c4; s[0] = v[i][0]; s[1] = v[i][1]; s[2] = v[i][2]; s[3] = v[i][3]; }
        { const int itn = it + ngw < nit ? it + ngw : it, kbn = itn / nnb, n0n = (itn % nnb) * 32;
#pragma unroll
          for (int i = 0; i < 16; ++i) v[i] = *(const f32x4*)(W + (size_t)(kbn * 128 + 8 * i + r8) * N + n0n + c4); }
        asm volatile("s_waitcnt lgkmcnt(0)" ::: "memory");
#pragma unroll
        for (int j = 0; j < 4; ++j) { const int n = nb + 8 * j; const float* s = scr + (16 * c) * 33 + n; const float ws_ = pg8::W8_SCALE;
            u32x4 o; o.x = pg8::pk_fp8x4(s[0] * ws_, s[33] * ws_, s[66] * ws_, s[99] * ws_); o.y = pg8::pk_fp8x4(s[132] * ws_, s[165] * ws_, s[198] * ws_, s[231] * ws_);
            o.z = pg8::pk_fp8x4(s[264] * ws_, s[297] * ws_, s[330] * ws_, s[363] * ws_); o.w = pg8::pk_fp8x4(s[396] * ws_, s[429] * ws_, s[462] * ws_, s[495] * ws_);
            *(u32x4*)(WT + (drow0 + n) * (size_t)ldd + k0 + 16 * c) = o; }
        asm volatile("s_waitcnt lgkmcnt(0)" ::: "memory");
    }
}
DI void tr_matrix(const float* W, int K, int N, int NP, h16* WT, int ldd, int mode, size_t rowbase, int gw, int ngw, float* scr, int lane, int drop = WQ_DROP) {
    const int nnb = NP / 64, nit = (K / 64) * nnb;
    const int nkb = K / 64;
    for (int it = gw; it < nit; it += ngw) { const int kb = it % nkb, n0 = (it / nkb) * 64;
        const size_t drow0 = mode ? rowbase + (size_t)(n0 >> 7) * 256 + (n0 & 127) : rowbase + n0;
        tr_item(W, N, kb * 64, n0, WT, drow0, ldd, scr, lane, drop); }
}
DI void s5_tables(const Args& a, char* lds, int g, int q4, int nq) {
    const int tid = threadIdx.x;
    f32x2* Lpow = (f32x2*)lds;
    f32x2* Bbar = Lpow + 33 * 64;
    f32x2* Cc = Bbar + 1024;
    f32x2* coef = Cc + 1024;
    float* Kern = (float*)(coef + 64);
    h16* TCAT = (h16*)(a.ws + WS_TCAT) + (size_t)g * 512 * S5K;
    h16* EPAD = (h16*)(a.ws + WS_EPAD) + (size_t)g * 256 * 512;
    __syncthreads();
    if (tid < 64) { const int p = tid; const float dt = expf(a.in[I_LOGDT][g]); const float lre = a.in[I_LAMRE][g * 64 + p], lim = a.in[I_LAMIM][g * 64 + p];
        const float mag = expf(lre * dt); float sn, cs; sincosf(lim * dt, &sn, &cs); const float l1r = mag * cs, l1i = mag * sn;
        float pr = 1.f, pi = 0.f; Lpow[p] = (f32x2){1.f, 0.f};
        for (int j = 1; j <= 32; ++j) { const float nr = pr * l1r - pi * l1i, ni = pr * l1i + pi * l1r; pr = nr; pi = ni; Lpow[j * 64 + p] = (f32x2){pr, pi}; }
        const float nr = l1r - 1.f, ni = l1i, den = lre * lre + lim * lim; coef[p] = (f32x2){(nr * lre + ni * lim) / den, (ni * lre - nr * lim) / den}; }
    __syncthreads();
    for (int i = tid; i < 1024; i += NT) { const int p = i >> 4; const float br = a.in[I_BRE][g * 1024 + i], bi = a.in[I_BIM][g * 1024 + i]; const f32x2 c = coef[p];
        Bbar[i] = (f32x2){c.x * br - c.y * bi, c.x * bi + c.y * br}; Cc[i] = (f32x2){a.in[I_CRE][g * 1024 + i], a.in[I_CIM][g * 1024 + i]}; }
    __syncthreads();
    const int r_lo = 512 * q4 / nq, r_hi = 512 * (q4 + 1) / nq, e_lo = 256 * q4 / nq, e_hi = 256 * (q4 + 1) / nq, nlag = ((r_hi - 1) >> 4) + 1;
    for (int i = tid; i < nlag * 256; i += NT) { const int j = i >> 8, h = (i >> 4) & 15, h2 = i & 15; float s = 0.f;
        for (int p = 0; p < 64; ++p) { const f32x2 c = Cc[h * 64 + p], l = Lpow[j * 64 + p], b = Bbar[p * 16 + h2]; const float mr = c.x * l.x - c.y * l.y, mi = c.x * l.y + c.y * l.x; s += mr * b.x - mi * b.y; }
        Kern[i] = s; }
    __syncthreads();
    for (int i = r_lo * 80 + tid; i < r_hi * 80; i += NT) { const int row = i / 80, ch = i % 80, tau = row >> 4, h = row & 15; float r[8];
        if (ch < 64) { const int sg = ch >> 1, h0 = (ch & 1) * 8, lag = tau - sg;
#pragma unroll
            for (int j = 0; j < 8; ++j) r[j] = lag >= 0 ? Kern[lag * 256 + h * 16 + h0 + j] : 0.f; }
        else { const int p0 = (ch - 64) * 4;
#pragma unroll
            for (int q = 0; q < 4; ++q) { const f32x2 c = Cc[h * 64 + p0 + q], l = Lpow[(tau + 1) * 64 + p0 + q]; r[2 * q] = c.x * l.x - c.y * l.y; r[2 * q + 1] = -(c.x * l.y + c.y * l.x); } }
        u32x4 w; w.x = pkh(r[0], r[1]); w.y = pkh(r[2], r[3]); w.z = pkh(r[4], r[5]); w.w = pkh(r[6], r[7]);
        *(u32x4*)(TCAT + (size_t)row * S5K + ch * 8) = w; }
    for (int i = e_lo * 64 + tid; i < e_hi * 64; i += NT) { const int row = i >> 6, ch = i & 63; float r[8];
        if (row < 128) { const int p = row >> 1, ri = row & 1, sg = ch >> 1, h0 = (ch & 1) * 8; const f32x2 l = Lpow[(31 - sg) * 64 + p];
#pragma unroll
            for (int j = 0; j < 8; ++j) { const f32x2 b = Bbar[p * 16 + h0 + j]; r[j] = ri ? (l.x * b.y + l.y * b.x) : (l.x * b.x - l.y * b.y); } }
        else {
#pragma unroll
            for (int j = 0; j < 8; ++j) r[j] = 0.f; }
        u32x4 w; w.x = pkh(r[0], r[1]); w.y = pkh(r[2], r[3]); w.z = pkh(r[4], r[5]); w.w = pkh(r[6], r[7]);
        *(u32x4*)(EPAD + (size_t)row * 512 + ch * 8) = w; }
}
#ifndef MOE_CONV_LATE
#define MOE_CONV_LATE 6
#endif
DI void moe_convert(const Args& a, char* lds, int e_lo, int e_hi, int gw, int ngw) {
    const int lane = threadIdx.x & 63, wave = threadIdx.x >> 6; float* scr = (float*)(lds + wave * 16896); unsigned char* ws = a.ws;
    for (int e = e_lo; e < e_hi; ++e) {
        tr_matrix8(a.in[I_MW1] + (size_t)e * D * DFE, D, DFE, (unsigned char*)(ws + WS_MOE13), D, (size_t)e * 2 * DFE, gw, ngw, scr, lane, 1);
        tr_matrix8(a.in[I_MW3] + (size_t)e * D * DFE, D, DFE, (unsigned char*)(ws + WS_MOE13), D, (size_t)e * 2 * DFE + 128, gw, ngw, scr, lane, 1);
        tr_matrix8(a.in[I_MW2] + (size_t)e * DFE * D, DFE, D, (unsigned char*)(ws + WS_MOE2), DFE, (size_t)e * D, gw, ngw, scr, lane);
    }
}
DI void phase_prologue(const Args& a, char* lds) {
    const int tid = threadIdx.x, lane = tid & 63, wave = tid >> 6, gw = blockIdx.x * NWAVES + wave, ngw = gridDim.x * NWAVES;
    float* scr = (float*)(lds + wave * 16896);
    unsigned char* ws = a.ws;
    moe_convert(a, lds, 0, MOE_CONV_LATE, gw, ngw);
    tr_matrix(a.in[I_OWOUT], D, D, D, (h16*)(ws + WS_WOUT1), D, 0, 0, gw, ngw, scr, lane);
    tr_matrix(a.in[I_GLUW], 1024, 1024, 1024, (h16*)(ws + WS_WGLU), 1024, 0, 0, gw, ngw, scr, lane);
    tr_matrix(a.in[I_OWIN], D, IN1, IN1P, (h16*)(ws + WS_WIN1), D, 0, 0, gw, ngw, scr, lane);
    tr_matrix(a.in[I_EW2], DFF, D, D, (h16*)(ws + WS_WFF2), DFF, 0, 0, gw, ngw, scr, lane);
    tr_matrix(a.in[I_EW1], D, DFF, DFF, (h16*)(ws + WS_WFF13), D, 1, 0, gw, ngw, scr, lane);
    tr_matrix(a.in[I_EW3], D, DFF, DFF, (h16*)(ws + WS_WFF13), D, 1, 128, gw, ngw, scr, lane);
    tr_matrix(a.in[I_EWOUT], D, D, D, (h16*)(ws + WS_WOUT0), D, 0, 0, gw, ngw, scr, lane);
    tr_matrix(a.in[I_EWIN], D, IN0, IN0, (h16*)(ws + WS_WIN0), D, 0, 0, gw, ngw, scr, lane);
    { const float* x = a.in[I_X]; h16* xh = (h16*)(ws + WS_XH);
      for (size_t i = (size_t)blockIdx.x * NT + tid; i < (size_t)M * D / 8; i += (size_t)gridDim.x * NT) { const f32x4 v0 = *(const f32x4*)(x + i * 8), v1 = *(const f32x4*)(x + i * 8 + 4);
          u32x4 w; w.x = pka(v0[0], v0[1]); w.y = pka(v0[2], v0[3]); w.z = pka(v1[0], v1[1]); w.w = pka(v1[2], v1[3]); *(u32x4*)(xh + i * 8) = w; } }
    __syncthreads();
    if (gridDim.x >= 256) { if (blockIdx.x < 256) s5_tables(a, lds, (int)blockIdx.x >> 2, (int)blockIdx.x & 3, 4); }
    else for (int g = blockIdx.x; g < 64; g += gridDim.x) s5_tables(a, lds, g, 0, 1);
}

DI void ln_normalize(float (&v)[32], const float* gam, const float* bet, int lane) {
    float s = 0.f;
#pragma unroll
    for (int i = 0; i < 32; ++i) s += v[i];
    const float mean = wave_sum(s) * (1.f / D); float s2 = 0.f;
#pragma unroll
    for (int i = 0; i < 32; ++i) { v[i] -= mean; s2 += v[i] * v[i]; }
    const float rstd = 1.0f / sqrtf(wave_sum(s2) * (1.f / D) + 1e-5f);
#pragma unroll
    for (int j = 0; j < 4; ++j) { const f32x4 g0 = *(const f32x4*)(gam + 8 * lane + 512 * j), g1 = *(const f32x4*)(gam + 8 * lane + 512 * j + 4), b0 = *(const f32x4*)(bet + 8 * lane + 512 * j), b1 = *(const f32x4*)(bet + 8 * lane + 512 * j + 4);
#pragma unroll
        for (int q = 0; q < 4; ++q) { v[8 * j + q] = v[8 * j + q] * rstd * g0[q] + b0[q]; v[8 * j + 4 + q] = v[8 * j + 4 + q] * rstd * g1[q] + b1[q]; } }
}
template <bool ROUTER>
DI void phase_ln(const Args& a, char* lds, const h16* Pin, const float* gam, const float* bet) {
    const int tid = threadIdx.x, lane = tid & 63, wave = tid >> 6, gw = blockIdx.x * NWAVES + wave, ngw = gridDim.x * NWAVES;
    h16* XH = (h16*)(a.ws + WS_XH);
    float* WrT = (float*)lds;
    if (ROUTER) { __syncthreads(); const float* rw = a.in[I_ROUTER]; for (int i = tid; i < D * 8; i += NT) WrT[(i & 7) * D + (i >> 3)] = rw[i]; __syncthreads(); }
    h16x8 pn[4];
    if (gw < M) {
#pragma unroll
        for (int j = 0; j < 4; ++j) pn[j] = *(const h16x8*)(Pin + (size_t)gw * D + 8 * lane + 512 * j); }
    for (int row = gw; row < M; row += ngw) {
        float v[32];
#pragma unroll
        for (int j = 0; j < 4; ++j) {
#pragma unroll
            for (int q = 0; q < 8; ++q) v[8 * j + q] = (float)pn[j][q]; }
        { const int nr = row + ngw < M ? row + ngw : row;
#pragma unroll
          for (int j = 0; j < 4; ++j) pn[j] = *(const h16x8*)(Pin + (size_t)nr * D + 8 * lane + 512 * j); }
        ln_normalize(v, gam, bet, lane);
#pragma unroll
        for (int j = 0; j < 4; ++j) { u32x4 w; w.x = pka(v[8 * j], v[8 * j + 1]); w.y = pka(v[8 * j + 2], v[8 * j + 3]); w.z = pka(v[8 * j + 4], v[8 * j + 5]); w.w = pka(v[8 * j + 6], v[8 * j + 7]);
            *(u32x4*)(XH + (size_t)row * D + 8 * lane + 512 * j) = w; }
        if (ROUTER) {
#pragma unroll
            for (int j = 0; j < 4; ++j) { u32x2 q; q.x = pg8::pk_fp8x4(v[8 * j] * pg8::X8_SCALE, v[8 * j + 1] * pg8::X8_SCALE, v[8 * j + 2] * pg8::X8_SCALE, v[8 * j + 3] * pg8::X8_SCALE);
                q.y = pg8::pk_fp8x4(v[8 * j + 4] * pg8::X8_SCALE, v[8 * j + 5] * pg8::X8_SCALE, v[8 * j + 6] * pg8::X8_SCALE, v[8 * j + 7] * pg8::X8_SCALE);
                *(u32x2*)(a.ws + WS_XQ8 + (size_t)row * D + 8 * lane + 512 * j) = q; }
            float lg[8];
#pragma unroll
            for (int e = 0; e < 8; ++e) { float s = 0.f;
#pragma unroll
                for (int j = 0; j < 4; ++j) { const f32x4 w0 = *(const f32x4*)(WrT + e * D + 8 * lane + 512 * j), w1 = *(const f32x4*)(WrT + e * D + 8 * lane + 512 * j + 4);
#pragma unroll
                    for (int q = 0; q < 4; ++q) s += v[8 * j + q] * w0[q] + v[8 * j + 4 + q] * w1[q]; }
                lg[e] = wave_sum(s); asm volatile("" ::: "memory"); }
            int i1 = 0; float v1 = lg[0];
#pragma unroll
            for (int e = 1; e < 8; ++e) if (lg[e] > v1) { v1 = lg[e]; i1 = e; }
            int i2 = -1; float v2 = -3.0e38f;
#pragma unroll
            for (int e = 0; e < 8; ++e) if (e != i1 && lg[e] > v2) { v2 = lg[e]; i2 = e; }
            const float g1 = 1.0f / (1.0f + expf(v2 - v1)), g2 = 1.0f - g1;
            if (lane == 0) { unsigned* cnt = (unsigned*)(a.ws + WS_CTL) + CW_CNT;
                const unsigned p1 = atomicAdd(cnt + i1, 1u), p2 = atomicAdd(cnt + i2, 1u);
                int* tk = (int*)(a.ws + WS_TOK) + (size_t)row * 8; tk[0] = i1; tk[1] = i2; tk[2] = (int)p1; tk[3] = (int)p2; ((float*)tk)[4] = g1; ((float*)tk)[5] = g2;
                int* lst = (int*)(a.ws + WS_LIST); lst[(i1 << 14) + (int)p1] = row; lst[(i2 << 14) + (int)p2] = row; }
        }
    }
}
DI void moe_y8(const h16* Y, const float* SL, int slot, int col, int pm0, int R, int sp, float (&y)[8]) {
    const int pm = slot >> 8;
    if (pm < pm0) { const h16x8 t = *(const h16x8*)(Y + (size_t)slot * D + col);
#pragma unroll
        for (int q = 0; q < 8; ++q) y[q] = (float)t[q]; }
    else { const int tile = (pm - pm0) * 8 + (col >> 8);
#pragma unroll
        for (int q = 0; q < 8; ++q) y[q] = 0.f;
        for (int ks = 0; ks < sp; ++ks) { const float* p = SL + (size_t)(ks * R + tile) * 65536 + (size_t)(slot & 255) * 256 + (col & 255); const f32x4 t0 = *(const f32x4*)p, t1 = *(const f32x4*)(p + 4);
#pragma unroll
            for (int q = 0; q < 4; ++q) { y[q] += t0[q]; y[4 + q] += t1[q]; } } }
}
DI void final_row_slow(const Args& a, int row, int s1, int s2, float g1, float g2, int pm0, int R, int sp, int lane) {
    const h16* XH = (const h16*)(a.ws + WS_XH); const h16* Y = (const h16*)(a.ws + WS_XG); const float* SL = (const float*)(a.ws + WS_SLAB);
    float v[32];
#pragma unroll
    for (int j = 0; j < 4; ++j) { const int col = 8 * lane + 512 * j; const h16x8 x = *(const h16x8*)(XH + (size_t)row * D + col); float y1[8], y2[8];
        moe_y8(Y, SL, s1, col, pm0, R, sp, y1); moe_y8(Y, SL, s2, col, pm0, R, sp, y2);
#pragma unroll
        for (int q = 0; q < 8; ++q) v[8 * j + q] = ALPHA * (float)x[q] + g1 * y1[q] + g2 * y2[q]; }
    ln_normalize(v, a.in[I_OLNFG], a.in[I_OLNFB], lane);
#pragma unroll
    for (int j = 0; j < 4; ++j) { *(f32x4*)(a.out + (size_t)row * D + 8 * lane + 512 * j) = (f32x4){v[8 * j], v[8 * j + 1], v[8 * j + 2], v[8 * j + 3]}; *(f32x4*)(a.out + (size_t)row * D + 8 * lane + 512 * j + 4) = (f32x4){v[8 * j + 4], v[8 * j + 5], v[8 * j + 6], v[8 * j + 7]}; }
}
DI void phase_final(const Args& a, int pm0, int R, int sp, int t1, int t2, int t3, int t4, int t5, int t6, int t7) {
#define FIN_SLOT(e_, p_) ((((e_) == 1 ? t1 : (e_) == 2 ? t2 : (e_) == 3 ? t3 : (e_) == 4 ? t4 : (e_) == 5 ? t5 : (e_) == 6 ? t6 : (e_) == 7 ? t7 : 0) << 8) + (p_))
    const int tid = threadIdx.x, lane = tid & 63, wave = __builtin_amdgcn_readfirstlane(tid >> 6), gw = blockIdx.x * NWAVES + wave, ngw = gridDim.x * NWAVES;
    const h16* XH = (const h16*)(a.ws + WS_XH); const h16* Y = (const h16*)(a.ws + WS_XG);
    for (int rowA = gw; rowA < M; rowA += 2 * ngw) {
        const int rowB = rowA + ngw < M ? rowA + ngw : rowA;
        const int* tkA = (const int*)(a.ws + WS_TOK) + (size_t)rowA * 8; const int* tkB = (const int*)(a.ws + WS_TOK) + (size_t)rowB * 8;
        const int a1 = FIN_SLOT(tkA[0], tkA[2]), a2 = FIN_SLOT(tkA[1], tkA[3]), b1 = FIN_SLOT(tkB[0], tkB[2]), b2 = FIN_SLOT(tkB[1], tkB[3]); const float ga1 = ((const float*)tkA)[4], ga2 = ((const float*)tkA)[5], gb1 = ((const float*)tkB)[4], gb2 = ((const float*)tkB)[5];
        const bool fast = (a1 >> 8) < pm0 && (a2 >> 8) < pm0 && (b1 >> 8) < pm0 && (b2 >> 8) < pm0;
        if (fast) {
            h16x8 xa[4], ya1[4], ya2[4], xb[4], yb1[4], yb2[4];
#pragma unroll
            for (int j = 0; j < 4; ++j) { const int col = 8 * lane + 512 * j; xa[j] = *(const h16x8*)(XH + (size_t)rowA * D + col); ya1[j] = *(const h16x8*)(Y + (size_t)a1 * D + col); ya2[j] = *(const h16x8*)(Y + (size_t)a2 * D + col);
                xb[j] = *(const h16x8*)(XH + (size_t)rowB * D + col); yb1[j] = *(const h16x8*)(Y + (size_t)b1 * D + col); yb2[j] = *(const h16x8*)(Y + (size_t)b2 * D + col); }
            float v[32];
#pragma unroll
            for (int j = 0; j < 4; ++j)
#pragma unroll
                for (int q = 0; q < 8; ++q) v[8 * j + q] = ALPHA * (float)xa[j][q] + ga1 * (float)ya1[j][q] + ga2 * (float)ya2[j][q];
            ln_normalize(v, a.in[I_OLNFG], a.in[I_OLNFB], lane);
#pragma unroll
            for (int j = 0; j < 4; ++j) { *(f32x4*)(a.out + (size_t)rowA * D + 8 * lane + 512 * j) = (f32x4){v[8 * j], v[8 * j + 1], v[8 * j + 2], v[8 * j + 3]}; *(f32x4*)(a.out + (size_t)rowA * D + 8 * lane + 512 * j + 4) = (f32x4){v[8 * j + 4], v[8 * j + 5], v[8 * j + 6], v[8 * j + 7]}; }
#pragma unroll
            for (int j = 0; j < 4; ++j)
#pragma unroll
                for (int q = 0; q < 8; ++q) v[8 * j + q] = ALPHA * (float)xb[j][q] + gb1 * (float)yb1[j][q] + gb2 * (float)yb2[j][q];
            ln_normalize(v, a.in[I_OLNFG], a.in[I_OLNFB], lane);
            if (rowB != rowA) {
#pragma unroll
                for (int j = 0; j < 4; ++j) { *(f32x4*)(a.out + (size_t)rowB * D + 8 * lane + 512 * j) = (f32x4){v[8 * j], v[8 * j + 1], v[8 * j + 2], v[8 * j + 3]}; *(f32x4*)(a.out + (size_t)rowB * D + 8 * lane + 512 * j + 4) = (f32x4){v[8 * j + 4], v[8 * j + 5], v[8 * j + 6], v[8 * j + 7]}; } }
        } else { final_row_slow(a, rowA, a1, a2, ga1, ga2, pm0, R, sp, lane); if (rowB != rowA) final_row_slow(a, rowB, b1, b2, gb1, gb2, pm0, R, sp, lane); }
    }
#undef FIN_SLOT
}

DI void phase_dilated(const Args& a, char* lds) {
    const int tid = threadIdx.x, lane = tid & 63, w = __builtin_amdgcn_readfirstlane(tid >> 6), g = lane >> 4, lq = lane & 15;
    const h16* H0 = (const h16*)(a.ws + WS_H0); h16* OP = (h16*)(a.ws + WS_OP); float* LSE = (float*)(a.ws + WS_LSE);
    char* Ks = lds; char* Vs = lds + 256 * 272;
    const int chunk = tid & 15, rr = tid >> 4;
    u32x4 kv[8], vv[8]; h16x8 qn[4];
#define DIL_LOAD(u_) do { const int pt_ = (u_) >> 10, rem_ = (u_) & 1023, bh_ = rem_ >> 6, blk_ = rem_ & 63, dsh_ = 2 * pt_, d_ = 1 << dsh_, r_ = blk_ >> (6 - dsh_), m0_ = (blk_ & ((64 >> dsh_) - 1)) * 128; \
        const h16* base_ = H0 + (size_t)((bh_ >> 3) * SEQ) * IN0 + (bh_ & 7) * 128; \
        _Pragma("unroll") for (int p = 0; p < 8; ++p) { const int mm = m0_ - 128 + p * 32 + rr; const int mc = mm >= 0 ? mm : 0; const h16* rp = base_ + (size_t)(mc * d_ + r_) * IN0 + chunk * 8; \
            kv[p] = *(const u32x4*)(rp + 4096); vv[p] = *(const u32x4*)(rp + 5120); if (mm < 0) { kv[p] = (u32x4){0u, 0u, 0u, 0u}; vv[p] = kv[p]; } } \
        const int tq_ = (m0_ + 16 * w + lq) * d_ + r_; \
        _Pragma("unroll") for (int kk = 0; kk < 4; ++kk) qn[kk] = *(const h16x8*)(base_ + (size_t)tq_ * IN0 + 3072 + 32 * kk + 8 * g); } while (0)
    const int G_ = gridDim.x, xg = (G_ % 8 == 0 && 3072 % G_ == 0) ? 1 : 0;
    const int ustart = xg ? ((int)blockIdx.x & 7) * (3072 / 8) + ((int)blockIdx.x >> 3) : (int)blockIdx.x, ustep = xg ? G_ / 8 : G_, uend = xg ? (((int)blockIdx.x & 7) + 1) * (3072 / 8) : 3072;
    __syncthreads();
    if (ustart < uend) DIL_LOAD(ustart);
    for (int u = ustart; u < uend; u += ustep) {
        const int pt = u >> 10, rem = u & 1023, bh = rem >> 6, blk = rem & 63, b = bh >> 3, h = bh & 7;
        const int dsh = 2 * pt, d = 1 << dsh, r = blk >> (6 - dsh), m0 = (blk & ((64 >> dsh) - 1)) * 128;
        LBAR();
#pragma unroll
        for (int p = 0; p < 8; ++p) { const int row = p * 32 + rr; *(u32x4*)(Ks + row * 272 + chunk * 16) = kv[p]; *(u32x4*)(Vs + row * 288 + chunk * 16) = vv[p]; }
        h16x8 qf[4];
#pragma unroll
        for (int kk = 0; kk < 4; ++kk) qf[kk] = qn[kk];
        { const int un = u + ustep < uend ? u + ustep : u; DIL_LOAD(un); }
        const int tq = (m0 + 16 * w + lq) * d + r;
        LBAR();
        f32x4 acc[9];
#pragma unroll
        for (int ti = 0; ti < 9; ++ti) { acc[ti] = (f32x4){0.f, 0.f, 0.f, 0.f};
#pragma unroll
            for (int kk = 0; kk < 4; ++kk) { const h16x8 kf = *(const h16x8*)(Ks + (16 * w + 16 * ti + lq) * 272 + (4 * kk + g) * 16); acc[ti] = MFMA16(kf, qf[kk], acc[ti]); } }
        const int kbase = m0 + 16 * w - 128;
        float mx = -1e30f;
#pragma unroll
        for (int ti = 0; ti < 9; ++ti)
#pragma unroll
            for (int i = 0; i < 4; ++i) { const int kr = 16 * ti + 4 * g + i; const bool valid = (kr >= lq) && (kr <= lq + 128) && (kbase + kr >= 0);
                const float sc = valid ? acc[ti][i] * QK_SCALE : -1e30f; acc[ti][i] = sc; mx = fmaxf(mx, sc); }
        mx = fmaxf(mx, __shfl_xor(mx, 16)); mx = fmaxf(mx, __shfl_xor(mx, 32));
        float sum = 0.f;
#pragma unroll
        for (int ti = 0; ti < 9; ++ti)
#pragma unroll
            for (int i = 0; i < 4; ++i) { const float p = __expf(acc[ti][i] - mx); acc[ti][i] = p; sum += p; }
        sum += __shfl_xor(sum, 16); sum += __shfl_xor(sum, 32);
        const float inv = 1.0f / sum;
        f32x4 o[8];
#pragma unroll
        for (int c = 0; c < 8; ++c) o[c] = (f32x4){0.f, 0.f, 0.f, 0.f};
#pragma unroll
        for (int s = 0; s < 5; ++s) {
            h16x8 pf;
#pragma unroll
            for (int j = 0; j < 4; ++j) { pf[j] = (h16)(acc[2 * s][j] * inv); pf[4 + j] = (s < 4) ? (h16)(acc[(s < 4) ? 2 * s + 1 : 0][j] * inv) : (h16)0.f; }
            const char* vb = Vs + (16 * w + 32 * s + 4 * g + (lq >> 2)) * 288 + (4 * (lq & 3)) * 2;
#pragma unroll
            for (int c = 0; c < 8; ++c) { const h16x4 t0 = trread(vb + c * 32); h16x4 t1 = (h16x4){(h16)0.f, (h16)0.f, (h16)0.f, (h16)0.f}; if (s < 4) t1 = trread(vb + 16 * 288 + c * 32);
                o[c] = MFMA16(mk8(t0, t1), pf, o[c]); }
        }
        h16* op = OP + ((size_t)pt * M + (size_t)(b * SEQ + tq)) * 1024 + h * 128 + 4 * g;
#pragma unroll
        for (int c = 0; c < 8; ++c) { u32x2 wv; wv.x = pkh(o[c][0], o[c][1]); wv.y = pkh(o[c][2], o[c][3]); *(u32x2*)(op + 16 * c) = wv; }
        if (g == 0) LSE[(size_t)(pt * 16 + bh) * SEQ + tq] = mx + __logf(sum);
    }
#undef DIL_LOAD
    __syncthreads();
}
DI void phase_combine(const Args& a) {
    const h16* OP = (const h16*)(a.ws + WS_OP); const float* LSE = (const float*)(a.ws + WS_LSE); h16* O0 = (h16*)(a.ws + WS_O0);
#pragma unroll 4
    for (size_t i = (size_t)blockIdx.x * NT + threadIdx.x; i < (size_t)M * 128; i += (size_t)gridDim.x * NT) {
        const int token = (int)(i >> 7), hc = (int)(i & 127), h = hc >> 4, b = token >> 13, t = token & 8191;
        const float l0 = LSE[(size_t)(0 * 16 + b * 8 + h) * SEQ + t], l1 = LSE[(size_t)(1 * 16 + b * 8 + h) * SEQ + t], l2 = LSE[(size_t)(2 * 16 + b * 8 + h) * SEQ + t];
        const float mx = fmaxf(l0, fmaxf(l1, l2)); float w0 = __expf(l0 - mx), w1 = __expf(l1 - mx), w2 = __expf(l2 - mx); const float inv = 1.0f / (w0 + w1 + w2); w0 *= inv; w1 *= inv; w2 *= inv;
        const size_t off = (size_t)token * 1024 + hc * 8;
        const h16x8 a0 = *(const h16x8*)(OP + off), a1 = *(const h16x8*)(OP + (size_t)M * 1024 + off), a2 = *(const h16x8*)(OP + (size_t)2 * M * 1024 + off);
        float r[8];
#pragma unroll
        for (int j = 0; j < 8; ++j) r[j] = w0 * (float)a0[j] + w1 * (float)a1[j] + w2 * (float)a2[j];
        u32x4 wv; wv.x = pkh(r[0], r[1]); wv.y = pkh(r[2], r[3]); wv.z = pkh(r[4], r[5]); wv.w = pkh(r[6], r[7]);
        *(u32x4*)(O0 + (size_t)token * 2048 + 1024 + hc * 8) = wv;
    }
}

DI void sb_tile(const f32x4& acc, int key0, int tq, int g, int lq, float& R, float (&wout)[4]) {
    float lk[4], lsz[4]; bool past[4];
#pragma unroll
    for (int i = 0; i < 4; ++i) { const int key = key0 + 4 * g + i; const float z = acc[i] * QK_SCALE; past[i] = (key < tq) && (key >= 0);
        const float sp = softplusf_(z); lk[i] = past[i] ? -sp : 0.f; lsz[i] = z - sp; }
    const float suf2 = lk[3], suf1 = suf2 + lk[2], suf0 = suf1 + lk[1], T = suf0 + lk[0];
    float IS = T; float t = __shfl_down(IS, 16); if (g < 3) IS += t; t = __shfl_down(IS, 32); if (g < 2) IS += t;
    const float G = IS - T, total = __shfl(IS, lq);
    const float base = R + G;
    wout[0] = past[0] ? __expf(lsz[0] + base + suf0) : 0.f; wout[1] = past[1] ? __expf(lsz[1] + base + suf1) : 0.f;
    wout[2] = past[2] ? __expf(lsz[2] + base + suf2) : 0.f; wout[3] = past[3] ? __expf(lsz[3] + base) : 0.f;
    R += total;
}
DI void phase_sb(const Args& a, char* lds) {
    const int tid = threadIdx.x, lane = tid & 63, w = __builtin_amdgcn_readfirstlane(tid >> 6), g = lane >> 4, lq = lane & 15;
    const h16* H0 = (const h16*)(a.ws + WS_H0); h16* O0 = (h16*)(a.ws + WS_O0);
    char* Vw = lds + w * 9216;
    const int G_ = gridDim.x, xg = (G_ % 8 == 0 && 1024 % G_ == 0) ? 1 : 0;
    const int bstart = xg ? ((int)blockIdx.x & 7) * 128 + ((int)blockIdx.x >> 3) : (int)blockIdx.x, bstep = xg ? G_ / 8 : G_, bend = xg ? (((int)blockIdx.x & 7) + 1) * 128 : 1024;
    for (int bu = bstart; bu < bend; bu += bstep) { const int wu = bu * NWAVES + w;
        const int bh = wu >> 9, qt = wu & 511, b = bh >> 3, h = bh & 7, q0 = 16 * qt, tq = q0 + lq;
        const h16* base = H0 + (size_t)(b * SEQ) * IN0 + h * 128;
        h16x8 qf[4];
#pragma unroll
        for (int kk = 0; kk < 4; ++kk) qf[kk] = *(const h16x8*)(base + (size_t)tq * IN0 + 32 * kk + 8 * g);
        float R = 0.f; f32x4 o[8];
#pragma unroll
        for (int c = 0; c < 8; ++c) o[c] = (f32x4){0.f, 0.f, 0.f, 0.f};
        for (int sb = q0 - 16; sb > -32; sb -= 32) {
            const int ra = max(sb + lq, 0), rb = sb + 16 + lq;
            h16x8 kfa[4], kfb[4];
#pragma unroll
            for (int kk = 0; kk < 4; ++kk) { kfa[kk] = *(const h16x8*)(base + (size_t)ra * IN0 + 1024 + 32 * kk + 8 * g); kfb[kk] = *(const h16x8*)(base + (size_t)rb * IN0 + 1024 + 32 * kk + 8 * g); }
            u32x4 vr[8];
#pragma unroll
            for (int i = 0; i < 8; ++i) { const int idx = lane + 64 * i, row = idx >> 4, chunk = idx & 15; vr[i] = *(const u32x4*)(base + (size_t)max(sb + row, 0) * IN0 + 2048 + chunk * 8); }
#pragma unroll
            for (int i = 0; i < 8; ++i) { const int idx = lane + 64 * i, row = idx >> 4, chunk = idx & 15; *(u32x4*)(Vw + row * 288 + chunk * 16) = vr[i]; }
            f32x4 accA = (f32x4){0.f, 0.f, 0.f, 0.f}, accB = accA;
#pragma unroll
            for (int kk = 0; kk < 4; ++kk) { accA = MFMA16(kfa[kk], qf[kk], accA); accB = MFMA16(kfb[kk], qf[kk], accB); }
            float wa[4], wb[4];
            sb_tile(accB, sb + 16, tq, g, lq, R, wb);
            sb_tile(accA, sb, tq, g, lq, R, wa);
            h16x8 pf;
#pragma unroll
            for (int j = 0; j < 4; ++j) { pf[j] = (h16)wa[j]; pf[4 + j] = (h16)wb[j]; }
            asm volatile("s_waitcnt lgkmcnt(0)" ::: "memory");
            const char* vb = Vw + (4 * g + (lq >> 2)) * 288 + (4 * (lq & 3)) * 2;
#pragma unroll
            for (int c = 0; c < 8; ++c) { const h16x4 t0 = trread(vb + c * 32), t1 = trread(vb + 16 * 288 + c * 32); o[c] = MFMA16(mk8(t0, t1), pf, o[c]); }
            asm volatile("s_waitcnt lgkmcnt(0)" ::: "memory");
            if (__all(R < -50.0f)) break;
        }
        h16* op = O0 + (size_t)(b * SEQ + tq) * 2048 + h * 128 + 4 * g;
#pragma unroll
        for (int c = 0; c < 8; ++c) { u32x2 wv; wv.x = pkh(o[c][0], o[c][1]); wv.y = pkh(o[c][2], o[c][3]); *(u32x2*)(op + 16 * c) = wv; }
    }
}

DI void phase_gdn_pre(const Args& a, char* lds, int row_lo, int row_hi, int first_block) {
    const int tid = threadIdx.x, lane = tid & 63, wave = tid >> 6, gw = ((int)blockIdx.x - first_block) * NWAVES + wave, ngw = ((int)gridDim.x - first_block) * NWAVES;
    if ((int)blockIdx.x < first_block) return;
    const h16* QKVG = (const h16*)(a.ws + WS_QKVG); const float* LOGIT = (const float*)(a.ws + WS_LOGIT); h16* QKVN = (h16*)(a.ws + WS_QKVN); float* GB = (float*)(a.ws + WS_GB);
    float* cw = (float*)lds;
    __syncthreads();
    for (int i = tid; i < 3072; i += NT) ((f32x4*)cw)[i] = ((const f32x4*)a.in[I_CONVW])[i];
    __syncthreads();
    for (int row = row_lo + gw; row < row_hi; row += ngw) { const int t = row & (SEQ - 1);
        float acc[6][8];
#pragma unroll
        for (int j = 0; j < 6; ++j)
#pragma unroll
            for (int q = 0; q < 8; ++q) acc[j][q] = 0.f;
#pragma unroll
        for (int i = 0; i < 4; ++i) { if (t - 3 + i >= 0) {
#pragma unroll
            for (int j = 0; j < 6; ++j) { const int c8 = 8 * (lane + 64 * j); const h16x8 xv = *(const h16x8*)(QKVG + (size_t)(row - 3 + i) * 4096 + c8);
                const f32x4 w0 = *(const f32x4*)(cw + i * 3072 + c8), w1 = *(const f32x4*)(cw + i * 3072 + c8 + 4);
#pragma unroll
                for (int q = 0; q < 8; ++q) acc[j][q] += (q < 4 ? w0[q & 3] : w1[q & 3]) * (float)xv[q]; } } }
#pragma unroll
        for (int j = 0; j < 6; ++j) { float ss = 0.f;
#pragma unroll
            for (int q = 0; q < 8; ++q) { acc[j][q] = siluf_(acc[j][q]); ss += acc[j][q] * acc[j][q]; }
            if (j < 4) { ss += __shfl_xor(ss, 1); ss += __shfl_xor(ss, 2); ss += __shfl_xor(ss, 4); ss += __shfl_xor(ss, 8); float rinv = 1.0f / sqrtf(ss + 1e-6f); if (j < 2) rinv *= QK_SCALE;
#pragma unroll
                for (int q = 0; q < 8; ++q) acc[j][q] *= rinv; }
            u32x4 wv; wv.x = pkh(acc[j][0], acc[j][1]); wv.y = pkh(acc[j][2], acc[j][3]); wv.z = pkh(acc[j][4], acc[j][5]); wv.w = pkh(acc[j][6], acc[j][7]);
            *(u32x4*)(QKVN + (size_t)row * 3072 + 8 * (lane + 64 * j)) = wv; }
        if (lane < 8) { const float bl = LOGIT[(size_t)row * 16 + lane], al = LOGIT[(size_t)row * 16 + 8 + lane];
            GB[(size_t)row * 16 + lane] = sigmoidf_(bl); GB[(size_t)row * 16 + 8 + lane] = -expf(a.in[I_ALOG][lane]) * softplusf_(al + a.in[I_DTB][lane]); }
    }
}
DI void phase_gdn_local(const Args& a, char* lds) {
    const int tid = threadIdx.x, lane = tid & 63, w = __builtin_amdgcn_readfirstlane(tid >> 6), g = lane >> 4, lq = lane & 15;
    const h16* QKVN = (const h16*)(a.ws + WS_QKVN); const float* GB = (const float*)(a.ws + WS_GB);
    constexpr int TB = 52224;
    int off_lm = 2 * TB, off_gc = 2 * TB + 16384; asm volatile("" : "+v"(off_lm)); asm volatile("" : "+v"(off_gc));
    float* Lm = (float*)(lds + off_lm);
    float* gcb = (float*)(lds + off_gc);
    float* Dinv = gcb + 384;
    int t2 = tid - 256;
    u32x4 pre[6]; float pg = 0.f, pb = 0.f;
#define GL_LOAD(un) do { const int b_ = (un) >> 10, n_ = ((un) >> 3) & 127, h_ = (un) & 7; const size_t row0_ = (size_t)b_ * SEQ + n_ * 64; const int tq_ = t2 + 256; \
        _Pragma("unroll") for (int k = 0; k < 6; ++k) { const int idx = tq_ + 512 * k, part = idx >> 10, r = (idx >> 4) & 63, ch = idx & 15; pre[k] = *(const u32x4*)(QKVN + (row0_ + r) * 3072 + part * 1024 + h_ * 128 + ch * 8); } \
        if (tq_ < 64) { pb = GB[(row0_ + tq_) * 16 + h_]; pg = GB[(row0_ + tq_) * 16 + 8 + h_]; } } while (0)
#define GL_STORE(buf) do { char* tb_ = lds + (buf) * TB; const int tq_ = t2 + 256; \
        _Pragma("unroll") for (int k = 0; k < 6; ++k) { const int idx = tq_ + 512 * k, part = idx >> 10, r = (idx >> 4) & 63, ch = idx & 15; *(u32x4*)(tb_ + part * 17408 + r * 272 + ch * 16) = pre[k]; } \
        if (tq_ < 64) { float s_ = pg; _Pragma("unroll") for (int o = 1; o < 64; o <<= 1) { const float t_ = __shfl_up(s_, o); if (lane >= o) s_ += t_; } \
            float* gq_ = gcb + (buf) * 192; gq_[tq_] = s_; gq_[64 + tq_] = pb; gq_[128 + tq_] = __expf(s_); } } while (0)
    __syncthreads();
    if ((int)blockIdx.x < GUNITS) { GL_LOAD((int)blockIdx.x); GL_STORE(0); }
    int cur = 0;
    for (int unit = blockIdx.x; unit < GUNITS; unit += gridDim.x, cur ^= 1) {
        asm volatile("" : "+v"(t2));
        const char* qh = lds + cur * TB; const char* kh = qh + 17408; const char* vh = qh + 34816;
        const float* gc = gcb + cur * 192; const float* bt = gc + 64; const float* eg = gc + 128;
        LBAR();
        { const int nu_ = unit + (int)gridDim.x < GUNITS ? unit + (int)gridDim.x : unit; GL_LOAD(nu_); }
        { const int which = w >> 2, ti = w & 3; const char* Ah = which ? qh : kh; h16* INTRA = (h16*)(a.ws + WS_GINTRA) + (size_t)unit * 4096;
#pragma unroll
          for (int tj = 0; tj < 4; ++tj) {
              if (tj <= ti) { f32x4 acc = (f32x4){0.f, 0.f, 0.f, 0.f};
#pragma unroll
                  for (int kk = 0; kk < 4; ++kk) { const h16x8 af = *(const h16x8*)(Ah + (16 * ti + lq) * 272 + (4 * kk + g) * 16), bf = *(const h16x8*)(kh + (16 * tj + lq) * 272 + (4 * kk + g) * 16); acc = MFMA16(af, bf, acc); }
#pragma unroll
                  for (int e = 0; e < 4; ++e) { const int i = 16 * ti + 4 * g + e, j = 16 * tj + lq; const float dec = (j <= i) ? __expf(gc[i] - gc[j]) : 0.f;
                      if (which == 0) Lm[i * 64 + j] = (j < i) ? -(acc[e] * bt[i] * dec) : 0.f; else INTRA[i * 64 + j] = (h16)(acc[e] * dec); } }
              else if (which) {
#pragma unroll
                  for (int e = 0; e < 4; ++e) INTRA[(16 * ti + 4 * g + e) * 64 + 16 * tj + lq] = (h16)0.f; } } }
        LBAR();
        if (tid < 256) { const int bb = w, c = lq; float nn[16];
#pragma unroll
            for (int i = 0; i < 16; ++i) { float sacc = (i == c) ? 1.f : 0.f;
#pragma unroll
                for (int j4 = 0; j4 < (i + 3) / 4; ++j4) { const f32x4 l = *(const f32x4*)(Lm + (16 * bb + i) * 64 + 16 * bb + 4 * j4);
#pragma unroll
                    for (int q = 0; q < 4; ++q) if (4 * j4 + q < i) sacc += l[q] * nn[4 * j4 + q]; }
                nn[i] = sacc; if (lane < 16) Dinv[bb * 256 + i * 16 + c] = sacc; } }
        else {
            h16* QD = (h16*)(a.ws + WS_GQD) + (size_t)unit * 8192; h16* KDT = (h16*)(a.ws + WS_GKDT) + (size_t)unit * 8192; const float gl = gc[63];
            for (int it = t2; it < 1024; it += 256) { const int i = it >> 4, c8 = (it & 15) * 8; const float e = eg[i]; const h16x8 qv = *(const h16x8*)(qh + i * 272 + c8 * 2);
                u32x4 wv; wv.x = pkh((float)qv[0] * e, (float)qv[1] * e); wv.y = pkh((float)qv[2] * e, (float)qv[3] * e); wv.z = pkh((float)qv[4] * e, (float)qv[5] * e); wv.w = pkh((float)qv[6] * e, (float)qv[7] * e); *(u32x4*)(QD + i * 128 + c8) = wv; }
            for (int it = t2; it < 1024; it += 256) { const int dk = it & 127, c0 = (it >> 7) * 8; float r[8];
#pragma unroll
                for (int j = 0; j < 8; ++j) r[j] = (float)((const h16*)kh)[(c0 + j) * 136 + dk] * __expf(gl - gc[c0 + j]);
                u32x4 wv; wv.x = pkh(r[0], r[1]); wv.y = pkh(r[2], r[3]); wv.z = pkh(r[4], r[5]); wv.w = pkh(r[6], r[7]); *(u32x4*)(KDT + dk * 64 + c0) = wv; }
            if (t2 == 0) ((float*)(a.ws + WS_GLAST))[unit] = __expf(gl); }
        LBAR();
#pragma unroll
        for (int cc = 0; cc < 2; ++cc) { const int ctile = 2 * w + cc, c = 16 * ctile + lq; const bool isv = ctile < 8; const h16* src = (const h16*)(isv ? vh : kh) + (c & 127);
            h16* dst = (h16*)(a.ws + (isv ? WS_GU : WS_GW)) + (size_t)unit * 8192 + (c & 127);
            f32x4 X[4];
#pragma unroll
            for (int bb = 0; bb < 4; ++bb) { f32x4 T;
#pragma unroll
                for (int i = 0; i < 4; ++i) { const int row = 16 * bb + 4 * g + i; float r = (float)src[row * 136] * bt[row]; if (!isv) r *= eg[row]; T[i] = r; }
#pragma unroll
                for (int b2 = 0; b2 < 4; ++b2) if (b2 < bb) { const f32x4 lv = *(const f32x4*)(Lm + (16 * bb + lq) * 64 + 16 * b2 + 4 * g);
#pragma unroll
                    for (int i = 0; i < 4; ++i) T = __builtin_amdgcn_mfma_f32_16x16x4f32(lv[i], X[b2][i], T, 0, 0, 0); }
                const f32x4 dv = *(const f32x4*)(Dinv + bb * 256 + lq * 16 + 4 * g); f32x4 Xb = (f32x4){0.f, 0.f, 0.f, 0.f};
#pragma unroll
                for (int i = 0; i < 4; ++i) Xb = __builtin_amdgcn_mfma_f32_16x16x4f32(dv[i], T[i], Xb, 0, 0, 0);
                X[bb] = Xb;
#pragma unroll
                for (int i = 0; i < 4; ++i) dst[(16 * bb + 4 * g + i) * 128] = (h16)Xb[i]; } }
        GL_STORE(cur ^ 1);
    }
#undef GL_LOAD
#undef GL_STORE
    __syncthreads();
}

struct GdnRegs { u32x4 rW[2], rQ[2], rI, rK[2]; h16 rU[4]; float rGl; };
DI void gdn_recur_job(const Args& a, char* lds, int job) {
    const int tid = threadIdx.x, lane = tid & 63, w = __builtin_amdgcn_readfirstlane(tid >> 6), g = lane >> 4, lq = lane & 15;
    const int bh = job >> 2, dv0 = (job & 3) * 32, b = bh >> 3, h = bh & 7;
    constexpr int OPB = 62464, O_QD = 17408, O_IN = 34816, O_KDT = 44032, O_SH = 2 * OPB, SHB = 8448, O_VN = O_SH + 2 * SHB;
    int zoff = 0; asm volatile("" : "+v"(zoff)); char* L = lds + zoff;
    const h16* GU = (const h16*)(a.ws + WS_GU); const h16* GW = (const h16*)(a.ws + WS_GW); const h16* GQD = (const h16*)(a.ws + WS_GQD);
    const h16* GKDT = (const h16*)(a.ws + WS_GKDT); const h16* GIN = (const h16*)(a.ws + WS_GINTRA); const float* GLAST = (const float*)(a.ws + WS_GLAST);
    h16* OG = (h16*)(a.ws + WS_OG);
    const int ct = w >> 1, dt = w & 1;
    f32x4 S0 = (f32x4){0.f, 0.f, 0.f, 0.f}, S1 = S0;
    GdnRegs RA, RB;
#define GDN_LOAD(R, nn) do { const size_t un = (size_t)((b * GNCH + (nn)) * 8 + h); \
        _Pragma("unroll") for (int k = 0; k < 2; ++k) { const int idx = tid + 512 * k; R.rW[k] = *(const u32x4*)(GW + un * 8192 + idx * 8); R.rQ[k] = *(const u32x4*)(GQD + un * 8192 + idx * 8); R.rK[k] = *(const u32x4*)(GKDT + un * 8192 + idx * 8); } \
        R.rI = *(const u32x4*)(GIN + un * 4096 + tid * 8); \
        _Pragma("unroll") for (int i = 0; i < 4; ++i) R.rU[i] = GU[un * 8192 + (16 * ct + 4 * g + i) * 128 + dv0 + 16 * dt + lq]; \
        R.rGl = GLAST[un + zoff]; } while (0)
#define GDN_STORE(R, buf) do { char* ob_ = L + (buf) * OPB; \
        _Pragma("unroll") for (int k = 0; k < 2; ++k) { const int idx = tid + 512 * k; *(u32x4*)(ob_ + (idx >> 4) * 272 + (idx & 15) * 16) = R.rW[k]; *(u32x4*)(ob_ + O_QD + (idx >> 4) * 272 + (idx & 15) * 16) = R.rQ[k]; \
            *(u32x4*)(ob_ + O_KDT + (idx >> 3) * 144 + (idx & 7) * 16) = R.rK[k]; } \
        *(u32x4*)(ob_ + O_IN + (tid >> 3) * 144 + (tid & 7) * 16) = R.rI; } while (0)
#define FR8(p) mk8(*(const h16x4*)(p), *(const h16x4*)((p) + 32))
#define GDN_STEP(n, cur, RN, RF) do { \
        const char* ob = L + (cur) * OPB; const char* sh = L + O_SH + (cur) * SHB; char* shn = L + O_SH + ((cur) ^ 1) * SHB; char* VN = L + O_VN; \
        GDN_LOAD(RF, ((n) + 2 < GNCH ? (n) + 2 : GNCH - 1));     \
        f32x4 a0 = (f32x4){0.f, 0.f, 0.f, 0.f}, a1 = a0; \
        _Pragma("unroll") for (int kk = 0; kk < 4; kk += 2) { const char* ap = ob + (16 * ct + lq) * 272 + (32 * kk + 4 * g) * 2; const char* bp = sh + (16 * dt + lq) * 264 + (32 * kk + 4 * g) * 2; \
            a0 = MFMA16(FR8(ap), FR8(bp), a0); a1 = MFMA16(FR8(ap + 64), FR8(bp + 64), a1); } \
        { h16x4 vn; _Pragma("unroll") for (int i = 0; i < 4; ++i) vn[i] = (h16)(uv[i] - (a0[i] + a1[i])); \
          *(h16x4*)(VN + (16 * dt + lq) * 136 + (16 * ct + 4 * g) * 2) = vn; } \
        f32x4 o0 = (f32x4){0.f, 0.f, 0.f, 0.f}, o1 = o0; \
        _Pragma("unroll") for (int kk = 0; kk < 4; kk += 2) { const char* ap = ob + O_QD + (16 * ct + lq) * 272 + (32 * kk + 4 * g) * 2; const char* bp = sh + (16 * dt + lq) * 264 + (32 * kk + 4 * g) * 2; \
            o0 = MFMA16(FR8(ap), FR8(bp), o0); o1 = MFMA16(FR8(ap + 64), FR8(bp + 64), o1); } \
        LBAR(); \
        { const char* ap = ob + O_IN + (16 * ct + lq) * 144 + (4 * g) * 2; const char* bp = VN + (16 * dt + lq) * 136 + (4 * g) * 2; \
          o0 = MFMA16(FR8(ap), FR8(bp), o0); o1 = MFMA16(FR8(ap + 64), FR8(bp + 64), o1); } \
        S0 = S0 * gl; S1 = S1 * gl; \
        _Pragma("unroll") for (int kk = 0; kk < 2; ++kk) { const char* ap = ob + O_KDT + (16 * w + lq) * 144 + (32 * kk + 4 * g) * 2; const h16x8 af = FR8(ap); \
            const char* b0 = VN + (lq) * 136 + (32 * kk + 4 * g) * 2; const char* b1 = VN + (16 + lq) * 136 + (32 * kk + 4 * g) * 2; \
            S0 = MFMA16(af, FR8(b0), S0); S1 = MFMA16(af, FR8(b1), S1); } \
        { h16* op = OG + (size_t)(b * SEQ + (n) * 64 + 16 * ct + 4 * g) * 1024 + h * 128 + dv0 + 16 * dt + lq; \
          _Pragma("unroll") for (int i = 0; i < 4; ++i) op[(size_t)i * 1024] = (h16)(o0[i] + o1[i]); } \
        { h16x4 s0, s1; _Pragma("unroll") for (int i = 0; i < 4; ++i) { s0[i] = (h16)S0[i]; s1[i] = (h16)S1[i]; } \
          *(h16x4*)(shn + (lq) * 264 + (16 * w + 4 * g) * 2) = s0; *(h16x4*)(shn + (16 + lq) * 264 + (16 * w + 4 * g) * 2) = s1; } \
        { GDN_STORE(RN, (cur) ^ 1); _Pragma("unroll") for (int i = 0; i < 4; ++i) uv[i] = (float)RN.rU[i]; gl = RN.rGl; } \
        LBAR(); } while (0)
    __syncthreads();
    GDN_LOAD(RA, 0); GDN_LOAD(RB, 1);
    { const h16x4 z = (h16x4){(h16)0.f, (h16)0.f, (h16)0.f, (h16)0.f}; *(h16x4*)(L + O_SH + (lq) * 264 + (16 * w + 4 * g) * 2) = z; *(h16x4*)(L + O_SH + (16 + lq) * 264 + (16 * w + 4 * g) * 2) = z; }
    GDN_STORE(RA, 0);
    float uv[4];
#pragma unroll
    for (int i = 0; i < 4; ++i) uv[i] = (float)RA.rU[i];
    float gl = RA.rGl;
    LBAR();
    for (int n = 0; n < GNCH; n += 2) { GDN_STEP(n, 0, RB, RA); GDN_STEP(n + 1, 1, RA, RB); }
#undef GDN_LOAD
#undef GDN_STORE
#undef GDN_STEP
#undef FR8
    __syncthreads();
}
DI void s5_scan_job(const Args& a, int j) {
    const int T = j * NT + threadIdx.x, b = T >> 12, g = (T >> 6) & 63, p = T & 63;
    const float dt = expf(a.in[I_LOGDT][g]); const float lre = a.in[I_LAMRE][g * 64 + p], lim = a.in[I_LAMIM][g * 64 + p];
    const float mag = expf(lre * dt); float sn, cs; sincosf(lim * dt, &sn, &cs); float lr = mag * cs, li = mag * sn;
#pragma unroll
    for (int i = 0; i < 5; ++i) { const float nr = lr * lr - li * li, ni = 2.f * lr * li; lr = nr; li = ni; }
    const float* EC = (const float*)(a.ws + WS_EC) + ((size_t)(g * S5N + b * S5NCH)) * 128 + 2 * p;
    h16* UC = (h16*)(a.ws + WS_UCAT) + ((size_t)(g * S5N + b * S5NCH)) * S5K + 512 + 2 * p;
    float cr = 0.f, ci = 0.f;
    for (int c0 = 0; c0 < S5NCH; c0 += 16) { f32x2 e[16];
#pragma unroll
        for (int k = 0; k < 16; ++k) e[k] = *(const f32x2*)(EC + (size_t)(c0 + k) * 128);
#pragma unroll
        for (int k = 0; k < 16; ++k) { *(unsigned*)(UC + (size_t)(c0 + k) * S5K) = pkh(cr, ci); const float nr = lr * cr - li * ci + e[k].x, ni = lr * ci + li * cr + e[k].y; cr = nr; ci = ni; } }
}
DI void phase_gdn_final(const Args& a) {
    const int tid = threadIdx.x, lane = tid & 63, wave = tid >> 6, gw = blockIdx.x * NWAVES + wave, ngw = gridDim.x * NWAVES;
    const h16* OG = (const h16*)(a.ws + WS_OG); const h16* QKVG = (const h16*)(a.ws + WS_QKVG); h16* MIX = (h16*)(a.ws + WS_MIXIN); const float* nw = a.in[I_NORMW] + ((16 * lane) & 127);
    float nwv[16];
#pragma unroll
    for (int j = 0; j < 16; ++j) nwv[j] = nw[j];
    for (int tA = gw; tA < M; tA += 2 * ngw) { const int tB = tA + ngw < M ? tA + ngw : tA;
        h16x8 o[2][2], gt[2][2];
#pragma unroll
        for (int r = 0; r < 2; ++r) { const size_t t = r ? tB : tA;
#pragma unroll
            for (int q = 0; q < 2; ++q) { o[r][q] = *(const h16x8*)(OG + t * 1024 + 16 * lane + 8 * q); gt[r][q] = *(const h16x8*)(QKVG + t * 4096 + 3072 + 16 * lane + 8 * q); } }
#pragma unroll
        for (int r = 0; r < 2; ++r) { const size_t t = r ? tB : tA; float ss = 0.f;
#pragma unroll
            for (int q = 0; q < 2; ++q)
#pragma unroll
                for (int j = 0; j < 8; ++j) { const float v = (float)o[r][q][j]; ss += v * v; }
            ss += __shfl_xor(ss, 1); ss += __shfl_xor(ss, 2); ss += __shfl_xor(ss, 4);
            const float rinv = 1.0f / sqrtf(ss * (1.f / 128.f) + 1e-6f);
            if (r == 0 || tB != tA) {
#pragma unroll
                for (int q = 0; q < 2; ++q) { float y[8];
#pragma unroll
                    for (int j = 0; j < 8; ++j) y[j] = (float)o[r][q][j] * rinv * nwv[8 * q + j] * siluf_((float)gt[r][q][j]);
                    u32x4 wv; wv.x = pkh(y[0], y[1]); wv.y = pkh(y[2], y[3]); wv.z = pkh(y[4], y[5]); wv.w = pkh(y[6], y[7]);
                    *(u32x4*)(MIX + t * 2048 + 1024 + 16 * lane + 8 * q) = wv; } } }
    }
}

DI void phase_logits(const Args& a) {
    const int tid = threadIdx.x, lane = tid & 63, wave = tid >> 6, g = lane >> 4, lq = lane & 15;
    const h16* XH = (const h16*)(a.ws + WS_XH); const h16* WT = (const h16*)(a.ws + WS_WIN1) + (size_t)5120 * D; float* LOGIT = (float*)(a.ws + WS_LOGIT);
    for (int wu = blockIdx.x * NWAVES + wave; wu < M / 16; wu += gridDim.x * NWAVES) {
        const h16* ap = XH + (size_t)(wu * 16 + lq) * D + 8 * g; const h16* bp = WT + (size_t)lq * D + 8 * g;
        f32x4 c0 = (f32x4){0.f, 0.f, 0.f, 0.f}, c1 = c0;
#pragma unroll 2
        for (int k8 = 0; k8 < 64; k8 += 8) { h16x8 af[8], bf[8];
#pragma unroll
            for (int j = 0; j < 8; ++j) { af[j] = *(const h16x8*)(ap + 32 * (k8 + j)); bf[j] = *(const h16x8*)(bp + 32 * (k8 + j)); }
#pragma unroll
            for (int j = 0; j < 8; j += 2) { c0 = MFMA16(af[j], bf[j], c0); c1 = MFMA16(af[j + 1], bf[j + 1], c1); } }
#pragma unroll
        for (int i = 0; i < 4; ++i) LOGIT[(size_t)(wu * 16 + 4 * g + i) * 16 + lq] = c0[i] + c1[i];
    }
}

struct MoeTiles { int tp[9]; int cnt[8]; };
DI MoeTiles moe_tiles(const Args& a) { MoeTiles t; const unsigned* cnt = (const unsigned*)(a.ws + WS_CTL) + CW_CNT; t.tp[0] = 0;
#pragma unroll
    for (int e = 0; e < 8; ++e) { const int c = (int)__builtin_amdgcn_readfirstlane((int)cnt[e]); t.cnt[e] = c; t.tp[e + 1] = t.tp[e] + ((c + 255) >> 8); }
    return t; }
template <class Sched>
DI void moe_fill_toktab(const Args& a, LAS unsigned char* lds, const Sched& S, const MoeTiles& mt) {
    const int tid = threadIdx.x;
    LAS unsigned short* tt = (LAS unsigned short*)(lds + TOKTAB_OFF); LAS int* info = (LAS int*)(lds + TOKTAB_OFF + TOKTAB_UNITS * 512);
    const int* lst = (const int*)(a.ws + WS_LIST);
    __syncthreads();
    if (tid < TOKTAB_UNITS) { pg8::Unit u; int base = 0, rem = 0;
        if (S.next(tid, u)) { int st = 0, cn = 0;
#pragma unroll
            for (int q = 0; q < 8; ++q) if (q == u.grp) { st = mt.tp[q]; cn = mt.cnt[q]; }
            base = (u.grp << 14) + (u.pm - st) * 256; rem = cn - (u.pm - st) * 256; }
        info[2 * tid] = base; info[2 * tid + 1] = rem; }
    __syncthreads();
    int tok[TOKTAB_UNITS / 2];
#pragma unroll
    for (int k = 0; k < TOKTAB_UNITS / 2; ++k) { const int q = tid + NT * k, i = q >> 8, r = q & 255; const int base = info[2 * i], rem = info[2 * i + 1]; tok[k] = lst[base + (r < rem ? r : 0)]; if (r >= rem) tok[k] = 0; }
#pragma unroll
    for (int k = 0; k < TOKTAB_UNITS / 2; ++k) tt[tid + NT * k] = (unsigned short)tok[k];
    __syncthreads();
}

enum { PH_PRO, PH_H0, PH_DIL, PH_SB, PH_WOUT0, PH_LN1, PH_FFUP, PH_FFDN, PH_LN2, PH_WIN1, PH_GPRE, PH_GLOC, PH_REC, PH_S5Y, PH_GLU, PH_WOUT1, PH_LN3, PH_MUP, PH_MDN, PH_FINAL, N_PHASES };
#ifndef SKIP_EC
#define SKIP_EC 0
#endif
#ifndef SKIP_GL
#define SKIP_GL 0
#endif
__global__ void __launch_bounds__(NT, 2) hybrid_fwd(Args args) {
    extern __shared__ __attribute__((aligned(16))) unsigned char lds_raw[];
    char* lds = (char*)lds_raw;
    LAS unsigned char* ldsl = (LAS unsigned char*)lds_raw;
    const int tid = threadIdx.x;
    volatile LAS unsigned* MISC = (volatile LAS unsigned*)(ldsl + MISC_OFF);
    if (tid < 64) MISC[tid] = 0u;
    __syncthreads();
    unsigned char* ws = args.ws;
    XcdBarrier bar; bar.bar = (unsigned*)(ws + WS_CTL) + CW_BAR; bar.x = 0; bar.st = nullptr;
    if (N_LAUNCH_MODE == 1) bar = xcd_barrier_post((unsigned*)(ws + WS_CTL) + CW_BAR, MISC + 8);
    const int lo = args.ph_lo, hi = args.ph_hi, G = gridDim.x, bx = blockIdx.x;
#ifndef PH_MASK
#define PH_MASK 0xFFFFFFFu
#endif
#define IN(k) (((PH_MASK >> (k)) & 1u) && lo <= (k) && (k) < hi)
#define SEAM(k) do { if (IN(k) && IN((k) + 1)) xcd_barrier(bar); } while (0)
#ifndef PROBE_PHASE
#define PROBE_PHASE (-1)
#endif
#ifndef PROBE_REPS
#define PROBE_REPS 2
#endif
#define REP(k) _Pragma("unroll 1") for (int _r = 0; _r < ((PROBE_PHASE == (k)) ? PROBE_REPS : 1); ++_r)
    using namespace pg8;
    h16* XH = (h16*)(ws + WS_XH); h16* P = (h16*)args.out;

    if (IN(PH_PRO)) { REP(PH_PRO) phase_prologue(args, lds); } SEAM(PH_PRO);
    if (IN(PH_H0)) { DenseSched S{XH, (const h16*)(ws + WS_WIN0), D, D, M / 256, IN0 / 256, G, bx}; EpiH E{(h16*)(ws + WS_H0), IN0}; gemm_phase(ldsl, D, S, E); if (PROBE_PHASE == PH_H0) gemm_phase(ldsl, D, S, E); } SEAM(PH_H0);
    if (IN(PH_DIL)) { phase_dilated(args, lds); if (PROBE_PHASE == PH_DIL) phase_dilated(args, lds); } SEAM(PH_DIL);
    if (IN(PH_SB)) { REP(PH_SB) phase_sb(args, lds); phase_combine(args); } SEAM(PH_SB);
    if (IN(PH_WOUT0)) { DenseSched S{(const h16*)(ws + WS_O0), (const h16*)(ws + WS_WOUT0), D, D, M / 256, D / 256, G, bx}; EpiRes E{XH, P, D}; gemm_phase(ldsl, D, S, E); } SEAM(PH_WOUT0);
    if (IN(PH_LN1)) { phase_ln<false>(args, lds, P, args.in[I_ELNMG], args.in[I_ELNMB]); if (PROBE_PHASE == PH_LN1) phase_ln<false>(args, lds, P, args.in[I_ELNMG], args.in[I_ELNMB]); } SEAM(PH_LN1);
    if (IN(PH_FFUP)) { DenseSched S{XH, (const h16*)(ws + WS_WFF13), D, D, M / 256, 2 * DFF / 256, G, bx}; EpiSwiGLU E{(h16*)(ws + WS_HFF), DFF, AQ_DROP}; gemm_phase(ldsl, D, S, E); if (PROBE_PHASE == PH_FFUP) gemm_phase(ldsl, D, S, E); } SEAM(PH_FFUP);
    if (IN(PH_FFDN)) { DenseSched S{(const h16*)(ws + WS_HFF), (const h16*)(ws + WS_WFF2), DFF, DFF, M / 256, D / 256, G, bx}; EpiRes E{XH, P, D}; gemm_phase(ldsl, DFF, S, E); if (PROBE_PHASE == PH_FFDN) { EpiRes E{XH, P, D}; gemm_phase(ldsl, DFF, S, E); } } SEAM(PH_FFDN);
    if (IN(PH_LN2)) { phase_ln<false>(args, lds, P, args.in[I_ELNFG], args.in[I_ELNFB]); } SEAM(PH_LN2);
    if (IN(PH_WIN1)) { DenseSched S{XH, (const h16*)(ws + WS_WIN1), D, D, M / 256, 20, G, bx}; EpiIn1 E{(h16*)(ws + WS_UCAT), (h16*)(ws + WS_QKVG), (float*)(ws + WS_LOGIT)}; gemm_phase(ldsl, D, S, E); phase_logits(args); if (PROBE_PHASE == PH_WIN1) gemm_phase(ldsl, D, S, E); phase_logits(args); } SEAM(PH_WIN1);
    if (IN(PH_GPRE)) { GroupSched S{(const h16*)(ws + WS_UCAT), (const h16*)(ws + WS_EPAD), S5K, 512, 2, 1, 64, G, bx, (size_t)S5N * S5K, (size_t)256 * 512}; EpiEC E{(float*)(ws + WS_EC)}; gemm_phase(ldsl, 512, S, E);
                  if (G == 256) { phase_gdn_pre(args, lds, 0, 10752, 0); phase_gdn_pre(args, lds, 10752, M, 128); }
                  else phase_gdn_pre(args, lds, 0, M, 0); } SEAM(PH_GPRE);
    if (IN(PH_GLOC)) { REP(PH_GLOC) phase_gdn_local(args, lds); } SEAM(PH_GLOC);
    if (IN(PH_REC)) { REP(PH_REC) for (int job = bx; job < 80; job += G) { if (job < 64) gdn_recur_job(args, lds, job); else s5_scan_job(args, job - 64); }
                      if (G > 80) { if (bx >= 80) moe_convert(args, lds, MOE_CONV_LATE, NEXP, (bx - 80) * NWAVES + (tid >> 6), (G - 80) * NWAVES); }
                      else moe_convert(args, lds, MOE_CONV_LATE, NEXP, bx * NWAVES + (tid >> 6), G * NWAVES); } SEAM(PH_REC);
    if (IN(PH_S5Y)) { GroupSched S{(const h16*)(ws + WS_UCAT), (const h16*)(ws + WS_TCAT), S5K, S5K, 2, 2, 64, G, bx, (size_t)S5N * S5K, (size_t)512 * S5K}; EpiS5Y E{(const h16*)(ws + WS_UCAT), args.in[I_SSMD], (h16*)(ws + WS_Z)}; gemm_phase(ldsl, S5K, S, E); if (PROBE_PHASE == PH_S5Y) gemm_phase(ldsl, S5K, S, E);
                  phase_gdn_final(args); } SEAM(PH_S5Y);
    if (IN(PH_GLU)) { DenseSched S{(const h16*)(ws + WS_Z), (const h16*)(ws + WS_WGLU), 1024, 1024, M / 256, 4, G, bx}; EpiGLU E{(const h16*)(ws + WS_Z), args.in[I_GLUB], (h16*)(ws + WS_MIXIN)}; gemm_phase(ldsl, 1024, S, E); if (PROBE_PHASE == PH_S5Y) gemm_phase(ldsl, 1024, S, E); } SEAM(PH_GLU);
    if (IN(PH_WOUT1)) { DenseSched S{(const h16*)(ws + WS_MIXIN), (const h16*)(ws + WS_WOUT1), D, D, M / 256, D / 256, G, bx}; EpiRes E{XH, P, D}; gemm_phase(ldsl, D, S, E); } SEAM(PH_WOUT1);
    if (IN(PH_LN3)) { phase_ln<true>(args, lds, P, args.in[I_OLNMG], args.in[I_OLNMB]); } SEAM(PH_LN3);
    if (IN(PH_MUP)) { const MoeTiles mt = moe_tiles(args); MoeGatherSched S{ws + WS_XQ8, ws + WS_MOE13, D, D, 2 * DFE / 256, G, bx, mt.tp[1], mt.tp[2], mt.tp[3], mt.tp[4], mt.tp[5], mt.tp[6], mt.tp[7], mt.tp[8], 1};
                  moe_fill_toktab(args, ldsl, S, mt);
                  EpiSwiGLU8 E{(unsigned char*)(ws + WS_HMOE), DFE, 1.0f / (X8_SCALE * W8_SCALE)}; gemm_phase8(ldsl, D, S, E); if (PROBE_PHASE == PH_MUP) gemm_phase8(ldsl, D, S, E); } SEAM(PH_MUP);
    if (IN(PH_MDN)) { const MoeTiles mt = moe_tiles(args); const int nMt = mt.tp[8], R = (nMt * 8) % 256, pm0 = nMt - R / 8, sp = tail_split8(R); const float ysc = 1.0f / (H8_SCALE * W8_SCALE);
                  MoeSched S{ws + WS_HMOE, ws + WS_MOE2, DFE, DFE, D / 256, G, bx, mt.tp[1], mt.tp[2], mt.tp[3], mt.tp[4], mt.tp[5], mt.tp[6], mt.tp[7], pm0, 1};
                  EpiHs E{(h16*)(ws + WS_XG), D, ysc}; gemm_phase8(ldsl, DFE, S, E); if (PROBE_PHASE == PH_MDN) gemm_phase8(ldsl, DFE, S, E);
                  TailSched T{ws + WS_HMOE, ws + WS_MOE2, DFE, DFE, D / 256, G, bx, pm0, R, sp, DFE / sp, mt.tp[1], mt.tp[2], mt.tp[3], mt.tp[4], mt.tp[5], mt.tp[6], mt.tp[7], 1};
                  EpiSlab ES{(float*)(ws + WS_SLAB), ysc}; gemm_phase8(ldsl, DFE / sp, T, ES); if (PROBE_PHASE == PH_MDN) gemm_phase8(ldsl, DFE / sp, T, ES); } SEAM(PH_MDN);
    if (IN(PH_FINAL)) { const MoeTiles mt = moe_tiles(args); const int nMt = mt.tp[8], R = (nMt * 8) % 256; phase_final(args, nMt - R / 8, R, tail_split8(R), mt.tp[1], mt.tp[2], mt.tp[3], mt.tp[4], mt.tp[5], mt.tp[6], mt.tp[7]); }
#undef IN
#undef SEAM
}

extern "C" void kernel_launch(void* const* d_in, const int* in_sizes, int n_in, void* d_out, int out_size, void* d_ws, size_t ws_size, hipStream_t stream) {
    static int grid = 0;
    if (grid == 0) {
        if (n_in != 34 || out_size != M * D || ws_size < WS_END) { fprintf(stderr, "kernel_launch: unexpected shapes (n_in %d out %d ws %zu need %zu)\n", n_in, out_size, ws_size, (size_t)WS_END); grid = -1; return; }
        int dev = 0, cus = 0, per_cu = 0;
        if (hipGetDevice(&dev) != hipSuccess || hipDeviceGetAttribute(&cus, hipDeviceAttributeMultiprocessorCount, dev) != hipSuccess) { grid = -1; return; }
        if (hipFuncSetAttribute((const void*)hybrid_fwd, hipFuncAttributeMaxDynamicSharedMemorySize, LDS_BYTES) != hipSuccess) { fprintf(stderr, "kernel_launch: hipFuncSetAttribute failed\n"); grid = -1; return; }
        if (hipOccupancyMaxActiveBlocksPerMultiprocessor(&per_cu, (const void*)hybrid_fwd, NT, LDS_BYTES) != hipSuccess || per_cu < 1) fprintf(stderr, "kernel_launch: occupancy query says %d\n", per_cu);
        (void)hipGetLastError();
        grid = cus;
    }
    if (grid < 0) return;
    (void)hipMemsetAsync((char*)d_ws + WS_CTL, 0, CTL_BYTES, stream);
    Args a{};
    for (int i = 0; i < 34; ++i) a.in[i] = (const float*)d_in[i];
    a.out = (float*)d_out; a.ws = (unsigned char*)d_ws;
#if N_LAUNCH_MODE == 1
    a.ph_lo = 0; a.ph_hi = N_PHASES;
    hipLaunchKernelGGL(hybrid_fwd, dim3(grid), dim3(NT), LDS_BYTES, stream, a);
#else
    for (int p = 0; p < N_PHASES; ++p) { a.ph_lo = p; a.ph_hi = p + 1; hipLaunchKernelGGL(hybrid_fwd, dim3(grid), dim3(NT), LDS_BYTES, stream, a); }
#endif
}
```

```cpp
#include <hip/hip_runtime.h>
#include <stdint.h>
#include <stdio.h>

#define LAS __attribute__((address_space(3)))
#define GAS __attribute__((address_space(1)))
#define DI __device__ __forceinline__
typedef _Float16 h16;
typedef _Float16 h16x2 __attribute__((ext_vector_type(2)));
typedef _Float16 h16x4 __attribute__((ext_vector_type(4)));
typedef _Float16 h16x8 __attribute__((ext_vector_type(8)));
typedef float f32x2 __attribute__((ext_vector_type(2)));
typedef float f32x4 __attribute__((ext_vector_type(4)));
typedef unsigned u32x2 __attribute__((ext_vector_type(2)));
typedef unsigned u32x4 __attribute__((ext_vector_type(4)));
typedef short v4i16_t __attribute__((ext_vector_type(4)));

#ifndef N_LAUNCH_MODE
#define N_LAUNCH_MODE 1
#endif
#ifndef DBG_CHECK
#define DBG_CHECK 0
#endif

constexpr int NT = 512, NWAVES = 8;
constexpr int M = 16384, D = 2048, SEQ = 8192;
constexpr int IN0 = 6144, DFF = 5632, IN1 = 5136, IN1P = 5376, DFE = 7168, NEXP = 8;
constexpr float ALPHA = 1.41421356237309515f;
constexpr float QK_SCALE = 0.08838834764831845f;
constexpr int S5L = 32, S5NCH = SEQ / S5L, S5N = 2 * S5NCH  , S5K = 640  ;
constexpr int GDC = 64, GNCH = SEQ / GDC  , GUNITS = 2 * GNCH * 8  ;
constexpr int XG_ROWS = 2 * M + NEXP * 256;

constexpr size_t MiB = 1u << 20;
constexpr size_t WS_CTL = 0, CTL_BYTES = 1 * MiB;
constexpr size_t WS_MOE13 = 1 * MiB;
constexpr size_t WS_MOE2 = 449 * MiB;
constexpr size_t WS_X = 673 * MiB;
constexpr size_t WS_XH = 801 * MiB;
constexpr size_t WS_WIN0 = 865 * MiB;
constexpr size_t WS_WOUT0 = 889 * MiB;
constexpr size_t WS_WFF13 = 897 * MiB;
constexpr size_t WS_WFF2 = 941 * MiB;
constexpr size_t WS_WIN1 = 963 * MiB;
constexpr size_t WS_WGLU = 984 * MiB;
constexpr size_t WS_WOUT1 = 986 * MiB;
constexpr size_t WS_TCAT = 994 * MiB;
constexpr size_t WS_EPAD = 1034 * MiB;
constexpr size_t WS_SCR = 1050 * MiB;
constexpr size_t WS_END = 1792 * MiB;
constexpr size_t WS_H0 = WS_SCR;
constexpr size_t WS_OP = WS_SCR + 192 * MiB;
constexpr size_t WS_LSE = WS_SCR + 288 * MiB;
constexpr size_t WS_O0 = WS_SCR + 290 * MiB;
constexpr size_t WS_HFF = WS_SCR;
constexpr size_t WS_UCAT = WS_SCR;
constexpr size_t WS_QKVG = WS_SCR + 40 * MiB;
constexpr size_t WS_LOGIT = WS_SCR + 168 * MiB;
constexpr size_t WS_EC = WS_SCR + 169 * MiB;
constexpr size_t WS_GU = WS_SCR + 185 * MiB;
constexpr size_t WS_GW = WS_SCR + 217 * MiB;
constexpr size_t WS_GQD = WS_SCR + 249 * MiB;
constexpr size_t WS_GKDT = WS_SCR + 281 * MiB;
constexpr size_t WS_GINTRA = WS_SCR + 313 * MiB;
constexpr size_t WS_GLAST = WS_SCR + 329 * MiB;
constexpr size_t WS_OG = WS_SCR + 330 * MiB;
constexpr size_t WS_Z = WS_SCR + 362 * MiB;
constexpr size_t WS_MIXIN = WS_SCR + 394 * MiB;
constexpr size_t WS_QKVN = WS_SCR + 458 * MiB;
constexpr size_t WS_GB = WS_SCR + 554 * MiB;
constexpr size_t WS_HMOE = WS_SCR;
constexpr size_t WS_XG = WS_SCR + 476 * MiB;
constexpr size_t WS_TOK = WS_SCR + 612 * MiB;
constexpr size_t WS_SLAB = WS_SCR + 614 * MiB;
static_assert((size_t)XG_ROWS * DFE * 2 <= 476 * MiB && (size_t)XG_ROWS * D * 2 <= 136 * MiB && WS_TOK + 1 * MiB <= WS_END, "moe scratch");
static_assert(WS_SLAB + 64 * MiB <= WS_END && WS_MIXIN + 64 * MiB <= WS_END && WS_O0 + 64 * MiB <= WS_END, "scratch");
constexpr int CW_BAR = 0;
constexpr int CW_CNT = 4096;
constexpr int CW_DBG = 8192;

constexpr int MISC_OFF = 155648;
constexpr int LDS_BYTES = MISC_OFF + 1024;
constexpr int TOKTAB_OFF = 131072, TOKTAB_UNITS = 46;
constexpr size_t WS_XQ8 = WS_SCR + 240 * MiB;
constexpr size_t WS_LIST = WS_TOK + 512 * 1024;

DI unsigned pkh(float a, float b) { f32x2 v = {a, b}; return __builtin_bit_cast(unsigned, __builtin_convertvector(v, h16x2)); }
#ifndef WQ_DROP
#define WQ_DROP 4
#endif
#ifndef AQ_DROP
#define AQ_DROP 2
#endif
DI unsigned pka(float a, float b) { const unsigned u = pkh(a, b); if (AQ_DROP == 0) return u; constexpr unsigned H = (1u << (AQ_DROP - 1)) * 0x00010001u, Mk = ~(((1u << AQ_DROP) - 1u) * 0x00010001u); return (u + H) & Mk; }
DI unsigned rnd_drop(unsigned u, int drop) { if (drop <= 0) return u; const unsigned h = (1u << (drop - 1)) * 0x00010001u, mk = ~(((1u << drop) - 1u) * 0x00010001u); return (u + h) & mk; }
#ifndef WQ_MOE
#define WQ_MOE 5
#endif
#ifndef AQ_MOE
#define AQ_MOE 4
#endif
DI unsigned pkw(float a, float b) { const unsigned u = pkh(a, b); if (WQ_DROP == 0) return u; constexpr unsigned H = (1u << (WQ_DROP - 1)) * 0x00010001u, Mk = ~(((1u << WQ_DROP) - 1u) * 0x00010001u); return (u + H) & Mk; }
DI float wave_sum(float v) {
#pragma unroll
    for (int o = 32; o >= 1; o >>= 1) v += __shfl_xor(v, o);
    return v;
}
DI float fast_rcp(float x) { return __builtin_amdgcn_rcpf(x); }
DI float sigmoidf_(float x) { return fast_rcp(1.0f + __expf(-x)); }
DI float siluf_(float x) { return x * sigmoidf_(x); }
DI float softplusf_(float z) { return fmaxf(z, 0.f) + __logf(1.0f + __expf(-fabsf(z))); }
DI h16x8 mk8(h16x4 a, h16x4 b) { return __builtin_shufflevector(a, b, 0, 1, 2, 3, 4, 5, 6, 7); }
DI h16x4 trread(const char* p) { return __builtin_bit_cast(h16x4, __builtin_amdgcn_ds_read_tr16_b64_v4i16((LAS v4i16_t*)p)); }
#define MFMA16(a, b, c) __builtin_amdgcn_mfma_f32_16x16x32_f16((a), (b), (c), 0, 0, 0)
#define LBAR() do { asm volatile("s_waitcnt lgkmcnt(0)" ::: "memory"); __builtin_amdgcn_s_barrier(); asm volatile("" ::: "memory"); } while (0)

#define XB_TMO      128
#define XB_XCNT(j)  (256  + 64 * (j))
#define XB_XSUB(j)  (1280 + 64 * (j))
#define XB_XGEN(j)  (2304 + 64 * (j))
#define XB_TOP      3328
#define XB_TOPGEN   3392
#define XCD_BAR_WORDS 3456
#define XB_SPIN_CAP (1u << 22)
__device__ __forceinline__ unsigned xb_ld(unsigned* p)              { return __hip_atomic_load(p, __ATOMIC_RELAXED, __HIP_MEMORY_SCOPE_AGENT); }
__device__ __forceinline__ unsigned xb_add(unsigned* p, unsigned v) { return __hip_atomic_fetch_add(p, v, __ATOMIC_RELAXED, __HIP_MEMORY_SCOPE_AGENT); }
__device__ __forceinline__ unsigned xb_xcc_id() { return (unsigned)__builtin_amdgcn_s_getreg((3 << 11) | 20) & 0xFu; }
#define XB_SPIN(cond, bar) do { unsigned _sp = 0; while (cond) { __builtin_amdgcn_s_sleep(1); \
    if ((++_sp & 255u) == 0u) { if (xb_ld(&(bar)[XB_TMO])) break; if (_sp > XB_SPIN_CAP) { atomicAdd(&(bar)[XB_TMO], 1u); break; } } } } while (0)
struct XcdBarrier { unsigned* bar; unsigned x; volatile LAS unsigned* st; };
__device__ __forceinline__ XcdBarrier xcd_barrier_post(unsigned* bar, volatile LAS unsigned* st) {
    XcdBarrier b; b.bar = bar; b.x = xb_xcc_id(); b.st = st;
    if (threadIdx.x == 0) (void)xb_add(&bar[XB_XCNT(b.x)], 1u);
    return b;
}
__device__ __forceinline__ void xcd_barrier_complete(unsigned* bar, unsigned x, unsigned& nloc, unsigned& nx) {
    const unsigned G = gridDim.x * gridDim.y * gridDim.z;
    unsigned sum, cnt, mine, sp = 0u;
    for (;;) {
        sum = 0u; cnt = 0u; mine = 0u;
#pragma unroll
        for (unsigned j = 0; j < 16; ++j) { const unsigned c = xb_ld(&bar[XB_XCNT(j)]); sum += c; cnt += (c > 0u) ? 1u : 0u; mine = (j == x) ? c : mine; }
        if (sum == G) break;
        __builtin_amdgcn_s_sleep(1);
        if ((++sp & 255u) == 0u) { if (xb_ld(&bar[XB_TMO])) break; if (sp > XB_SPIN_CAP) { atomicAdd(&bar[XB_TMO], 1u); break; } }
    }
    nloc = mine > 0u ? mine : 1u; nx = cnt > 0u ? cnt : 1u;
}
__device__ __forceinline__ void xcd_barrier(const XcdBarrier& b) {
    asm volatile("s_waitcnt vmcnt(0)" ::: "memory");
    __syncthreads();
    if (threadIdx.x == 0) {
        unsigned* bar = b.bar;
        __builtin_amdgcn_s_waitcnt(0);
        unsigned nloc = b.st[0], nx = b.st[1];
        if (nloc == 0u) { xcd_barrier_complete(bar, b.x, nloc, nx); b.st[0] = nloc; b.st[1] = nx; }
        const unsigned old = xb_add(&bar[XB_XSUB(b.x)], 1u);
        const unsigned gen = old / nloc;
        if (old + 1u == (gen + 1u) * nloc) {
            __builtin_amdgcn_fence(__ATOMIC_RELEASE, "agent");
            asm volatile("s_waitcnt vmcnt(0)" ::: "memory");
            const unsigned og = xb_add(&bar[XB_TOP], 1u);
            const unsigned tg = og / nx;
            if (og + 1u == (tg + 1u) * nx) xb_add(&bar[XB_TOPGEN], 1u);
            else XB_SPIN(xb_ld(&bar[XB_TOPGEN]) == tg, bar);
            __builtin_amdgcn_fence(__ATOMIC_ACQUIRE, "agent");
            xb_add(&bar[XB_XGEN(b.x)], 1u);
            asm volatile("s_waitcnt vmcnt(0)" ::: "memory");
        } else {
            XB_SPIN(xb_ld(&bar[XB_XGEN(b.x)]) == gen, bar);
            __builtin_amdgcn_fence(__ATOMIC_ACQUIRE, "agent");
            asm volatile("s_waitcnt vmcnt(0)" ::: "memory");
        }
    }
    __syncthreads();
}

namespace pg8 {
constexpr int BM = 256, BK = 64, HALF = 128, HTB = HALF * BK * 2, STAGE_BYTES = 8 * HTB, NXCD = 8, WGM = 8;
__host__ __device__ __forceinline__ int lds_byte(int r, int c) { const int st = (r >> 4) * 2 + (c >> 5), rr = r & 15, cc = c & 31, ob = rr * 64 + cc * 2; return st * 1024 + (ob ^ (((ob >> 9) & 1) << 5)); }
__host__ __device__ __forceinline__ void stage_rc(int b, int& R, int& C) { const int st = b / 1024, sb = b % 1024, swz = sb ^ (((sb >> 9) & 1) << 5); R = (st >> 1) * 16 + swz / 64; C = (st & 1) * 32 + (swz % 64) / 2; }
__host__ __device__ __forceinline__ int perm32(int rho) { const int n = rho >> 4, i = rho & 15; return 8 * (i >> 2) + 4 * n + (i & 3); }
struct Unit { int pm, pn, pc, grp, aux; };
typedef __bf16 bf16x8_t __attribute__((ext_vector_type(8)));
typedef int v8i_t __attribute__((ext_vector_type(8)));
typedef int v4i_t __attribute__((ext_vector_type(4)));
DI v8i_t cat8(h16x8 a, h16x8 b) { const v4i_t x = __builtin_bit_cast(v4i_t, a), y = __builtin_bit_cast(v4i_t, b); return __builtin_shufflevector(x, y, 0, 1, 2, 3, 4, 5, 6, 7); }
template <bool BF16> DI f32x4 mma_op(h16x8 a, h16x8 b, f32x4 c) {
    if constexpr (BF16) return __builtin_amdgcn_mfma_f32_16x16x32_bf16(__builtin_bit_cast(bf16x8_t, a), __builtin_bit_cast(bf16x8_t, b), c, 0, 0, 0);
    else return __builtin_amdgcn_mfma_f32_16x16x32_f16(a, b, c, 0, 0, 0); }

DI bool tile_order(int i, int G, int c, int nM, int nN, int& pm, int& pn) {
    const int nwg = nM * nN; const long L = (long)i * G + c; if (L >= nwg) return false;
    int wgid = (int)L; { const int q = nwg / NXCD, r = nwg % NXCD, xcd = wgid % NXCD, off = wgid / NXCD; wgid = (xcd < r ? xcd * (q + 1) : r * (q + 1) + (xcd - r) * q) + off; }
    const int nig = WGM * nN, gid = wgid / nig, fm = gid * WGM, gsz = (nM - fm) < WGM ? (nM - fm) : WGM;
    pm = fm + ((wgid % nig) % gsz); pn = (wgid % nig) / gsz; return true;
}
struct DenseSched {
    static constexpr bool GATHER = false; const h16* A; const h16* Bt; int lda, ldb, nM, nN, G, c;
    DI bool next(int i, Unit& u) const { int pm, pn; if (!tile_order(i, G, c, nM, nN, pm, pn)) return false; u.pm = pm; u.pn = pn; u.pc = pn; u.grp = 0; return true; }
    DI const char* a_base(const Unit& u) const { return (const char*)A + (size_t)u.pm * 256 * lda * 2; }
    DI const char* b_base(const Unit& u) const { return (const char*)Bt + (size_t)u.pn * 256 * ldb * 2; }
};
struct GroupSched {
    static constexpr bool GATHER = false; const h16* A; const h16* Bt; int lda, ldb, nM, nN, ngrp, G, c; size_t strideA, strideB;
    DI bool next(int i, Unit& u) const { const long L = (long)i * G + c; const int per = nM * nN; if (L >= (long)per * ngrp) return false;
        const int g = (int)L / per, r = (int)L % per; u.grp = g; u.pm = r % nM; u.pn = r / nM; u.pc = u.pn; return true; }
    DI const char* a_base(const Unit& u) const { return (const char*)(A + (size_t)u.grp * strideA) + (size_t)u.pm * 256 * lda * 2; }
    DI const char* b_base(const Unit& u) const { return (const char*)(Bt + (size_t)u.grp * strideB) + (size_t)u.pn * 256 * ldb * 2; }
};
struct MoeSched {
    static constexpr bool GATHER = false; const void* A; const void* Bt; int lda, ldb, nN, G, c; int tp1, tp2, tp3, tp4, tp5, tp6, tp7, tp8; int esz;
    DI bool next(int i, Unit& u) const { int pm, pn; if (!tile_order(i, G, c, tp8, nN, pm, pn)) return false;
        const int e = (pm >= tp1) + (pm >= tp2) + (pm >= tp3) + (pm >= tp4) + (pm >= tp5) + (pm >= tp6) + (pm >= tp7);
        u.pm = pm; u.pc = pn; u.grp = e; u.pn = e * nN + pn; return true; }
    DI const char* a_base(const Unit& u) const { return (const char*)A + (size_t)u.pm * 256 * lda * esz; }
    DI const char* b_base(const Unit& u) const { return (const char*)Bt + (size_t)u.pn * 256 * ldb * esz; }
};

struct MoeGatherSched {
    static constexpr bool GATHER = true; const void* A; const void* Bt; int lda, ldb, nN, G, c; int tp1, tp2, tp3, tp4, tp5, tp6, tp7, tp8; int esz;
    DI bool next(int i, Unit& u) const { int pm, pn; if (!tile_order(i, G, c, tp8, nN, pm, pn)) return false;
        const int e = (pm >= tp1) + (pm >= tp2) + (pm >= tp3) + (pm >= tp4) + (pm >= tp5) + (pm >= tp6) + (pm >= tp7);
        u.pm = pm; u.pc = pn; u.grp = e; u.pn = e * nN + pn; return true; }
    DI const char* a_base(const Unit&) const { return (const char*)A; }
    DI const char* b_base(const Unit& u) const { return (const char*)Bt + (size_t)u.pn * 256 * ldb * esz; }
};
struct TailSched {
    static constexpr bool GATHER = false; const void* A; const void* Bt; int lda, ldb, nN, G, c, pm0, R, s, Ks; int tp1, tp2, tp3, tp4, tp5, tp6, tp7; int esz;
    DI bool next(int i, Unit& u) const { const long L = (long)i * G + c; if (L >= (long)R * s) return false; const int tile = (int)L / s, ks = (int)L % s, pm = pm0 + tile / nN, pn = tile % nN;
        const int e = (pm >= tp1) + (pm >= tp2) + (pm >= tp3) + (pm >= tp4) + (pm >= tp5) + (pm >= tp6) + (pm >= tp7);
        u.pm = pm; u.pc = pn; u.grp = e; u.pn = e * nN + pn; u.aux = ks * R + tile; return true; }
    DI const char* a_base(const Unit& u) const { return (const char*)A + (size_t)u.pm * 256 * lda * esz + (size_t)(u.aux / R) * Ks * esz; }
    DI const char* b_base(const Unit& u) const { return (const char*)Bt + (size_t)u.pn * 256 * ldb * esz + (size_t)(u.aux / R) * Ks * esz; }
};
DI int tail_split8(int R) { const int q = R > 0 ? 256 / R : 0; return q >= 14 ? 14 : q >= 7 ? 7 : q >= 4 ? 4 : q >= 2 ? 2 : 1; }
DI int tail_split(int R) { const int q = R > 0 ? 256 / R : 0; return q >= 28 ? 28 : q >= 14 ? 14 : q >= 8 ? 8 : q >= 7 ? 7 : q >= 4 ? 4 : q >= 2 ? 2 : 1; }

template <class Epi, class Sched, bool BF16 = false>
__device__ __forceinline__ void gemm_phase(LAS unsigned char* lds, const int K, const Sched& S, const Epi& E) {
    const int tid = threadIdx.x, wid = __builtin_amdgcn_readfirstlane(tid >> 6), lane = tid & 63, wr = wid >> 2, wc = wid & 3, fr = lane & 15, fq = lane >> 4;
    const int nt = K / BK; const int lda = S.lda, ldb = S.ldb;
    unsigned voffA[2], voffB[2]; int gR[2], gC[2];
#pragma unroll
    for (int i = 0; i < 2; ++i) { int R, C; stage_rc(tid * 16 + i * 8192, R, C); const int Rb = Epi::PERM ? ((R & ~31) + perm32(R & 31)) : R; gR[i] = R; gC[i] = C;
        voffA[i] = (unsigned)(R * lda + C) * 2u; voffB[i] = (unsigned)(Rb * ldb + C) * 2u; }
    const size_t kstep = (size_t)(BK * 2);
    const size_t hstepA = Sched::GATHER ? (size_t)0 : (size_t)HALF * lda * 2, hstepB = (size_t)HALF * ldb * 2;
    unsigned voC[2][2], voN[2][2];
#define PG8_GOFF(dst, unit_) do { if constexpr (Sched::GATHER) { const LAS unsigned short* tt_ = (const LAS unsigned short*)(lds + TOKTAB_OFF) + (unit_) * 256; _Pragma("unroll") for (int h_ = 0; h_ < 2; ++h_) _Pragma("unroll") for (int i_ = 0; i_ < 2; ++i_) \
        dst[h_][i_] = ((unsigned)tt_[128 * h_ + gR[i_]] * (unsigned)lda + (unsigned)gC[i_]) * 2u; } } while (0)
#define PG8_STAGE_A(b, h, gbase, vset) do { if constexpr (Sched::GATHER) { PG8_STAGE(PG8_SA(b, h), gbase, vset[h]); } else { PG8_STAGE(PG8_SA(b, h), (gbase) + (h) * hstepA, voffA); } } while (0)
    const unsigned ldsw = (unsigned)wid * 1024u;
    const int aoff = lds_byte(wr * 64 + fr, fq * 8), boff = lds_byte(wc * 32 + fr, fq * 8);
#define PG8_SA(b, h) (((b) * 2 + (h)) * HTB)
#define PG8_SB(b, h) ((4 + (b) * 2 + (h)) * HTB)
#define PG8_STAGE(bufoff, gbase, voff) do { _Pragma("unroll") for (int _i = 0; _i < 2; ++_i) \
        __builtin_amdgcn_global_load_lds((const unsigned*)((const char*)(gbase) + (voff)[_i]), (LAS unsigned*)(lds + (bufoff) + ldsw + _i * 8192), 16, 0, 0); } while (0)
#define PG8_LDA(dst, b, h) do { _Pragma("unroll") for (int m = 0; m < 4; ++m) _Pragma("unroll") for (int k = 0; k < 2; ++k) dst[m][k] = *(const LAS h16x8*)(lds + PG8_SA(b, h) + aoff + m * 2048 + k * 1024); } while (0)
#define PG8_LDB(dst, b, h) do { _Pragma("unroll") for (int n = 0; n < 2; ++n) _Pragma("unroll") for (int k = 0; k < 2; ++k) dst[n][k] = *(const LAS h16x8*)(lds + PG8_SB(b, h) + boff + n * 2048 + k * 1024); } while (0)
#define PG8_MMA(ai, bj, At, Bt) do { __builtin_amdgcn_s_setprio(1); _Pragma("unroll") for (int m = 0; m < 4; ++m) _Pragma("unroll") for (int n = 0; n < 2; ++n) _Pragma("unroll") for (int k = 0; k < 2; ++k) \
        acc[ai][bj][m][n] = mma_op<BF16>(Bt[n][k], At[m][k], acc[ai][bj][m][n]); __builtin_amdgcn_s_setprio(0); } while (0)
#define PG8_WAIT_V(n) asm volatile("s_waitcnt vmcnt(" #n ")" ::: "memory")
#define PG8_WAIT_L(n) asm volatile("s_waitcnt lgkmcnt(" #n ")" ::: "memory")
#define PG8_BAR __builtin_amdgcn_s_barrier()
#define PG8_SCHED __builtin_amdgcn_sched_barrier(0)
    Unit cur, nxt; int ui = 0;
    if (!S.next(0, cur)) return;
    f32x4 acc[2][2][4][2];
#pragma unroll
    for (int a = 0; a < 2; ++a)
#pragma unroll
        for (int b = 0; b < 2; ++b)
#pragma unroll
            for (int m = 0; m < 4; ++m)
#pragma unroll
                for (int n = 0; n < 2; ++n) acc[a][b][m][n] = (f32x4){0.f, 0.f, 0.f, 0.f};
    h16x8 At[4][2], B0[2][2], B1[2][2];
    const char* cA = S.a_base(cur); const char* cB = S.b_base(cur);
    PG8_GOFF(voC, 0);
    PG8_STAGE(PG8_SB(0, 0), cB, voffB); PG8_STAGE(PG8_SB(0, 1), cB + hstepB, voffB); PG8_STAGE_A(0, 0, cA, voC); PG8_STAGE_A(0, 1, cA, voC);
    if (wr == 1) PG8_BAR;
    PG8_WAIT_V(2); PG8_BAR;
    PG8_STAGE(PG8_SB(1, 0), cB + kstep, voffB); PG8_STAGE_A(1, 0, cA + kstep, voC); PG8_STAGE(PG8_SB(1, 1), cB + hstepB + kstep, voffB);
    PG8_WAIT_V(6); PG8_BAR;
    for (;;) {
        const bool has_next = S.next(ui + 1, nxt);
        const char* nA = has_next ? S.a_base(nxt) : cA; const char* nB = has_next ? S.b_base(nxt) : cB;
        PG8_GOFF(voN, has_next ? ui + 1 : ui);
        for (int t = 0; t < nt; t += 2) {
            const bool last = (t == nt - 2);
            unsigned vo2[2][2];
            if constexpr (Sched::GATHER) {
#pragma unroll
                for (int h_ = 0; h_ < 2; ++h_)
#pragma unroll
                    for (int i_ = 0; i_ < 2; ++i_) vo2[h_][i_] = last ? voN[h_][i_] : voC[h_][i_]; }
            const char* a1 = cA + (size_t)(t + 1) * kstep;
            const char* a2 = last ? nA : cA + (size_t)(t + 2) * kstep; const char* b2 = last ? nB : cB + (size_t)(t + 2) * kstep;
            const char* a3 = a2 + kstep; const char* b3 = b2 + kstep;
            PG8_LDB(B0, 0, 0); PG8_LDB(B1, 0, 1); PG8_SCHED; PG8_LDA(At, 0, 0); PG8_STAGE_A(1, 1, a1, voC);
            PG8_WAIT_V(8); PG8_WAIT_L(0); PG8_BAR; PG8_MMA(0, 0, At, B0); PG8_MMA(0, 1, At, B1); PG8_BAR; PG8_SCHED;
            PG8_LDA(At, 0, 1); PG8_STAGE(PG8_SB(0, 0), b2, voffB); PG8_STAGE(PG8_SB(0, 1), b2 + hstepB, voffB); PG8_STAGE_A(0, 0, a2, vo2);
            PG8_WAIT_V(8); PG8_WAIT_L(0); PG8_BAR; PG8_MMA(1, 0, At, B0); PG8_MMA(1, 1, At, B1); PG8_BAR; PG8_SCHED;
            PG8_LDB(B0, 1, 0); PG8_LDB(B1, 1, 1); PG8_SCHED; PG8_LDA(At, 1, 0); PG8_STAGE_A(0, 1, a2, vo2);
            PG8_WAIT_V(8); PG8_WAIT_L(0); PG8_BAR; PG8_MMA(0, 0, At, B0); PG8_MMA(0, 1, At, B1); PG8_BAR; PG8_SCHED;
            PG8_LDA(At, 1, 1); PG8_STAGE(PG8_SB(1, 0), b3, voffB); PG8_STAGE(PG8_SB(1, 1), b3 + hstepB, voffB); PG8_STAGE_A(1, 0, a3, vo2);
            PG8_WAIT_V(8); PG8_WAIT_L(0); PG8_BAR; PG8_MMA(1, 0, At, B0); PG8_MMA(1, 1, At, B1); PG8_BAR; PG8_SCHED;
        }
        if (wr == 0) PG8_BAR;
        E(acc, cur, wr, wc, fr, fq);
        if (!has_next) break;
#pragma unroll
        for (int a = 0; a < 2; ++a)
#pragma unroll
            for (int b = 0; b < 2; ++b)
#pragma unroll
                for (int m = 0; m < 4; ++m)
#pragma unroll
                    for (int n = 0; n < 2; ++n) acc[a][b][m][n] = (f32x4){0.f, 0.f, 0.f, 0.f};
        cur = nxt; cA = nA; cB = nB; ++ui;
        if constexpr (Sched::GATHER) {
#pragma unroll
            for (int h_ = 0; h_ < 2; ++h_)
#pragma unroll
                for (int i_ = 0; i_ < 2; ++i_) voC[h_][i_] = voN[h_][i_]; }
        if (wr == 1) PG8_BAR;
    }
    PG8_WAIT_V(0);
    PG8_BAR;
#undef PG8_SA
#undef PG8_GOFF
#undef PG8_STAGE_A
#undef PG8_SB
#undef PG8_STAGE
#undef PG8_LDA
#undef PG8_LDB
#undef PG8_MMA
#undef PG8_WAIT_V
#undef PG8_WAIT_L
#undef PG8_BAR
#undef PG8_SCHED
}
template <class Epi, class Sched>
__device__ __forceinline__ void gemm_phase8(LAS unsigned char* lds, const int K, const Sched& S, const Epi& E) {
    const int tid = threadIdx.x, wid = __builtin_amdgcn_readfirstlane(tid >> 6), lane = tid & 63, wr = wid >> 2, wc = wid & 3, fr = lane & 15, fq = lane >> 4;
    const int nt = K / (2 * BK); const int lda = S.lda, ldb = S.ldb;
    unsigned voffA[2], voffB[2]; int gR[2], gC[2];
#pragma unroll
    for (int i = 0; i < 2; ++i) { int R, C; stage_rc(tid * 16 + i * 8192, R, C); const int Rb = Epi::PERM ? ((R & ~31) + perm32(R & 31)) : R; gR[i] = R; gC[i] = C;
        voffA[i] = (unsigned)(R * lda + C * 2); voffB[i] = (unsigned)(Rb * ldb + C * 2); }
    const size_t kstep = (size_t)(BK * 2);
    const size_t hstepA = Sched::GATHER ? (size_t)0 : (size_t)HALF * lda, hstepB = (size_t)HALF * ldb;
    unsigned voC[2][2], voN[2][2];
#define PG8_GOFF(dst, unit_) do { if constexpr (Sched::GATHER) { const LAS unsigned short* tt_ = (const LAS unsigned short*)(lds + TOKTAB_OFF) + (unit_) * 256; _Pragma("unroll") for (int h_ = 0; h_ < 2; ++h_) _Pragma("unroll") for (int i_ = 0; i_ < 2; ++i_) \
        dst[h_][i_] = (unsigned)tt_[128 * h_ + gR[i_]] * (unsigned)lda + (unsigned)gC[i_] * 2u; } } while (0)
#define PG8_STAGE_A(b, h, gbase, vset) do { if constexpr (Sched::GATHER) { PG8_STAGE(PG8_SA(b, h), gbase, vset[h]); } else { PG8_STAGE(PG8_SA(b, h), (gbase) + (h) * hstepA, voffA); } } while (0)
    const unsigned ldsw = (unsigned)wid * 1024u;
    const int aoff = lds_byte(wr * 64 + fr, fq * 8), boff = lds_byte(wc * 32 + fr, fq * 8);
    int sc127 = 127; asm volatile("" : "+v"(sc127));
#define PG8_SA(b, h) (((b) * 2 + (h)) * HTB)
#define PG8_SB(b, h) ((4 + (b) * 2 + (h)) * HTB)
#define PG8_STAGE(bufoff, gbase, voff) do { _Pragma("unroll") for (int _i = 0; _i < 2; ++_i) \
        __builtin_amdgcn_global_load_lds((const unsigned*)((const char*)(gbase) + (voff)[_i]), (LAS unsigned*)(lds + (bufoff) + ldsw + _i * 8192), 16, 0, 0); } while (0)
#define PG8_LDA(dst, b, h) do { _Pragma("unroll") for (int m = 0; m < 4; ++m) _Pragma("unroll") for (int k = 0; k < 2; ++k) dst[m][k] = *(const LAS h16x8*)(lds + PG8_SA(b, h) + aoff + m * 2048 + k * 1024); } while (0)
#define PG8_LDB(dst, b, h) do { _Pragma("unroll") for (int n = 0; n < 2; ++n) _Pragma("unroll") for (int k = 0; k < 2; ++k) dst[n][k] = *(const LAS h16x8*)(lds + PG8_SB(b, h) + boff + n * 2048 + k * 1024); } while (0)
#define PG8_MMA(ai, bj, At, Bt) do { __builtin_amdgcn_s_setprio(1); _Pragma("unroll") for (int m = 0; m < 4; ++m) _Pragma("unroll") for (int n = 0; n < 2; ++n) \
        asm volatile("v_mfma_scale_f32_16x16x128_f8f6f4 %0, %1, %2, %0, %3, %3 op_sel_hi:[0,0,0]" : "+v"(acc[ai][bj][m][n]) : "v"(cat8(Bt[n][0], Bt[n][1])), "v"(cat8(At[m][0], At[m][1])), "v"(sc127)); \
        __builtin_amdgcn_s_setprio(0); } while (0)
#define PG8_WAIT_V(n) asm volatile("s_waitcnt vmcnt(" #n ")" ::: "memory")
#define PG8_WAIT_L(n) asm volatile("s_waitcnt lgkmcnt(" #n ")" ::: "memory")
#define PG8_BAR __builtin_amdgcn_s_barrier()
#define PG8_SCHED __builtin_amdgcn_sched_barrier(0)
    Unit cur, nxt; int ui = 0;
    if (!S.next(0, cur)) return;
    f32x4 acc[2][2][4][2];
#pragma unroll
    for (int a = 0; a < 2; ++a)
#pragma unroll
        for (int b = 0; b < 2; ++b)
#pragma unroll
            for (int m = 0; m < 4; ++m)
#pragma unroll
                for (int n = 0; n < 2; ++n) acc[a][b][m][n] = (f32x4){0.f, 0.f, 0.f, 0.f};
    h16x8 At[4][2], B0[2][2], B1[2][2];
    const char* cA = S.a_base(cur); const char* cB = S.b_base(cur);
    PG8_GOFF(voC, 0);
    PG8_STAGE(PG8_SB(0, 0), cB, voffB); PG8_STAGE(PG8_SB(0, 1), cB + hstepB, voffB); PG8_STAGE_A(0, 0, cA, voC); PG8_STAGE_A(0, 1, cA, voC);
    if (wr == 1) PG8_BAR;
    PG8_WAIT_V(2); PG8_BAR;
    PG8_STAGE(PG8_SB(1, 0), cB + kstep, voffB); PG8_STAGE_A(1, 0, cA + kstep, voC); PG8_STAGE(PG8_SB(1, 1), cB + hstepB + kstep, voffB);
    PG8_WAIT_V(6); PG8_BAR;
    for (;;) {
        const bool has_next = S.next(ui + 1, nxt);
        const char* nA = has_next ? S.a_base(nxt) : cA; const char* nB = has_next ? S.b_base(nxt) : cB;
        PG8_GOFF(voN, has_next ? ui + 1 : ui);
        for (int t = 0; t < nt; t += 2) {
            const bool last = (t == nt - 2);
            unsigned vo2[2][2];
            if constexpr (Sched::GATHER) {
#pragma unroll
                for (int h_ = 0; h_ < 2; ++h_)
#pragma unroll
                    for (int i_ = 0; i_ < 2; ++i_) vo2[h_][i_] = last ? voN[h_][i_] : voC[h_][i_]; }
            const char* a1 = cA + (size_t)(t + 1) * kstep;
            const char* a2 = last ? nA : cA + (size_t)(t + 2) * kstep; const char* b2 = last ? nB : cB + (size_t)(t + 2) * kstep;
            const char* a3 = a2 + kstep; const char* b3 = b2 + kstep;
            PG8_LDB(B0, 0, 0); PG8_LDB(B1, 0, 1); PG8_SCHED; PG8_LDA(At, 0, 0); PG8_STAGE_A(1, 1, a1, voC);
            PG8_WAIT_V(8); PG8_WAIT_L(0); PG8_BAR; PG8_MMA(0, 0, At, B0); PG8_MMA(0, 1, At, B1); PG8_BAR; PG8_SCHED;
            PG8_LDA(At, 0, 1); PG8_STAGE(PG8_SB(0, 0), b2, voffB); PG8_STAGE(PG8_SB(0, 1), b2 + hstepB, voffB); PG8_STAGE_A(0, 0, a2, vo2);
            PG8_WAIT_V(8); PG8_WAIT_L(0); PG8_BAR; PG8_MMA(1, 0, At, B0); PG8_MMA(1, 1, At, B1); PG8_BAR; PG8_SCHED;
            PG8_LDB(B0, 1, 0); PG8_LDB(B1, 1, 1); PG8_SCHED; PG8_LDA(At, 1, 0); PG8_STAGE_A(0, 1, a2, vo2);
            PG8_WAIT_V(8); PG8_WAIT_L(0); PG8_BAR; PG8_MMA(0, 0, At, B0); PG8_MMA(0, 1, At, B1); PG8_BAR; PG8_SCHED;
            PG8_LDA(At, 1, 1); PG8_STAGE(PG8_SB(1, 0), b3, voffB); PG8_STAGE(PG8_SB(1, 1), b3 + hstepB, voffB); PG8_STAGE_A(1, 0, a3, vo2);
            PG8_WAIT_V(8); PG8_WAIT_L(0); PG8_BAR; PG8_MMA(1, 0, At, B0); PG8_MMA(1, 1, At, B1); PG8_BAR; PG8_SCHED;
        }
        if (wr == 0) PG8_BAR;
        asm volatile("s_nop 15\n\ts_nop 15\n\ts_nop 15" ::: "memory");
#pragma unroll
        for (int ai_ = 0; ai_ < 2; ++ai_)
#pragma unroll
            for (int bj_ = 0; bj_ < 2; ++bj_) asm volatile("" : "+v"(acc[ai_][bj_][0][0]), "+v"(acc[ai_][bj_][0][1]), "+v"(acc[ai_][bj_][1][0]), "+v"(acc[ai_][bj_][1][1]), "+v"(acc[ai_][bj_][2][0]), "+v"(acc[ai_][bj_][2][1]), "+v"(acc[ai_][bj_][3][0]), "+v"(acc[ai_][bj_][3][1]));
        E(acc, cur, wr, wc, fr, fq);
        if (!has_next) break;
#pragma unroll
        for (int a = 0; a < 2; ++a)
#pragma unroll
            for (int b = 0; b < 2; ++b)
#pragma unroll
                for (int m = 0; m < 4; ++m)
#pragma unroll
                    for (int n = 0; n < 2; ++n) acc[a][b][m][n] = (f32x4){0.f, 0.f, 0.f, 0.f};
        cur = nxt; cA = nA; cB = nB; ++ui;
        if constexpr (Sched::GATHER) {
#pragma unroll
            for (int h_ = 0; h_ < 2; ++h_)
#pragma unroll
                for (int i_ = 0; i_ < 2; ++i_) voC[h_][i_] = voN[h_][i_]; }
        if (wr == 1) PG8_BAR;
    }
    PG8_WAIT_V(0);
    PG8_BAR;
#undef PG8_GOFF
#undef PG8_STAGE_A
#undef PG8_SA
#undef PG8_SB
#undef PG8_STAGE
#undef PG8_LDA
#undef PG8_LDB
#undef PG8_MMA
#undef PG8_WAIT_V
#undef PG8_WAIT_L
#undef PG8_BAR
#undef PG8_SCHED
}

#define EPI_ARGS const f32x4 (&acc)[2][2][4][2], const Unit& u, int wr, int wc, int fr, int fq
struct EpiH {
    static constexpr bool PERM = true;
    h16* O; int ldc;
    DI void operator()(EPI_ARGS) const {
        const int row0 = u.pm * 256 + wr * 64 + fr, col0 = u.pc * 256 + wc * 32 + 8 * fq;
#pragma unroll
        for (int ai = 0; ai < 2; ++ai)
#pragma unroll
            for (int m = 0; m < 4; ++m) { h16* rowp = O + (size_t)(row0 + ai * 128 + m * 16) * ldc + col0;
#pragma unroll
                for (int bj = 0; bj < 2; ++bj) { const f32x4 v0 = acc[ai][bj][m][0], v1 = acc[ai][bj][m][1];
                    u32x4 w; w.x = pkh(v0[0], v0[1]); w.y = pkh(v0[2], v0[3]); w.z = pkh(v1[0], v1[1]); w.w = pkh(v1[2], v1[3]);
                    *(u32x4*)(rowp + bj * 128) = w; } }
    }
};
struct EpiRes {
    static constexpr bool PERM = true;
    const h16* R; h16* O; int ldc;
    DI void operator()(EPI_ARGS) const {
        const int row0 = u.pm * 256 + wr * 64 + fr, col0 = u.pc * 256 + wc * 32 + 8 * fq;
#pragma unroll
        for (int ai = 0; ai < 2; ++ai)
#pragma unroll
            for (int m = 0; m < 4; ++m) { const size_t off = (size_t)(row0 + ai * 128 + m * 16) * ldc + col0;
#pragma unroll
                for (int bj = 0; bj < 2; ++bj) { const h16x8 r = *(const h16x8*)(R + off + bj * 128); const f32x4 v0 = acc[ai][bj][m][0], v1 = acc[ai][bj][m][1];
                    u32x4 w; w.x = pkh(ALPHA * (float)r[0] + v0[0], ALPHA * (float)r[1] + v0[1]); w.y = pkh(ALPHA * (float)r[2] + v0[2], ALPHA * (float)r[3] + v0[3]);
                    w.z = pkh(ALPHA * (float)r[4] + v1[0], ALPHA * (float)r[5] + v1[1]); w.w = pkh(ALPHA * (float)r[6] + v1[2], ALPHA * (float)r[7] + v1[3]);
                    *(u32x4*)(O + off + bj * 128) = w; }
                asm volatile("" ::: "memory"); }
    }
};
struct EpiSwiGLU {
    static constexpr bool PERM = true;
    h16* O; int ldc; int drop;
    DI void operator()(EPI_ARGS) const {
        const int row0 = u.pm * 256 + wr * 64 + fr, col0 = u.pc * 128 + wc * 32 + 8 * fq;
#pragma unroll
        for (int ai = 0; ai < 2; ++ai)
#pragma unroll
            for (int m = 0; m < 4; ++m) { h16* rowp = O + (size_t)(row0 + ai * 128 + m * 16) * ldc + col0;
                float r[8];
#pragma unroll
                for (int n = 0; n < 2; ++n)
#pragma unroll
                    for (int j = 0; j < 4; ++j) { const float g = acc[ai][0][m][n][j], up = acc[ai][1][m][n][j]; r[n * 4 + j] = siluf_(g) * up; }
                u32x4 w; w.x = rnd_drop(pkh(r[0], r[1]), drop); w.y = rnd_drop(pkh(r[2], r[3]), drop); w.z = rnd_drop(pkh(r[4], r[5]), drop); w.w = rnd_drop(pkh(r[6], r[7]), drop);
                *(u32x4*)rowp = w; }
    }
};
struct EpiIn1 {
    static constexpr bool PERM = true;
    h16* Ucat; h16* QKVG; float* LOGIT;
    DI void operator()(EPI_ARGS) const {
        const int row0 = u.pm * 256 + wr * 64 + fr;
#pragma unroll
        for (int ai = 0; ai < 2; ++ai)
#pragma unroll
            for (int m = 0; m < 4; ++m) { const int row = row0 + ai * 128 + m * 16;
#pragma unroll
                for (int bj = 0; bj < 2; ++bj) { const int col = u.pc * 256 + bj * 128 + wc * 32 + 8 * fq; const f32x4 v0 = acc[ai][bj][m][0], v1 = acc[ai][bj][m][1];
                    u32x4 w; w.x = pkh(v0[0], v0[1]); w.y = pkh(v0[2], v0[3]); w.z = pkh(v1[0], v1[1]); w.w = pkh(v1[2], v1[3]);
                    if (u.pc < 4) { const int g = col >> 4, hh = col & 15, b = row >> 13, t = row & 8191, ch = t >> 5, sg = t & 31;
                        *(u32x4*)(Ucat + ((size_t)(g * S5N + b * S5NCH + ch) * S5K + sg * 16 + hh)) = w; }
                    else { *(u32x4*)(QKVG + (size_t)row * 4096 + (col - 1024)) = w; } } }
    }
};
struct EpiS5Y {
    static constexpr bool PERM = true;
    const h16* Ucat; const float* Dskip; h16* Z;
    DI void operator()(EPI_ARGS) const {
        const int g = u.grp;
#pragma unroll
        for (int bj = 0; bj < 2; ++bj) { const int col = u.pc * 256 + bj * 128 + wc * 32 + 8 * fq, tau = col >> 4, hh = col & 15;
            const f32x4 d0 = *(const f32x4*)(Dskip + g * 16 + hh), d1 = *(const f32x4*)(Dskip + g * 16 + hh + 4);
#pragma unroll
            for (int ai = 0; ai < 2; ++ai)
#pragma unroll
                for (int m = 0; m < 4; ++m) { const int n = u.pm * 256 + ai * 128 + wr * 64 + m * 16 + fr, b = n >> 8, ch = n & 255;
                    const h16x8 uv = *(const h16x8*)(Ucat + ((size_t)(g * S5N + n) * S5K + col));
                    const f32x4 v0 = acc[ai][bj][m][0], v1 = acc[ai][bj][m][1]; float r[8];
#pragma unroll
                    for (int j = 0; j < 8; ++j) { const float a = (j < 4 ? v0[j & 3] : v1[j & 3]), dd = (j < 4 ? d0[j & 3] : d1[j & 3]); const float y = a + dd * (float)uv[j];
                        r[j] = y * fast_rcp(1.0f + __expf(-1.5957691216057308f * (y + 0.044715f * y * y * y))); }
                    u32x4 w; w.x = pkh(r[0], r[1]); w.y = pkh(r[2], r[3]); w.z = pkh(r[4], r[5]); w.w = pkh(r[6], r[7]);
                    *(u32x4*)(Z + (size_t)(b * SEQ + ch * S5L + tau) * 1024 + g * 16 + hh) = w; } }
    }
};
struct EpiGLU {
    static constexpr bool PERM = true;
    const h16* Z; const float* bias; h16* O;
    DI void operator()(EPI_ARGS) const {
        const int row0 = u.pm * 256 + wr * 64 + fr;
#pragma unroll
        for (int bj = 0; bj < 2; ++bj) { const int col = u.pc * 256 + bj * 128 + wc * 32 + 8 * fq;
            const f32x4 b0 = *(const f32x4*)(bias + col), b1 = *(const f32x4*)(bias + col + 4);
#pragma unroll
            for (int ai = 0; ai < 2; ++ai)
#pragma unroll
                for (int m = 0; m < 4; ++m) { const int row = row0 + ai * 128 + m * 16;
                    const h16x8 zv = *(const h16x8*)(Z + (size_t)row * 1024 + col);
                    const f32x4 v0 = acc[ai][bj][m][0], v1 = acc[ai][bj][m][1]; float r[8];
#pragma unroll
                    for (int j = 0; j < 8; ++j) { const float a = (j < 4 ? v0[j & 3] + b0[j & 3] : v1[j & 3] + b1[j & 3]); r[j] = (float)zv[j] * sigmoidf_(a); }
                    u32x4 w; w.x = pkh(r[0], r[1]); w.y = pkh(r[2], r[3]); w.z = pkh(r[4], r[5]); w.w = pkh(r[6], r[7]);
                    *(u32x4*)(O + (size_t)row * 2048 + col) = w; } }
    }
};
struct EpiEC {
    static constexpr bool PERM = false;
    float* EC;
    DI void operator()(EPI_ARGS) const {
        const int g = u.grp, col0 = wc * 32 + 4 * fq;
#pragma unroll
        for (int ai = 0; ai < 2; ++ai)
#pragma unroll
            for (int m = 0; m < 4; ++m) { const int n = u.pm * 256 + ai * 128 + wr * 64 + m * 16 + fr; float* rowp = EC + ((size_t)(g * S5N + n)) * 128 + col0;
#pragma unroll
                for (int nn = 0; nn < 2; ++nn) *(f32x4*)(rowp + nn * 16) = acc[ai][0][m][nn]; }
    }
};
DI unsigned pk_fp8x4(float a, float b, float c, float d) {
    a = fminf(fmaxf(a, -448.f), 448.f); b = fminf(fmaxf(b, -448.f), 448.f); c = fminf(fmaxf(c, -448.f), 448.f); d = fminf(fmaxf(d, -448.f), 448.f);
    unsigned w = 0u; w = __builtin_amdgcn_cvt_pk_fp8_f32(a, b, w, false); w = __builtin_amdgcn_cvt_pk_fp8_f32(c, d, w, true); return w; }
constexpr float H8_SCALE = 8.0f, W8_SCALE = 256.0f, X8_SCALE = 16.0f;
struct EpiSwiGLU8 {
    static constexpr bool PERM = true;
    unsigned char* O; int ldc; float isc;
    DI void operator()(EPI_ARGS) const {
        const int row0 = u.pm * 256 + wr * 64 + fr, col0 = u.pc * 128 + wc * 32 + 8 * fq;
#pragma unroll
        for (int ai = 0; ai < 2; ++ai)
#pragma unroll
            for (int m = 0; m < 4; ++m) { unsigned char* rowp = O + (size_t)(row0 + ai * 128 + m * 16) * ldc + col0;
                float r[8];
#pragma unroll
                for (int n = 0; n < 2; ++n)
#pragma unroll
                    for (int j = 0; j < 4; ++j) { const float g = acc[ai][0][m][n][j] * isc, up = acc[ai][1][m][n][j] * isc; r[n * 4 + j] = H8_SCALE * siluf_(g) * up; }
                u32x2 w; w.x = pk_fp8x4(r[0], r[1], r[2], r[3]); w.y = pk_fp8x4(r[4], r[5], r[6], r[7]);
                *(u32x2*)rowp = w; }
    }
};
struct EpiHs {
    static constexpr bool PERM = true;
    h16* O; int ldc; float scale;
    DI void operator()(EPI_ARGS) const {
        const int row0 = u.pm * 256 + wr * 64 + fr, col0 = u.pc * 256 + wc * 32 + 8 * fq;
#pragma unroll
        for (int ai = 0; ai < 2; ++ai)
#pragma unroll
            for (int m = 0; m < 4; ++m) { h16* rowp = O + (size_t)(row0 + ai * 128 + m * 16) * ldc + col0;
#pragma unroll
                for (int bj = 0; bj < 2; ++bj) { const f32x4 v0 = acc[ai][bj][m][0] * scale, v1 = acc[ai][bj][m][1] * scale;
                    u32x4 w; w.x = pkh(v0[0], v0[1]); w.y = pkh(v0[2], v0[3]); w.z = pkh(v1[0], v1[1]); w.w = pkh(v1[2], v1[3]);
                    *(u32x4*)(rowp + bj * 128) = w; } }
    }
};
struct EpiSlab {
    static constexpr bool PERM = false;
    float* SL; float scale;
    DI void operator()(EPI_ARGS) const {
        float* base = SL + (size_t)u.aux * 65536 + (size_t)(wr * 64 + fr) * 256 + wc * 32 + 4 * fq;
#pragma unroll
        for (int ai = 0; ai < 2; ++ai)
#pragma unroll
            for (int m = 0; m < 4; ++m)
#pragma unroll
                for (int bj = 0; bj < 2; ++bj)
#pragma unroll
                    for (int n = 0; n < 2; ++n) *(f32x4*)(base + (size_t)(ai * 128 + m * 16) * 256 + bj * 128 + n * 16) = acc[ai][bj][m][n] * scale;
    }
};
}

struct Args { const float* in[34]; float* out; unsigned char* ws; int ph_lo, ph_hi; };
enum { I_X = 0, I_EWIN, I_EWOUT, I_ELNMG, I_ELNMB, I_EW1, I_EW3, I_EW2, I_ELNFG, I_ELNFB, I_OWIN, I_LAMRE, I_LAMIM, I_LOGDT, I_BRE, I_BIM, I_CRE, I_CIM, I_SSMD,
       I_GLUW, I_GLUB, I_CONVW, I_ALOG, I_DTB, I_NORMW, I_OWOUT, I_OLNMG, I_OLNMB, I_ROUTER, I_MW1, I_MW3, I_MW2, I_OLNFG, I_OLNFB };

DI void tr_item(const float* W, int N, int k0, int n0, h16* WT, size_t drow0, int ldd, float* scr, int lane, int drop) {
    const int c4 = (lane & 15) * 4, r4 = lane >> 4;
    f32x4 v[16];
#pragma unroll
    for (int i = 0; i < 16; ++i) { const int kk = 4 * i + r4, col = n0 + c4; v[i] = (col < N) ? *(const f32x4*)(W + (size_t)(k0 + kk) * N + col) : (f32x4){0.f, 0.f, 0.f, 0.f}; }
#pragma unroll
    for (int i = 0; i < 16; ++i) { float* s = scr + (4 * i + r4) * 65 + c4; s[0] = v[i][0]; s[1] = v[i][1]; s[2] = v[i][2]; s[3] = v[i][3]; }
    asm volatile("s_waitcnt lgkmcnt(0)" ::: "memory");
    const int c = lane & 7, nb = lane >> 3;
#pragma unroll
    for (int j = 0; j < 8; ++j) { const int n = nb + 8 * j; const float* s = scr + (8 * c) * 65 + n;
        u32x4 o; o.x = rnd_drop(pkh(s[0], s[65]), drop); o.y = rnd_drop(pkh(s[130], s[195]), drop); o.z = rnd_drop(pkh(s[260], s[325]), drop); o.w = rnd_drop(pkh(s[390], s[455]), drop);
        *(u32x4*)(WT + (drow0 + n) * (size_t)ldd + k0 + 8 * c) = o; }
    asm volatile("s_waitcnt lgkmcnt(0)" ::: "memory");
}
DI void tr_item8(const float* W, int N, int k0, int n0, unsigned char* WT, size_t drow0, int ldd, float* scr, int lane) {
    const int c4 = (lane & 7) * 4, r8 = lane >> 3;
    f32x4 v[16];
#pragma unroll
    for (int i = 0; i < 16; ++i) v[i] = *(const f32x4*)(W + (size_t)(k0 + 8 * i + r8) * N + n0 + c4);
#pragma unroll
    for (int i = 0; i < 16; ++i) { float* s = scr + (8 * i + r8) * 33 + c4; s[0] = v[i][0]; s[1] = v[i][1]; s[2] = v[i][2]; s[3] = v[i][3]; }
    asm volatile("s_waitcnt lgkmcnt(0)" ::: "memory");
    const int c = lane & 7, nb = lane >> 3;
#pragma unroll
    for (int j = 0; j < 4; ++j) { const int n = nb + 8 * j; const float* s = scr + (16 * c) * 33 + n; const float ws_ = pg8::W8_SCALE;
        u32x4 o; o.x = pg8::pk_fp8x4(s[0] * ws_, s[33] * ws_, s[66] * ws_, s[99] * ws_); o.y = pg8::pk_fp8x4(s[132] * ws_, s[165] * ws_, s[198] * ws_, s[231] * ws_);
        o.z = pg8::pk_fp8x4(s[264] * ws_, s[297] * ws_, s[330] * ws_, s[363] * ws_); o.w = pg8::pk_fp8x4(s[396] * ws_, s[429] * ws_, s[462] * ws_, s[495] * ws_);
        *(u32x4*)(WT + (drow0 + n) * (size_t)ldd + k0 + 16 * c) = o; }
    asm volatile("s_waitcnt lgkmcnt(0)" ::: "memory");
}
DI void tr_matrix8(const float* W, int K, int N, unsigned char* WT, int ldd, size_t rowbase, int gw, int ngw, float* scr, int lane, int mode = 0) {
    const int nkb = K / 128, nnb = N / 32, nit = nkb * nnb;
    if (gw >= nit) return;
    const int c4 = (lane & 7) * 4, r8 = lane >> 3, c = lane & 7, nb = lane >> 3;
    f32x4 v[16];
    { const int kb = gw / nnb, n0 = (gw % nnb) * 32;
#pragma unroll
      for (int i = 0; i < 16; ++i) v[i] = *(const f32x4*)(W + (size_t)(kb * 128 + 8 * i + r8) * N + n0 + c4); }
    for (int it = gw; it < nit; it += ngw) { const int kb = it / nnb, n0 = (it % nnb) * 32, k0 = kb * 128;
        const size_t drow0 = mode ? rowbase + (size_t)(n0 >> 7) * 256 + (n0 & 127) : rowbase + n0;
#pragma unroll
        for (int i = 0; i < 16; ++i) { float* s = scr + (8 * i + r8) * 33 + c4; s[0] = v[i][0]; s[1] = v[i][1]; s[2] = v[i][2]; s[3] = v[i][3]; }
        { const int itn = it + ngw < nit ? it + ngw : it, kbn = itn / nnb, n0n = (itn % nnb) * 32;
#pragma unroll
          for (int i = 0; i < 16; ++i) v[i] = *(const f32x4*)(W + (size_t)(kbn * 128 + 8 * i + r8) * N + n0n + c4); }
        asm volatile("s_waitcnt lgkmcnt(0)" ::: "memory");
#pragma unroll
        for (int j = 0; j < 4; ++j) { const int n = nb + 8 * j; const float* s = scr + (16 * c) * 33 + n; const float ws_ = pg8::W8_SCALE;
            u32x4 o; o.x = pg8::pk_fp8x4(s[0] * ws_, s[33] * ws_, s[66] * ws_, s[99] * ws_); o.y = pg8::pk_fp8x4(s[132] * ws_, s[165] * ws_, s[198] * ws_, s[231] * ws_);
            o.z = pg8::pk_fp8x4(s[264] * ws_, s[297] * ws_, s[330] * ws_, s[363] * ws_); o.w = pg8::pk_fp8x4(s[396] * ws_, s[429] * ws_, s[462] * ws_, s[495] * ws_);
            *(u32x4*)(WT + (drow0 + n) * (size_t)ldd + k0 + 16 * c) = o; }
        asm volatile("s_waitcnt lgkmcnt(0)" ::: "memory");
    }
}
DI void tr_matrix(const float* W, int K, int N, int NP, h16* WT, int ldd, int mode, size_t rowbase, int gw, int ngw, float* scr, int lane, int drop = WQ_DROP) {
    const int nnb = NP / 64, nit = (K / 64) * nnb;
    const int nkb = K / 64;
    for (int it = gw; it < nit; it += ngw) { const int kb = it % nkb, n0 = (it / nkb) * 64;
        const size_t drow0 = mode ? rowbase + (size_t)(n0 >> 7) * 256 + (n0 & 127) : rowbase + n0;
        tr_item(W, N, kb * 64, n0, WT, drow0, ldd, scr, lane, drop); }
}
DI void s5_tables(const Args& a, char* lds, int g, int q4, int nq) {
    const int tid = threadIdx.x;
    f32x2* Lpow = (f32x2*)lds;
    f32x2* Bbar = Lpow + 33 * 64;
    f32x2* Cc = Bbar + 1024;
    f32x2* coef = Cc + 1024;
    float* Kern = (float*)(coef + 64);
    h16* TCAT = (h16*)(a.ws + WS_TCAT) + (size_t)g * 512 * S5K;
    h16* EPAD = (h16*)(a.ws + WS_EPAD) + (size_t)g * 256 * 512;
    __syncthreads();
    if (tid < 64) { const int p = tid; const float dt = expf(a.in[I_LOGDT][g]); const float lre = a.in[I_LAMRE][g * 64 + p], lim = a.in[I_LAMIM][g * 64 + p];
        const float mag = expf(lre * dt); float sn, cs; sincosf(lim * dt, &sn, &cs); const float l1r = mag * cs, l1i = mag * sn;
        float pr = 1.f, pi = 0.f; Lpow[p] = (f32x2){1.f, 0.f};
        for (int j = 1; j <= 32; ++j) { const float nr = pr * l1r - pi * l1i, ni = pr * l1i + pi * l1r; pr = nr; pi = ni; Lpow[j * 64 + p] = (f32x2){pr, pi}; }
        const float nr = l1r - 1.f, ni = l1i, den = lre * lre + lim * lim; coef[p] = (f32x2){(nr * lre + ni * lim) / den, (ni * lre - nr * lim) / den}; }
    __syncthreads();
    for (int i = tid; i < 1024; i += NT) { const int p = i >> 4; const float br = a.in[I_BRE][g * 1024 + i], bi = a.in[I_BIM][g * 1024 + i]; const f32x2 c = coef[p];
        Bbar[i] = (f32x2){c.x * br - c.y * bi, c.x * bi + c.y * br}; Cc[i] = (f32x2){a.in[I_CRE][g * 1024 + i], a.in[I_CIM][g * 1024 + i]}; }
    __syncthreads();
    const int r_lo = 512 * q4 / nq, r_hi = 512 * (q4 + 1) / nq, e_lo = 256 * q4 / nq, e_hi = 256 * (q4 + 1) / nq, nlag = ((r_hi - 1) >> 4) + 1;
    for (int i = tid; i < nlag * 256; i += NT) { const int j = i >> 8, h = (i >> 4) & 15, h2 = i & 15; float s = 0.f;
        for (int p = 0; p < 64; ++p) { const f32x2 c = Cc[h * 64 + p], l = Lpow[j * 64 + p], b = Bbar[p * 16 + h2]; const float mr = c.x * l.x - c.y * l.y, mi = c.x * l.y + c.y * l.x; s += mr * b.x - mi * b.y; }
        Kern[i] = s; }
    __syncthreads();
    for (int i = r_lo * 80 + tid; i < r_hi * 80; i += NT) { const int row = i / 80, ch = i % 80, tau = row >> 4, h = row & 15; float r[8];
        if (ch < 64) { const int sg = ch >> 1, h0 = (ch & 1) * 8, lag = tau - sg;
#pragma unroll
            for (int j = 0; j < 8; ++j) r[j] = lag >= 0 ? Kern[lag * 256 + h * 16 + h0 + j] : 0.f; }
        else { const int p0 = (ch - 64) * 4;
#pragma unroll
            for (int q = 0; q < 4; ++q) { const f32x2 c = Cc[h * 64 + p0 + q], l = Lpow[(tau + 1) * 64 + p0 + q]; r[2 * q] = c.x * l.x - c.y * l.y; r[2 * q + 1] = -(c.x * l.y + c.y * l.x); } }
        u32x4 w; w.x = pkh(r[0], r[1]); w.y = pkh(r[2], r[3]); w.z = pkh(r[4], r[5]); w.w = pkh(r[6], r[7]);
        *(u32x4*)(TCAT + (size_t)row * S5K + ch * 8) = w; }
    for (int i = e_lo * 64 + tid; i < e_hi * 64; i += NT) { const int row = i >> 6, ch = i & 63; float r[8];
        if (row < 128) { const int p = row >> 1, ri = row & 1, sg = ch >> 1, h0 = (ch & 1) * 8; const f32x2 l = Lpow[(31 - sg) * 64 + p];
#pragma unroll
            for (int j = 0; j < 8; ++j) { const f32x2 b = Bbar[p * 16 + h0 + j]; r[j] = ri ? (l.x * b.y + l.y * b.x) : (l.x * b.x - l.y * b.y); } }
        else {
#pragma unroll
            for (int j = 0; j < 8; ++j) r[j] = 0.f; }
        u32x4 w; w.x = pkh(r[0], r[1]); w.y = pkh(r[2], r[3]); w.z = pkh(r[4], r[5]); w.w = pkh(r[6], r[7]);
        *(u32x4*)(EPAD + (size_t)row * 512 + ch * 8) = w; }
}
#ifndef MOE_CONV_LATE
#define MOE_CONV_LATE 5
#endif
DI void moe_convert(const Args& a, char* lds, int e_lo, int e_hi, int gw, int ngw) {
    const int lane = threadIdx.x & 63, wave = threadIdx.x >> 6; float* scr = (float*)(lds + wave * 16896); unsigned char* ws = a.ws;
    for (int e = e_lo; e < e_hi; ++e) {
        tr_matrix8(a.in[I_MW1] + (size_t)e * D * DFE, D, DFE, (unsigned char*)(ws + WS_MOE13), D, (size_t)e * 2 * DFE, gw, ngw, scr, lane, 1);
        tr_matrix8(a.in[I_MW3] + (size_t)e * D * DFE, D, DFE, (unsigned char*)(ws + WS_MOE13), D, (size_t)e * 2 * DFE + 128, gw, ngw, scr, lane, 1);
        tr_matrix8(a.in[I_MW2] + (size_t)e * DFE * D, DFE, D, (unsigned char*)(ws + WS_MOE2), DFE, (size_t)e * D, gw, ngw, scr, lane);
    }
}
DI void phase_prologue(const Args& a, char* lds) {
    const int tid = threadIdx.x, lane = tid & 63, wave = tid >> 6, gw = blockIdx.x * NWAVES + wave, ngw = gridDim.x * NWAVES;
    float* scr = (float*)(lds + wave * 16896);
    unsigned char* ws = a.ws;
    moe_convert(a, lds, 0, MOE_CONV_LATE, gw, ngw);
    tr_matrix(a.in[I_OWOUT], D, D, D, (h16*)(ws + WS_WOUT1), D, 0, 0, gw, ngw, scr, lane);
    tr_matrix(a.in[I_GLUW], 1024, 1024, 1024, (h16*)(ws + WS_WGLU), 1024, 0, 0, gw, ngw, scr, lane);
    tr_matrix(a.in[I_OWIN], D, IN1, IN1P, (h16*)(ws + WS_WIN1), D, 0, 0, gw, ngw, scr, lane);
    tr_matrix(a.in[I_EW2], DFF, D, D, (h16*)(ws + WS_WFF2), DFF, 0, 0, gw, ngw, scr, lane);
    tr_matrix(a.in[I_EW1], D, DFF, DFF, (h16*)(ws + WS_WFF13), D, 1, 0, gw, ngw, scr, lane);
    tr_matrix(a.in[I_EW3], D, DFF, DFF, (h16*)(ws + WS_WFF13), D, 1, 128, gw, ngw, scr, lane);
    tr_matrix(a.in[I_EWOUT], D, D, D, (h16*)(ws + WS_WOUT0), D, 0, 0, gw, ngw, scr, lane);
    tr_matrix(a.in[I_EWIN], D, IN0, IN0, (h16*)(ws + WS_WIN0), D, 0, 0, gw, ngw, scr, lane);
    { const float* x = a.in[I_X]; h16* xh = (h16*)(ws + WS_XH);
      for (size_t i = (size_t)blockIdx.x * NT + tid; i < (size_t)M * D / 8; i += (size_t)gridDim.x * NT) { const f32x4 v0 = *(const f32x4*)(x + i * 8), v1 = *(const f32x4*)(x + i * 8 + 4);
          u32x4 w; w.x = pka(v0[0], v0[1]); w.y = pka(v0[2], v0[3]); w.z = pka(v1[0], v1[1]); w.w = pka(v1[2], v1[3]); *(u32x4*)(xh + i * 8) = w; } }
    __syncthreads();
    if (gridDim.x >= 256) { if (blockIdx.x < 256) s5_tables(a, lds, (int)blockIdx.x >> 2, (int)blockIdx.x & 3, 4); }
    else for (int g = blockIdx.x; g < 64; g += gridDim.x) s5_tables(a, lds, g, 0, 1);
}

DI void ln_normalize(float (&v)[32], const float* gam, const float* bet, int lane) {
    float s = 0.f;
#pragma unroll
    for (int i = 0; i < 32; ++i) s += v[i];
    const float mean = wave_sum(s) * (1.f / D); float s2 = 0.f;
#pragma unroll
    for (int i = 0; i < 32; ++i) { v[i] -= mean; s2 += v[i] * v[i]; }
    const float rstd = 1.0f / sqrtf(wave_sum(s2) * (1.f / D) + 1e-5f);
#pragma unroll
    for (int j = 0; j < 4; ++j) { const f32x4 g0 = *(const f32x4*)(gam + 8 * lane + 512 * j), g1 = *(const f32x4*)(gam + 8 * lane + 512 * j + 4), b0 = *(const f32x4*)(bet + 8 * lane + 512 * j), b1 = *(const f32x4*)(bet + 8 * lane + 512 * j + 4);
#pragma unroll
        for (int q = 0; q < 4; ++q) { v[8 * j + q] = v[8 * j + q] * rstd * g0[q] + b0[q]; v[8 * j + 4 + q] = v[8 * j + 4 + q] * rstd * g1[q] + b1[q]; } }
}
template <bool ROUTER>
DI void phase_ln(const Args& a, char* lds, const h16* Pin, const float* gam, const float* bet) {
    const int tid = threadIdx.x, lane = tid & 63, wave = tid >> 6, gw = blockIdx.x * NWAVES + wave, ngw = gridDim.x * NWAVES;
    h16* XH = (h16*)(a.ws + WS_XH);
    float* WrT = (float*)lds;
    if (ROUTER) { __syncthreads(); const float* rw = a.in[I_ROUTER]; for (int i = tid; i < D * 8; i += NT) WrT[(i & 7) * D + (i >> 3)] = rw[i]; __syncthreads(); }
    h16x8 pn[4];
    if (gw < M) {
#pragma unroll
        for (int j = 0; j < 4; ++j) pn[j] = *(const h16x8*)(Pin + (size_t)gw * D + 8 * lane + 512 * j); }
    for (int row = gw; row < M; row += ngw) {
        float v[32];
#pragma unroll
        for (int j = 0; j < 4; ++j) {
#pragma unroll
            for (int q = 0; q < 8; ++q) v[8 * j + q] = (float)pn[j][q]; }
        { const int nr = row + ngw < M ? row + ngw : row;
#pragma unroll
          for (int j = 0; j < 4; ++j) pn[j] = *(const h16x8*)(Pin + (size_t)nr * D + 8 * lane + 512 * j); }
        ln_normalize(v, gam, bet, lane);
#pragma unroll
        for (int j = 0; j < 4; ++j) { u32x4 w; w.x = pka(v[8 * j], v[8 * j + 1]); w.y = pka(v[8 * j + 2], v[8 * j + 3]); w.z = pka(v[8 * j + 4], v[8 * j + 5]); w.w = pka(v[8 * j + 6], v[8 * j + 7]);
            *(u32x4*)(XH + (size_t)row * D + 8 * lane + 512 * j) = w; }
        if (ROUTER) {
#pragma unroll
            for (int j = 0; j < 4; ++j) { u32x2 q; q.x = pg8::pk_fp8x4(v[8 * j] * pg8::X8_SCALE, v[8 * j + 1] * pg8::X8_SCALE, v[8 * j + 2] * pg8::X8_SCALE, v[8 * j + 3] * pg8::X8_SCALE);
                q.y = pg8::pk_fp8x4(v[8 * j + 4] * pg8::X8_SCALE, v[8 * j + 5] * pg8::X8_SCALE, v[8 * j + 6] * pg8::X8_SCALE, v[8 * j + 7] * pg8::X8_SCALE);
                *(u32x2*)(a.ws + WS_XQ8 + (size_t)row * D + 8 * lane + 512 * j) = q; }
            float lg[8];
#pragma unroll
            for (int e = 0; e < 8; ++e) { float s = 0.f;
#pragma unroll
                for (int j = 0; j < 4; ++j) { const f32x4 w0 = *(const f32x4*)(WrT + e * D + 8 * lane + 512 * j), w1 = *(const f32x4*)(WrT + e * D + 8 * lane + 512 * j + 4);
#pragma unroll
                    for (int q = 0; q < 4; ++q) s += v[8 * j + q] * w0[q] + v[8 * j + 4 + q] * w1[q]; }
                lg[e] = wave_sum(s); asm volatile("" ::: "memory"); }
            int i1 = 0; float v1 = lg[0];
#pragma unroll
            for (int e = 1; e < 8; ++e) if (lg[e] > v1) { v1 = lg[e]; i1 = e; }
            int i2 = -1; float v2 = -3.0e38f;
#pragma unroll
            for (int e = 0; e < 8; ++e) if (e != i1 && lg[e] > v2) { v2 = lg[e]; i2 = e; }
            const float g1 = 1.0f / (1.0f + expf(v2 - v1)), g2 = 1.0f - g1;
            if (lane == 0) { unsigned* cnt = (unsigned*)(a.ws + WS_CTL) + CW_CNT;
                const unsigned p1 = atomicAdd(cnt + i1, 1u), p2 = atomicAdd(cnt + i2, 1u);
                int* tk = (int*)(a.ws + WS_TOK) + (size_t)row * 8; tk[0] = i1; tk[1] = i2; tk[2] = (int)p1; tk[3] = (int)p2; ((float*)tk)[4] = g1; ((float*)tk)[5] = g2;
                int* lst = (int*)(a.ws + WS_LIST); lst[(i1 << 14) + (int)p1] = row; lst[(i2 << 14) + (int)p2] = row; }
        }
    }
}
DI void moe_y8(const h16* Y, const float* SL, int slot, int col, int pm0, int R, int sp, float (&y)[8]) {
    const int pm = slot >> 8;
    if (pm < pm0) { const h16x8 t = *(const h16x8*)(Y + (size_t)slot * D + col);
#pragma unroll
        for (int q = 0; q < 8; ++q) y[q] = (float)t[q]; }
    else { const int tile = (pm - pm0) * 8 + (col >> 8);
#pragma unroll
        for (int q = 0; q < 8; ++q) y[q] = 0.f;
        for (int ks = 0; ks < sp; ++ks) { const float* p = SL + (size_t)(ks * R + tile) * 65536 + (size_t)(slot & 255) * 256 + (col & 255); const f32x4 t0 = *(const f32x4*)p, t1 = *(const f32x4*)(p + 4);
#pragma unroll
            for (int q = 0; q < 4; ++q) { y[q] += t0[q]; y[4 + q] += t1[q]; } } }
}
DI void final_row_slow(const Args& a, int row, int s1, int s2, float g1, float g2, int pm0, int R, int sp, int lane) {
    const h16* XH = (const h16*)(a.ws + WS_XH); const h16* Y = (const h16*)(a.ws + WS_XG); const float* SL = (const float*)(a.ws + WS_SLAB);
    float v[32];
#pragma unroll
    for (int j = 0; j < 4; ++j) { const int col = 8 * lane + 512 * j; const h16x8 x = *(const h16x8*)(XH + (size_t)row * D + col); float y1[8], y2[8];
        moe_y8(Y, SL, s1, col, pm0, R, sp, y1); moe_y8(Y, SL, s2, col, pm0, R, sp, y2);
#pragma unroll
        for (int q = 0; q < 8; ++q) v[8 * j + q] = ALPHA * (float)x[q] + g1 * y1[q] + g2 * y2[q]; }
    ln_normalize(v, a.in[I_OLNFG], a.in[I_OLNFB], lane);
#pragma unroll
    for (int j = 0; j < 4; ++j) { *(f32x4*)(a.out + (size_t)row * D + 8 * lane + 512 * j) = (f32x4){v[8 * j], v[8 * j + 1], v[8 * j + 2], v[8 * j + 3]}; *(f32x4*)(a.out + (size_t)row * D + 8 * lane + 512 * j + 4) = (f32x4){v[8 * j + 4], v[8 * j + 5], v[8 * j + 6], v[8 * j + 7]}; }
}
DI void phase_final(const Args& a, int pm0, int R, int sp, int t1, int t2, int t3, int t4, int t5, int t6, int t7) {
#define FIN_SLOT(e_, p_) ((((e_) == 1 ? t1 : (e_) == 2 ? t2 : (e_) == 3 ? t3 : (e_) == 4 ? t4 : (e_) == 5 ? t5 : (e_) == 6 ? t6 : (e_) == 7 ? t7 : 0) << 8) + (p_))
    const int tid = threadIdx.x, lane = tid & 63, wave = __builtin_amdgcn_readfirstlane(tid >> 6), gw = blockIdx.x * NWAVES + wave, ngw = gridDim.x * NWAVES;
    const h16* XH = (const h16*)(a.ws + WS_XH); const h16* Y = (const h16*)(a.ws + WS_XG);
    for (int rowA = gw; rowA < M; rowA += 2 * ngw) {
        const int rowB = rowA + ngw < M ? rowA + ngw : rowA;
        const int* tkA = (const int*)(a.ws + WS_TOK) + (size_t)rowA * 8; const int* tkB = (const int*)(a.ws + WS_TOK) + (size_t)rowB * 8;
        const int a1 = FIN_SLOT(tkA[0], tkA[2]), a2 = FIN_SLOT(tkA[1], tkA[3]), b1 = FIN_SLOT(tkB[0], tkB[2]), b2 = FIN_SLOT(tkB[1], tkB[3]); const float ga1 = ((const float*)tkA)[4], ga2 = ((const float*)tkA)[5], gb1 = ((const float*)tkB)[4], gb2 = ((const float*)tkB)[5];
        const bool fast = (a1 >> 8) < pm0 && (a2 >> 8) < pm0 && (b1 >> 8) < pm0 && (b2 >> 8) < pm0;
        if (fast) {
            h16x8 xa[4], ya1[4], ya2[4], xb[4], yb1[4], yb2[4];
#pragma unroll
            for (int j = 0; j < 4; ++j) { const int col = 8 * lane + 512 * j; xa[j] = *(const h16x8*)(XH + (size_t)rowA * D + col); ya1[j] = *(const h16x8*)(Y + (size_t)a1 * D + col); ya2[j] = *(const h16x8*)(Y + (size_t)a2 * D + col);
                xb[j] = *(const h16x8*)(XH + (size_t)rowB * D + col); yb1[j] = *(const h16x8*)(Y + (size_t)b1 * D + col); yb2[j] = *(const h16x8*)(Y + (size_t)b2 * D + col); }
            float v[32];
#pragma unroll
            for (int j = 0; j < 4; ++j)
#pragma unroll
                for (int q = 0; q < 8; ++q) v[8 * j + q] = ALPHA * (float)xa[j][q] + ga1 * (float)ya1[j][q] + ga2 * (float)ya2[j][q];
            ln_normalize(v, a.in[I_OLNFG], a.in[I_OLNFB], lane);
#pragma unroll
            for (int j = 0; j < 4; ++j) { *(f32x4*)(a.out + (size_t)rowA * D + 8 * lane + 512 * j) = (f32x4){v[8 * j], v[8 * j + 1], v[8 * j + 2], v[8 * j + 3]}; *(f32x4*)(a.out + (size_t)rowA * D + 8 * lane + 512 * j + 4) = (f32x4){v[8 * j + 4], v[8 * j + 5], v[8 * j + 6], v[8 * j + 7]}; }
#pragma unroll
            for (int j = 0; j < 4; ++j)
#pragma unroll
                for (int q = 0; q < 8; ++q) v[8 * j + q] = ALPHA * (float)xb[j][q] + gb1 * (float)yb1[j][q] + gb2 * (float)yb2[j][q];
            ln_normalize(v, a.in[I_OLNFG], a.in[I_OLNFB], lane);
            if (rowB != rowA) {
#pragma unroll
                for (int j = 0; j < 4; ++j) { *(f32x4*)(a.out + (size_t)rowB * D + 8 * lane + 512 * j) = (f32x4){v[8 * j], v[8 * j + 1], v[8 * j + 2], v[8 * j + 3]}; *(f32x4*)(a.out + (size_t)rowB * D + 8 * lane + 512 * j + 4) = (f32x4){v[8 * j + 4], v[8 * j + 5], v[8 * j + 6], v[8 * j + 7]}; } }
        } else { final_row_slow(a, rowA, a1, a2, ga1, ga2, pm0, R, sp, lane); if (rowB != rowA) final_row_slow(a, rowB, b1, b2, gb1, gb2, pm0, R, sp, lane); }
    }
#undef FIN_SLOT
}

DI void phase_dilated(const Args& a, char* lds) {
    const int tid = threadIdx.x, lane = tid & 63, w = __builtin_amdgcn_readfirstlane(tid >> 6), g = lane >> 4, lq = lane & 15;
    const h16* H0 = (const h16*)(a.ws + WS_H0); h16* OP = (h16*)(a.ws + WS_OP); float* LSE = (float*)(a.ws + WS_LSE);
    char* Ks = lds; char* Vs = lds + 256 * 272;
    const int chunk = tid & 15, rr = tid >> 4;
    u32x4 kv[8], vv[8]; h16x8 qn[4];
#define DIL_LOAD(u_) do { const int pt_ = (u_) >> 10, rem_ = (u_) & 1023, bh_ = rem_ >> 6, blk_ = rem_ & 63, dsh_ = 2 * pt_, d_ = 1 << dsh_, r_ = blk_ >> (6 - dsh_), m0_ = (blk_ & ((64 >> dsh_) - 1)) * 128; \
        const h16* base_ = H0 + (size_t)((bh_ >> 3) * SEQ) * IN0 + (bh_ & 7) * 128; \
        _Pragma("unroll") for (int p = 0; p < 8; ++p) { const int mm = m0_ - 128 + p * 32 + rr; const int mc = mm >= 0 ? mm : 0; const h16* rp = base_ + (size_t)(mc * d_ + r_) * IN0 + chunk * 8; \
            kv[p] = *(const u32x4*)(rp + 4096); vv[p] = *(const u32x4*)(rp + 5120); if (mm < 0) { kv[p] = (u32x4){0u, 0u, 0u, 0u}; vv[p] = kv[p]; } } \
        const int tq_ = (m0_ + 16 * w + lq) * d_ + r_; \
        _Pragma("unroll") for (int kk = 0; kk < 4; ++kk) qn[kk] = *(const h16x8*)(base_ + (size_t)tq_ * IN0 + 3072 + 32 * kk + 8 * g); } while (0)
    const int G_ = gridDim.x, xg = (G_ % 8 == 0 && 3072 % G_ == 0) ? 1 : 0;
    const int ustart = xg ? ((int)blockIdx.x & 7) * (3072 / 8) + ((int)blockIdx.x >> 3) : (int)blockIdx.x, ustep = xg ? G_ / 8 : G_, uend = xg ? (((int)blockIdx.x & 7) + 1) * (3072 / 8) : 3072;
    __syncthreads();
    if (ustart < uend) DIL_LOAD(ustart);
    for (int u = ustart; u < uend; u += ustep) {
        const int pt = u >> 10, rem = u & 1023, bh = rem >> 6, blk = rem & 63, b = bh >> 3, h = bh & 7;
        const int dsh = 2 * pt, d = 1 << dsh, r = blk >> (6 - dsh), m0 = (blk & ((64 >> dsh) - 1)) * 128;
        LBAR();
#pragma unroll
        for (int p = 0; p < 8; ++p) { const int row = p * 32 + rr; *(u32x4*)(Ks + row * 272 + chunk * 16) = kv[p]; *(u32x4*)(Vs + row * 288 + chunk * 16) = vv[p]; }
        h16x8 qf[4];
#pragma unroll
        for (int kk = 0; kk < 4; ++kk) qf[kk] = qn[kk];
        { const int un = u + ustep < uend ? u + ustep : u; DIL_LOAD(un); }
        const int tq = (m0 + 16 * w + lq) * d + r;
        LBAR();
        f32x4 acc[9];
#pragma unroll
        for (int ti = 0; ti < 9; ++ti) { acc[ti] = (f32x4){0.f, 0.f, 0.f, 0.f};
#pragma unroll
            for (int kk = 0; kk < 4; ++kk) { const h16x8 kf = *(const h16x8*)(Ks + (16 * w + 16 * ti + lq) * 272 + (4 * kk + g) * 16); acc[ti] = MFMA16(kf, qf[kk], acc[ti]); } }
        const int kbase = m0 + 16 * w - 128;
        float mx = -1e30f;
#pragma unroll
        for (int ti = 0; ti < 9; ++ti)
#pragma unroll
            for (int i = 0; i < 4; ++i) { const int kr = 16 * ti + 4 * g + i; const bool valid = (kr >= lq) && (kr <= lq + 128) && (kbase + kr >= 0);
                const float sc = valid ? acc[ti][i] * QK_SCALE : -1e30f; acc[ti][i] = sc; mx = fmaxf(mx, sc); }
        mx = fmaxf(mx, __shfl_xor(mx, 16)); mx = fmaxf(mx, __shfl_xor(mx, 32));
        float sum = 0.f;
#pragma unroll
        for (int ti = 0; ti < 9; ++ti)
#pragma unroll
            for (int i = 0; i < 4; ++i) { const float p = __expf(acc[ti][i] - mx); acc[ti][i] = p; sum += p; }
        sum += __shfl_xor(sum, 16); sum += __shfl_xor(sum, 32);
        const float inv = 1.0f / sum;
        f32x4 o[8];
#pragma unroll
        for (int c = 0; c < 8; ++c) o[c] = (f32x4){0.f, 0.f, 0.f, 0.f};
#pragma unroll
        for (int s = 0; s < 5; ++s) {
            h16x8 pf;
#pragma unroll
            for (int j = 0; j < 4; ++j) { pf[j] = (h16)(acc[2 * s][j] * inv); pf[4 + j] = (s < 4) ? (h16)(acc[(s < 4) ? 2 * s + 1 : 0][j] * inv) : (h16)0.f; }
            const char* vb = Vs + (16 * w + 32 * s + 4 * g + (lq >> 2)) * 288 + (4 * (lq & 3)) * 2;
#pragma unroll
            for (int c = 0; c < 8; ++c) { const h16x4 t0 = trread(vb + c * 32); h16x4 t1 = (h16x4){(h16)0.f, (h16)0.f, (h16)0.f, (h16)0.f}; if (s < 4) t1 = trread(vb + 16 * 288 + c * 32);
                o[c] = MFMA16(mk8(t0, t1), pf, o[c]); }
        }
        h16* op = OP + ((size_t)pt * M + (size_t)(b * SEQ + tq)) * 1024 + h * 128 + 4 * g;
#pragma unroll
        for (int c = 0; c < 8; ++c) { u32x2 wv; wv.x = pkh(o[c][0], o[c][1]); wv.y = pkh(o[c][2], o[c][3]); *(u32x2*)(op + 16 * c) = wv; }
        if (g == 0) LSE[(size_t)(pt * 16 + bh) * SEQ + tq] = mx + __logf(sum);
    }
#undef DIL_LOAD
    __syncthreads();
}
DI void phase_combine(const Args& a) {
    const h16* OP = (const h16*)(a.ws + WS_OP); const float* LSE = (const float*)(a.ws + WS_LSE); h16* O0 = (h16*)(a.ws + WS_O0);
#pragma unroll 4
    for (size_t i = (size_t)blockIdx.x * NT + threadIdx.x; i < (size_t)M * 128; i += (size_t)gridDim.x * NT) {
        const int token = (int)(i >> 7), hc = (int)(i & 127), h = hc >> 4, b = token >> 13, t = token & 8191;
        const float l0 = LSE[(size_t)(0 * 16 + b * 8 + h) * SEQ + t], l1 = LSE[(size_t)(1 * 16 + b * 8 + h) * SEQ + t], l2 = LSE[(size_t)(2 * 16 + b * 8 + h) * SEQ + t];
        const float mx = fmaxf(l0, fmaxf(l1, l2)); float w0 = __expf(l0 - mx), w1 = __expf(l1 - mx), w2 = __expf(l2 - mx); const float inv = 1.0f / (w0 + w1 + w2); w0 *= inv; w1 *= inv; w2 *= inv;
        const size_t off = (size_t)token * 1024 + hc * 8;
        const h16x8 a0 = *(const h16x8*)(OP + off), a1 = *(const h16x8*)(OP + (size_t)M * 1024 + off), a2 = *(const h16x8*)(OP + (size_t)2 * M * 1024 + off);
        float r[8];
#pragma unroll
        for (int j = 0; j < 8; ++j) r[j] = w0 * (float)a0[j] + w1 * (float)a1[j] + w2 * (float)a2[j];
        u32x4 wv; wv.x = pkh(r[0], r[1]); wv.y = pkh(r[2], r[3]); wv.z = pkh(r[4], r[5]); wv.w = pkh(r[6], r[7]);
        *(u32x4*)(O0 + (size_t)token * 2048 + 1024 + hc * 8) = wv;
    }
}

DI void sb_tile(const f32x4& acc, int key0, int tq, int g, int lq, float& R, float (&wout)[4]) {
    float lk[4], lsz[4]; bool past[4];
#pragma unroll
    for (int i = 0; i < 4; ++i) { const int key = key0 + 4 * g + i; const float z = acc[i] * QK_SCALE; past[i] = (key < tq) && (key >= 0);
        const float sp = softplusf_(z); lk[i] = past[i] ? -sp : 0.f; lsz[i] = z - sp; }
    const float suf2 = lk[3], suf1 = suf2 + lk[2], suf0 = suf1 + lk[1], T = suf0 + lk[0];
    float IS = T; float t = __shfl_down(IS, 16); if (g < 3) IS += t; t = __shfl_down(IS, 32); if (g < 2) IS += t;
    const float G = IS - T, total = __shfl(IS, lq);
    const float base = R + G;
    wout[0] = past[0] ? __expf(lsz[0] + base + suf0) : 0.f; wout[1] = past[1] ? __expf(lsz[1] + base + suf1) : 0.f;
    wout[2] = past[2] ? __expf(lsz[2] + base + suf2) : 0.f; wout[3] = past[3] ? __expf(lsz[3] + base) : 0.f;
    R += total;
}
DI void phase_sb(const Args& a, char* lds) {
    const int tid = threadIdx.x, lane = tid & 63, w = __builtin_amdgcn_readfirstlane(tid >> 6), g = lane >> 4, lq = lane & 15;
    const h16* H0 = (const h16*)(a.ws + WS_H0); h16* O0 = (h16*)(a.ws + WS_O0);
    char* Vw = lds + w * 9216;
    const int G_ = gridDim.x, xg = (G_ % 8 == 0 && 1024 % G_ == 0) ? 1 : 0;
    const int bstart = xg ? ((int)blockIdx.x & 7) * 128 + ((int)blockIdx.x >> 3) : (int)blockIdx.x, bstep = xg ? G_ / 8 : G_, bend = xg ? (((int)blockIdx.x & 7) + 1) * 128 : 1024;
    for (int bu = bstart; bu < bend; bu += bstep) { const int wu = bu * NWAVES + w;
        const int bh = wu >> 9, qt = wu & 511, b = bh >> 3, h = bh & 7, q0 = 16 * qt, tq = q0 + lq;
        const h16* base = H0 + (size_t)(b * SEQ) * IN0 + h * 128;
        h16x8 qf[4];
#pragma unroll
        for (int kk = 0; kk < 4; ++kk) qf[kk] = *(const h16x8*)(base + (size_t)tq * IN0 + 32 * kk + 8 * g);
        float R = 0.f; f32x4 o[8];
#pragma unroll
        for (int c = 0; c < 8; ++c) o[c] = (f32x4){0.f, 0.f, 0.f, 0.f};
        for (int sb = q0 - 16; sb > -32; sb -= 32) {
            const int ra = max(sb + lq, 0), rb = sb + 16 + lq;
            h16x8 kfa[4], kfb[4];
#pragma unroll
            for (int kk = 0; kk < 4; ++kk) { kfa[kk] = *(const h16x8*)(base + (size_t)ra * IN0 + 1024 + 32 * kk + 8 * g); kfb[kk] = *(const h16x8*)(base + (size_t)rb * IN0 + 1024 + 32 * kk + 8 * g); }
            u32x4 vr[8];
#pragma unroll
            for (int i = 0; i < 8; ++i) { const int idx = lane + 64 * i, row = idx >> 4, chunk = idx & 15; vr[i] = *(const u32x4*)(base + (size_t)max(sb + row, 0) * IN0 + 2048 + chunk * 8); }
#pragma unroll
            for (int i = 0; i < 8; ++i) { const int idx = lane + 64 * i, row = idx >> 4, chunk = idx & 15; *(u32x4*)(Vw + row * 288 + chunk * 16) = vr[i]; }
            f32x4 accA = (f32x4){0.f, 0.f, 0.f, 0.f}, accB = accA;
#pragma unroll
            for (int kk = 0; kk < 4; ++kk) { accA = MFMA16(kfa[kk], qf[kk], accA); accB = MFMA16(kfb[kk], qf[kk], accB); }
            float wa[4], wb[4];
            sb_tile(accB, sb + 16, tq, g, lq, R, wb);
            sb_tile(accA, sb, tq, g, lq, R, wa);
            h16x8 pf;
#pragma unroll
            for (int j = 0; j < 4; ++j) { pf[j] = (h16)wa[j]; pf[4 + j] = (h16)wb[j]; }
            asm volatile("s_waitcnt lgkmcnt(0)" ::: "memory");
            const char* vb = Vw + (4 * g + (lq >> 2)) * 288 + (4 * (lq & 3)) * 2;
#pragma unroll
            for (int c = 0; c < 8; ++c) { const h16x4 t0 = trread(vb + c * 32), t1 = trread(vb + 16 * 288 + c * 32); o[c] = MFMA16(mk8(t0, t1), pf, o[c]); }
            asm volatile("s_waitcnt lgkmcnt(0)" ::: "memory");
            if (__all(R < -50.0f)) break;
        }
        h16* op = O0 + (size_t)(b * SEQ + tq) * 2048 + h * 128 + 4 * g;
#pragma unroll
        for (int c = 0; c < 8; ++c) { u32x2 wv; wv.x = pkh(o[c][0], o[c][1]); wv.y = pkh(o[c][2], o[c][3]); *(u32x2*)(op + 16 * c) = wv; }
    }
}

DI void phase_gdn_pre(const Args& a, char* lds, int row_lo, int row_hi, int first_block) {
    const int tid = threadIdx.x, lane = tid & 63, wave = tid >> 6, gw = ((int)blockIdx.x - first_block) * NWAVES + wave, ngw = ((int)gridDim.x - first_block) * NWAVES;
    if ((int)blockIdx.x < first_block) return;
    const h16* QKVG = (const h16*)(a.ws + WS_QKVG); const float* LOGIT = (const float*)(a.ws + WS_LOGIT); h16* QKVN = (h16*)(a.ws + WS_QKVN); float* GB = (float*)(a.ws + WS_GB);
    float* cw = (float*)lds;
    __syncthreads();
    for (int i = tid; i < 3072; i += NT) ((f32x4*)cw)[i] = ((const f32x4*)a.in[I_CONVW])[i];
    __syncthreads();
    for (int row = row_lo + gw; row < row_hi; row += ngw) { const int t = row & (SEQ - 1);
        float acc[6][8];
#pragma unroll
        for (int j = 0; j < 6; ++j)
#pragma unroll
            for (int q = 0; q < 8; ++q) acc[j][q] = 0.f;
#pragma unroll
        for (int i = 0; i < 4; ++i) { if (t - 3 + i >= 0) {
#pragma unroll
            for (int j = 0; j < 6; ++j) { const int c8 = 8 * (lane + 64 * j); const h16x8 xv = *(const h16x8*)(QKVG + (size_t)(row - 3 + i) * 4096 + c8);
                const f32x4 w0 = *(const f32x4*)(cw + i * 3072 + c8), w1 = *(const f32x4*)(cw + i * 3072 + c8 + 4);
#pragma unroll
                for (int q = 0; q < 8; ++q) acc[j][q] += (q < 4 ? w0[q & 3] : w1[q & 3]) * (float)xv[q]; } } }
#pragma unroll
        for (int j = 0; j < 6; ++j) { float ss = 0.f;
#pragma unroll
            for (int q = 0; q < 8; ++q) { acc[j][q] = siluf_(acc[j][q]); ss += acc[j][q] * acc[j][q]; }
            if (j < 4) { ss += __shfl_xor(ss, 1); ss += __shfl_xor(ss, 2); ss += __shfl_xor(ss, 4); ss += __shfl_xor(ss, 8); float rinv = 1.0f / sqrtf(ss + 1e-6f); if (j < 2) rinv *= QK_SCALE;
#pragma unroll
                for (int q = 0; q < 8; ++q) acc[j][q] *= rinv; }
            u32x4 wv; wv.x = pkh(acc[j][0], acc[j][1]); wv.y = pkh(acc[j][2], acc[j][3]); wv.z = pkh(acc[j][4], acc[j][5]); wv.w = pkh(acc[j][6], acc[j][7]);
            *(u32x4*)(QKVN + (size_t)row * 3072 + 8 * (lane + 64 * j)) = wv; }
        if (lane < 8) { const float bl = LOGIT[(size_t)row * 16 + lane], al = LOGIT[(size_t)row * 16 + 8 + lane];
            GB[(size_t)row * 16 + lane] = sigmoidf_(bl); GB[(size_t)row * 16 + 8 + lane] = -expf(a.in[I_ALOG][lane]) * softplusf_(al + a.in[I_DTB][lane]); }
    }
}
DI void phase_gdn_local(const Args& a, char* lds) {
    const int tid = threadIdx.x, lane = tid & 63, w = __builtin_amdgcn_readfirstlane(tid >> 6), g = lane >> 4, lq = lane & 15;
    const h16* QKVN = (const h16*)(a.ws + WS_QKVN); const float* GB = (const float*)(a.ws + WS_GB);
    constexpr int TB = 52224;
    int off_lm = 2 * TB, off_gc = 2 * TB + 16384; asm volatile("" : "+v"(off_lm)); asm volatile("" : "+v"(off_gc));
    float* Lm = (float*)(lds + off_lm);
    float* gcb = (float*)(lds + off_gc);
    float* Dinv = gcb + 384;
    int t2 = tid - 256;
    u32x4 pre[6]; float pg = 0.f, pb = 0.f;
#define GL_LOAD(un) do { const int b_ = (un) >> 10, n_ = ((un) >> 3) & 127, h_ = (un) & 7; const size_t row0_ = (size_t)b_ * SEQ + n_ * 64; const int tq_ = t2 + 256; \
        _Pragma("unroll") for (int k = 0; k < 6; ++k) { const int idx = tq_ + 512 * k, part = idx >> 10, r = (idx >> 4) & 63, ch = idx & 15; pre[k] = *(const u32x4*)(QKVN + (row0_ + r) * 3072 + part * 1024 + h_ * 128 + ch * 8); } \
        if (tq_ < 64) { pb = GB[(row0_ + tq_) * 16 + h_]; pg = GB[(row0_ + tq_) * 16 + 8 + h_]; } } while (0)
#define GL_STORE(buf) do { char* tb_ = lds + (buf) * TB; const int tq_ = t2 + 256; \
        _Pragma("unroll") for (int k = 0; k < 6; ++k) { const int idx = tq_ + 512 * k, part = idx >> 10, r = (idx >> 4) & 63, ch = idx & 15; *(u32x4*)(tb_ + part * 17408 + r * 272 + ch * 16) = pre[k]; } \
        if (tq_ < 64) { float s_ = pg; _Pragma("unroll") for (int o = 1; o < 64; o <<= 1) { const float t_ = __shfl_up(s_, o); if (lane >= o) s_ += t_; } \
            float* gq_ = gcb + (buf) * 192; gq_[tq_] = s_; gq_[64 + tq_] = pb; gq_[128 + tq_] = __expf(s_); } } while (0)
    __syncthreads();
    if ((int)blockIdx.x < GUNITS) { GL_LOAD((int)blockIdx.x); GL_STORE(0); }
    int cur = 0;
    for (int unit = blockIdx.x; unit < GUNITS; unit += gridDim.x, cur ^= 1) {
        asm volatile("" : "+v"(t2));
        const char* qh = lds + cur * TB; const char* kh = qh + 17408; const char* vh = qh + 34816;
        const float* gc = gcb + cur * 192; const float* bt = gc + 64; const float* eg = gc + 128;
        LBAR();
        { const int nu_ = unit + (int)gridDim.x < GUNITS ? unit + (int)gridDim.x : unit; GL_LOAD(nu_); }
        { const int which = w >> 2, ti = w & 3; const char* Ah = which ? qh : kh; h16* INTRA = (h16*)(a.ws + WS_GINTRA) + (size_t)unit * 4096;
#pragma unroll
          for (int tj = 0; tj < 4; ++tj) {
              if (tj <= ti) { f32x4 acc = (f32x4){0.f, 0.f, 0.f, 0.f};
#pragma unroll
                  for (int kk = 0; kk < 4; ++kk) { const h16x8 af = *(const h16x8*)(Ah + (16 * ti + lq) * 272 + (4 * kk + g) * 16), bf = *(const h16x8*)(kh + (16 * tj + lq) * 272 + (4 * kk + g) * 16); acc = MFMA16(af, bf, acc); }
#pragma unroll
                  for (int e = 0; e < 4; ++e) { const int i = 16 * ti + 4 * g + e, j = 16 * tj + lq; const float dec = (j <= i) ? __expf(gc[i] - gc[j]) : 0.f;
                      if (which == 0) Lm[i * 64 + j] = (j < i) ? -(acc[e] * bt[i] * dec) : 0.f; else INTRA[i * 64 + j] = (h16)(acc[e] * dec); } }
              else if (which) {
#pragma unroll
                  for (int e = 0; e < 4; ++e) INTRA[(16 * ti + 4 * g + e) * 64 + 16 * tj + lq] = (h16)0.f; } } }
        LBAR();
        if (tid < 256) { const int bb = w, c = lq; float nn[16];
#pragma unroll
            for (int i = 0; i < 16; ++i) { float sacc = (i == c) ? 1.f : 0.f;
#pragma unroll
                for (int j4 = 0; j4 < (i + 3) / 4; ++j4) { const f32x4 l = *(const f32x4*)(Lm + (16 * bb + i) * 64 + 16 * bb + 4 * j4);
#pragma unroll
                    for (int q = 0; q < 4; ++q) if (4 * j4 + q < i) sacc += l[q] * nn[4 * j4 + q]; }
                nn[i] = sacc; if (lane < 16) Dinv[bb * 256 + i * 16 + c] = sacc; } }
        else {
            h16* QD = (h16*)(a.ws + WS_GQD) + (size_t)unit * 8192; h16* KDT = (h16*)(a.ws + WS_GKDT) + (size_t)unit * 8192; const float gl = gc[63];
            for (int it = t2; it < 1024; it += 256) { const int i = it >> 4, c8 = (it & 15) * 8; const float e = eg[i]; const h16x8 qv = *(const h16x8*)(qh + i * 272 + c8 * 2);
                u32x4 wv; wv.x = pkh((float)qv[0] * e, (float)qv[1] * e); wv.y = pkh((float)qv[2] * e, (float)qv[3] * e); wv.z = pkh((float)qv[4] * e, (float)qv[5] * e); wv.w = pkh((float)qv[6] * e, (float)qv[7] * e); *(u32x4*)(QD + i * 128 + c8) = wv; }
            for (int it = t2; it < 1024; it += 256) { const int dk = it & 127, c0 = (it >> 7) * 8; float r[8];
#pragma unroll
                for (int j = 0; j < 8; ++j) r[j] = (float)((const h16*)kh)[(c0 + j) * 136 + dk] * __expf(gl - gc[c0 + j]);
                u32x4 wv; wv.x = pkh(r[0], r[1]); wv.y = pkh(r[2], r[3]); wv.z = pkh(r[4], r[5]); wv.w = pkh(r[6], r[7]); *(u32x4*)(KDT + dk * 64 + c0) = wv; }
            if (t2 == 0) ((float*)(a.ws + WS_GLAST))[unit] = __expf(gl); }
        LBAR();
#pragma unroll
        for (int cc = 0; cc < 2; ++cc) { const int ctile = 2 * w + cc, c = 16 * ctile + lq; const bool isv = ctile < 8; const h16* src = (const h16*)(isv ? vh : kh) + (c & 127);
            h16* dst = (h16*)(a.ws + (isv ? WS_GU : WS_GW)) + (size_t)unit * 8192 + (c & 127);
            f32x4 X[4];
#pragma unroll
            for (int bb = 0; bb < 4; ++bb) { f32x4 T;
#pragma unroll
                for (int i = 0; i < 4; ++i) { const int row = 16 * bb + 4 * g + i; float r = (float)src[row * 136] * bt[row]; if (!isv) r *= eg[row]; T[i] = r; }
#pragma unroll
                for (int b2 = 0; b2 < 4; ++b2) if (b2 < bb) { const f32x4 lv = *(const f32x4*)(Lm + (16 * bb + lq) * 64 + 16 * b2 + 4 * g);
#pragma unroll
                    for (int i = 0; i < 4; ++i) T = __builtin_amdgcn_mfma_f32_16x16x4f32(lv[i], X[b2][i], T, 0, 0, 0); }
                const f32x4 dv = *(const f32x4*)(Dinv + bb * 256 + lq * 16 + 4 * g); f32x4 Xb = (f32x4){0.f, 0.f, 0.f, 0.f};
#pragma unroll
                for (int i = 0; i < 4; ++i) Xb = __builtin_amdgcn_mfma_f32_16x16x4f32(dv[i], T[i], Xb, 0, 0, 0);
                X[bb] = Xb;
#pragma unroll
                for (int i = 0; i < 4; ++i) dst[(16 * bb + 4 * g + i) * 128] = (h16)Xb[i]; } }
        GL_STORE(cur ^ 1);
    }
#undef GL_LOAD
#undef GL_STORE
    __syncthreads();
}

struct GdnRegs { u32x4 rW[2], rQ[2], rI, rK[2]; h16 rU[4]; float rGl; };
DI void gdn_recur_job(const Args& a, char* lds, int job) {
    const int tid = threadIdx.x, lane = tid & 63, w = __builtin_amdgcn_readfirstlane(tid >> 6), g = lane >> 4, lq = lane & 15;
    const int bh = job >> 2, dv0 = (job & 3) * 32, b = bh >> 3, h = bh & 7;
    constexpr int OPB = 62464, O_QD = 17408, O_IN = 34816, O_KDT = 44032, O_SH = 2 * OPB, SHB = 8448, O_VN = O_SH + 2 * SHB;
    int zoff = 0; asm volatile("" : "+v"(zoff)); char* L = lds + zoff;
    const h16* GU = (const h16*)(a.ws + WS_GU); const h16* GW = (const h16*)(a.ws + WS_GW); const h16* GQD = (const h16*)(a.ws + WS_GQD);
    const h16* GKDT = (const h16*)(a.ws + WS_GKDT); const h16* GIN = (const h16*)(a.ws + WS_GINTRA); const float* GLAST = (const float*)(a.ws + WS_GLAST);
    h16* OG = (h16*)(a.ws + WS_OG);
    const int ct = w >> 1, dt = w & 1;
    f32x4 S0 = (f32x4){0.f, 0.f, 0.f, 0.f}, S1 = S0;
    GdnRegs RA, RB;
#define GDN_LOAD(R, nn) do { const size_t un = (size_t)((b * GNCH + (nn)) * 8 + h); \
        _Pragma("unroll") for (int k = 0; k < 2; ++k) { const int idx = tid + 512 * k; R.rW[k] = *(const u32x4*)(GW + un * 8192 + idx * 8); R.rQ[k] = *(const u32x4*)(GQD + un * 8192 + idx * 8); R.rK[k] = *(const u32x4*)(GKDT + un * 8192 + idx * 8); } \
        R.rI = *(const u32x4*)(GIN + un * 4096 + tid * 8); \
        _Pragma("unroll") for (int i = 0; i < 4; ++i) R.rU[i] = GU[un * 8192 + (16 * ct + 4 * g + i) * 128 + dv0 + 16 * dt + lq]; \
        R.rGl = GLAST[un + zoff]; } while (0)
#define GDN_STORE(R, buf) do { char* ob_ = L + (buf) * OPB; \
        _Pragma("unroll") for (int k = 0; k < 2; ++k) { const int idx = tid + 512 * k; *(u32x4*)(ob_ + (idx >> 4) * 272 + (idx & 15) * 16) = R.rW[k]; *(u32x4*)(ob_ + O_QD + (idx >> 4) * 272 + (idx & 15) * 16) = R.rQ[k]; \
            *(u32x4*)(ob_ + O_KDT + (idx >> 3) * 144 + (idx & 7) * 16) = R.rK[k]; } \
        *(u32x4*)(ob_ + O_IN + (tid >> 3) * 144 + (tid & 7) * 16) = R.rI; } while (0)
#define FR8(p) mk8(*(const h16x4*)(p), *(const h16x4*)((p) + 32))
#define GDN_STEP(n, cur, RN, RF) do { \
        const char* ob = L + (cur) * OPB; const char* sh = L + O_SH + (cur) * SHB; char* shn = L + O_SH + ((cur) ^ 1) * SHB; char* VN = L + O_VN; \
        GDN_LOAD(RF, ((n) + 2 < GNCH ? (n) + 2 : GNCH - 1));     \
        f32x4 a0 = (f32x4){0.f, 0.f, 0.f, 0.f}, a1 = a0; \
        _Pragma("unroll") for (int kk = 0; kk < 4; kk += 2) { const char* ap = ob + (16 * ct + lq) * 272 + (32 * kk + 4 * g) * 2; const char* bp = sh + (16 * dt + lq) * 264 + (32 * kk + 4 * g) * 2; \
            a0 = MFMA16(FR8(ap), FR8(bp), a0); a1 = MFMA16(FR8(ap + 64), FR8(bp + 64), a1); } \
        { h16x4 vn; _Pragma("unroll") for (int i = 0; i < 4; ++i) vn[i] = (h16)(uv[i] - (a0[i] + a1[i])); \
          *(h16x4*)(VN + (16 * dt + lq) * 136 + (16 * ct + 4 * g) * 2) = vn; } \
        f32x4 o0 = (f32x4){0.f, 0.f, 0.f, 0.f}, o1 = o0; \
        _Pragma("unroll") for (int kk = 0; kk < 4; kk += 2) { const char* ap = ob + O_QD + (16 * ct + lq) * 272 + (32 * kk + 4 * g) * 2; const char* bp = sh + (16 * dt + lq) * 264 + (32 * kk + 4 * g) * 2; \
            o0 = MFMA16(FR8(ap), FR8(bp), o0); o1 = MFMA16(FR8(ap + 64), FR8(bp + 64), o1); } \
        LBAR(); \
        { const char* ap = ob + O_IN + (16 * ct + lq) * 144 + (4 * g) * 2; const char* bp = VN + (16 * dt + lq) * 136 + (4 * g) * 2; \
          o0 = MFMA16(FR8(ap), FR8(bp), o0); o1 = MFMA16(FR8(ap + 64), FR8(bp + 64), o1); } \
        S0 = S0 * gl; S1 = S1 * gl; \
        _Pragma("unroll") for (int kk = 0; kk < 2; ++kk) { const char* ap = ob + O_KDT + (16 * w + lq) * 144 + (32 * kk + 4 * g) * 2; const h16x8 af = FR8(ap); \
            const char* b0 = VN + (lq) * 136 + (32 * kk + 4 * g) * 2; const char* b1 = VN + (16 + lq) * 136 + (32 * kk + 4 * g) * 2; \
            S0 = MFMA16(af, FR8(b0), S0); S1 = MFMA16(af, FR8(b1), S1); } \
        { h16* op = OG + (size_t)(b * SEQ + (n) * 64 + 16 * ct + 4 * g) * 1024 + h * 128 + dv0 + 16 * dt + lq; \
          _Pragma("unroll") for (int i = 0; i < 4; ++i) op[(size_t)i * 1024] = (h16)(o0[i] + o1[i]); } \
        { h16x4 s0, s1; _Pragma("unroll") for (int i = 0; i < 4; ++i) { s0[i] = (h16)S0[i]; s1[i] = (h16)S1[i]; } \
          *(h16x4*)(shn + (lq) * 264 + (16 * w + 4 * g) * 2) = s0; *(h16x4*)(shn + (16 + lq) * 264 + (16 * w + 4 * g) * 2) = s1; } \
        { GDN_STORE(RN, (cur) ^ 1); _Pragma("unroll") for (int i = 0; i < 4; ++i) uv[i] = (float)RN.rU[i]; gl = RN.rGl; } \
        LBAR(); } while (0)
    __syncthreads();
    GDN_LOAD(RA, 0); GDN_LOAD(RB, 1);
    { const h16x4 z = (h16x4){(h16)0.f, (h16)0.f, (h16)0.f, (h16)0.f}; *(h16x4*)(L + O_SH + (lq) * 264 + (16 * w + 4 * g) * 2) = z; *(h16x4*)(L + O_SH + (16 + lq) * 264 + (16 * w + 4 * g) * 2) = z; }
    GDN_STORE(RA, 0);
    float uv[4];
#pragma unroll
    for (int i = 0; i < 4; ++i) uv[i] = (float)RA.rU[i];
    float gl = RA.rGl;
    LBAR();
    for (int n = 0; n < GNCH; n += 2) { GDN_STEP(n, 0, RB, RA); GDN_STEP(n + 1, 1, RA, RB); }
#undef GDN_LOAD
#undef GDN_STORE
#undef GDN_STEP
#undef FR8
    __syncthreads();
}
DI void s5_scan_job(const Args& a, int j) {
    const int T = j * NT + threadIdx.x, b = T >> 12, g = (T >> 6) & 63, p = T & 63;
    const float dt = expf(a.in[I_LOGDT][g]); const float lre = a.in[I_LAMRE][g * 64 + p], lim = a.in[I_LAMIM][g * 64 + p];
    const float mag = expf(lre * dt); float sn, cs; sincosf(lim * dt, &sn, &cs); float lr = mag * cs, li = mag * sn;
#pragma unroll
    for (int i = 0; i < 5; ++i) { const float nr = lr * lr - li * li, ni = 2.f * lr * li; lr = nr; li = ni; }
    const float* EC = (const float*)(a.ws + WS_EC) + ((size_t)(g * S5N + b * S5NCH)) * 128 + 2 * p;
    h16* UC = (h16*)(a.ws + WS_UCAT) + ((size_t)(g * S5N + b * S5NCH)) * S5K + 512 + 2 * p;
    float cr = 0.f, ci = 0.f;
    for (int c0 = 0; c0 < S5NCH; c0 += 16) { f32x2 e[16];
#pragma unroll
        for (int k = 0; k < 16; ++k) e[k] = *(const f32x2*)(EC + (size_t)(c0 + k) * 128);
#pragma unroll
        for (int k = 0; k < 16; ++k) { *(unsigned*)(UC + (size_t)(c0 + k) * S5K) = pkh(cr, ci); const float nr = lr * cr - li * ci + e[k].x, ni = lr * ci + li * cr + e[k].y; cr = nr; ci = ni; } }
}
DI void phase_gdn_final(const Args& a) {
    const int tid = threadIdx.x, lane = tid & 63, wave = tid >> 6, gw = blockIdx.x * NWAVES + wave, ngw = gridDim.x * NWAVES;
    const h16* OG = (const h16*)(a.ws + WS_OG); const h16* QKVG = (const h16*)(a.ws + WS_QKVG); h16* MIX = (h16*)(a.ws + WS_MIXIN); const float* nw = a.in[I_NORMW] + ((16 * lane) & 127);
    float nwv[16];
#pragma unroll
    for (int j = 0; j < 16; ++j) nwv[j] = nw[j];
    for (int tA = gw; tA < M; tA += 2 * ngw) { const int tB = tA + ngw < M ? tA + ngw : tA;
        h16x8 o[2][2], gt[2][2];
#pragma unroll
        for (int r = 0; r < 2; ++r) { const size_t t = r ? tB : tA;
#pragma unroll
            for (int q = 0; q < 2; ++q) { o[r][q] = *(const h16x8*)(OG + t * 1024 + 16 * lane + 8 * q); gt[r][q] = *(const h16x8*)(QKVG + t * 4096 + 3072 + 16 * lane + 8 * q); } }
#pragma unroll
        for (int r = 0; r < 2; ++r) { const size_t t = r ? tB : tA; float ss = 0.f;
#pragma unroll
            for (int q = 0; q < 2; ++q)
#pragma unroll
                for (int j = 0; j < 8; ++j) { const float v = (float)o[r][q][j]; ss += v * v; }
            ss += __shfl_xor(ss, 1); ss += __shfl_xor(ss, 2); ss += __shfl_xor(ss, 4);
            const float rinv = 1.0f / sqrtf(ss * (1.f / 128.f) + 1e-6f);
            if (r == 0 || tB != tA) {
#pragma unroll
                for (int q = 0; q < 2; ++q) { float y[8];
#pragma unroll
                    for (int j = 0; j < 8; ++j) y[j] = (float)o[r][q][j] * rinv * nwv[8 * q + j] * siluf_((float)gt[r][q][j]);
                    u32x4 wv; wv.x = pkh(y[0], y[1]); wv.y = pkh(y[2], y[3]); wv.z = pkh(y[4], y[5]); wv.w = pkh(y[6], y[7]);
                    *(u32x4*)(MIX + t * 2048 + 1024 + 16 * lane + 8 * q) = wv; } } }
    }
}

DI void phase_logits(const Args& a) {
    const int tid = threadIdx.x, lane = tid & 63, wave = tid >> 6, g = lane >> 4, lq = lane & 15;
    const h16* XH = (const h16*)(a.ws + WS_XH); const h16* WT = (const h16*)(a.ws + WS_WIN1) + (size_t)5120 * D; float* LOGIT = (float*)(a.ws + WS_LOGIT);
    for (int wu = blockIdx.x * NWAVES + wave; wu < M / 16; wu += gridDim.x * NWAVES) {
        const h16* ap = XH + (size_t)(wu * 16 + lq) * D + 8 * g; const h16* bp = WT + (size_t)lq * D + 8 * g;
        f32x4 c0 = (f32x4){0.f, 0.f, 0.f, 0.f}, c1 = c0;
#pragma unroll 2
        for (int k8 = 0; k8 < 64; k8 += 8) { h16x8 af[8], bf[8];
#pragma unroll
            for (int j = 0; j < 8; ++j) { af[j] = *(const h16x8*)(ap + 32 * (k8 + j)); bf[j] = *(const h16x8*)(bp + 32 * (k8 + j)); }
#pragma unroll
            for (int j = 0; j < 8; j += 2) { c0 = MFMA16(af[j], bf[j], c0); c1 = MFMA16(af[j + 1], bf[j + 1], c1); } }
#pragma unroll
        for (int i = 0; i < 4; ++i) LOGIT[(size_t)(wu * 16 + 4 * g + i) * 16 + lq] = c0[i] + c1[i];
    }
}

struct MoeTiles { int tp[9]; int cnt[8]; };
DI MoeTiles moe_tiles(const Args& a) { MoeTiles t; const unsigned* cnt = (const unsigned*)(a.ws + WS_CTL) + CW_CNT; t.tp[0] = 0;
#pragma unroll
    for (int e = 0; e < 8; ++e) { const int c = (int)__builtin_amdgcn_readfirstlane((int)cnt[e]); t.cnt[e] = c; t.tp[e + 1] = t.tp[e] + ((c + 255) >> 8); }
    return t; }
template <class Sched>
DI void moe_fill_toktab(const Args& a, LAS unsigned char* lds, const Sched& S, const MoeTiles& mt) {
    const int tid = threadIdx.x;
    LAS unsigned short* tt = (LAS unsigned short*)(lds + TOKTAB_OFF); LAS int* info = (LAS int*)(lds + TOKTAB_OFF + TOKTAB_UNITS * 512);
    const int* lst = (const int*)(a.ws + WS_LIST);
    __syncthreads();
    if (tid < TOKTAB_UNITS) { pg8::Unit u; int base = 0, rem = 0;
        if (S.next(tid, u)) { int st = 0, cn = 0;
#pragma unroll
            for (int q = 0; q < 8; ++q) if (q == u.grp) { st = mt.tp[q]; cn = mt.cnt[q]; }
            base = (u.grp << 14) + (u.pm - st) * 256; rem = cn - (u.pm - st) * 256; }
        info[2 * tid] = base; info[2 * tid + 1] = rem; }
    __syncthreads();
    int tok[TOKTAB_UNITS / 2];
#pragma unroll
    for (int k = 0; k < TOKTAB_UNITS / 2; ++k) { const int q = tid + NT * k, i = q >> 8, r = q & 255; const int base = info[2 * i], rem = info[2 * i + 1]; tok[k] = lst[base + (r < rem ? r : 0)]; if (r >= rem) tok[k] = 0; }
#pragma unroll
    for (int k = 0; k < TOKTAB_UNITS / 2; ++k) tt[tid + NT * k] = (unsigned short)tok[k];
    __syncthreads();
}

enum { PH_PRO, PH_H0, PH_DIL, PH_SB, PH_WOUT0, PH_LN1, PH_FFUP, PH_FFDN, PH_LN2, PH_WIN1, PH_GPRE, PH_GLOC, PH_REC, PH_S5Y, PH_GLU, PH_WOUT1, PH_LN3, PH_MUP, PH_MDN, PH_FINAL, N_PHASES };
#ifndef SKIP_EC
#define SKIP_EC 0
#endif
#ifndef SKIP_GL
#define SKIP_GL 0
#endif
__global__ void __launch_bounds__(NT, 2) hybrid_fwd(Args args) {
    extern __shared__ __attribute__((aligned(16))) unsigned char lds_raw[];
    char* lds = (char*)lds_raw;
    LAS unsigned char* ldsl = (LAS unsigned char*)lds_raw;
    const int tid = threadIdx.x;
    volatile LAS unsigned* MISC = (volatile LAS unsigned*)(ldsl + MISC_OFF);
    if (tid < 64) MISC[tid] = 0u;
    __syncthreads();
    unsigned char* ws = args.ws;
    XcdBarrier bar; bar.bar = (unsigned*)(ws + WS_CTL) + CW_BAR; bar.x = 0; bar.st = nullptr;
    if (N_LAUNCH_MODE == 1) bar = xcd_barrier_post((unsigned*)(ws + WS_CTL) + CW_BAR, MISC + 8);
    const int lo = args.ph_lo, hi = args.ph_hi, G = gridDim.x, bx = blockIdx.x;
#ifndef PH_MASK
#define PH_MASK 0xFFFFFFFu
#endif
#define IN(k) (((PH_MASK >> (k)) & 1u) && lo <= (k) && (k) < hi)
#define SEAM(k) do { if (IN(k) && IN((k) + 1)) xcd_barrier(bar); } while (0)
#ifndef PROBE_PHASE
#define PROBE_PHASE (-1)
#endif
#ifndef PROBE_REPS
#define PROBE_REPS 2
#endif
#define REP(k) _Pragma("unroll 1") for (int _r = 0; _r < ((PROBE_PHASE == (k)) ? PROBE_REPS : 1); ++_r)
    using namespace pg8;
    h16* XH = (h16*)(ws + WS_XH); h16* P = (h16*)args.out;

    if (IN(PH_PRO)) { REP(PH_PRO) phase_prologue(args, lds); } SEAM(PH_PRO);
    if (IN(PH_H0)) { DenseSched S{XH, (const h16*)(ws + WS_WIN0), D, D, M / 256, IN0 / 256, G, bx}; EpiH E{(h16*)(ws + WS_H0), IN0}; gemm_phase(ldsl, D, S, E); if (PROBE_PHASE == PH_H0) gemm_phase(ldsl, D, S, E); } SEAM(PH_H0);
    if (IN(PH_DIL)) { phase_dilated(args, lds); if (PROBE_PHASE == PH_DIL) phase_dilated(args, lds); } SEAM(PH_DIL);
    if (IN(PH_SB)) { REP(PH_SB) phase_sb(args, lds); phase_combine(args); } SEAM(PH_SB);
    if (IN(PH_WOUT0)) { DenseSched S{(const h16*)(ws + WS_O0), (const h16*)(ws + WS_WOUT0), D, D, M / 256, D / 256, G, bx}; EpiRes E{XH, P, D}; gemm_phase(ldsl, D, S, E); } SEAM(PH_WOUT0);
    if (IN(PH_LN1)) { phase_ln<false>(args, lds, P, args.in[I_ELNMG], args.in[I_ELNMB]); if (PROBE_PHASE == PH_LN1) phase_ln<false>(args, lds, P, args.in[I_ELNMG], args.in[I_ELNMB]); } SEAM(PH_LN1);
    if (IN(PH_FFUP)) { DenseSched S{XH, (const h16*)(ws + WS_WFF13), D, D, M / 256, 2 * DFF / 256, G, bx}; EpiSwiGLU E{(h16*)(ws + WS_HFF), DFF, AQ_DROP}; gemm_phase(ldsl, D, S, E); if (PROBE_PHASE == PH_FFUP) gemm_phase(ldsl, D, S, E); } SEAM(PH_FFUP);
    if (IN(PH_FFDN)) { DenseSched S{(const h16*)(ws + WS_HFF), (const h16*)(ws + WS_WFF2), DFF, DFF, M / 256, D / 256, G, bx}; EpiRes E{XH, P, D}; gemm_phase(ldsl, DFF, S, E); if (PROBE_PHASE == PH_FFDN) { EpiRes E{XH, P, D}; gemm_phase(ldsl, DFF, S, E); } } SEAM(PH_FFDN);
    if (IN(PH_LN2)) { phase_ln<false>(args, lds, P, args.in[I_ELNFG], args.in[I_ELNFB]); } SEAM(PH_LN2);
    if (IN(PH_WIN1)) { DenseSched S{XH, (const h16*)(ws + WS_WIN1), D, D, M / 256, 20, G, bx}; EpiIn1 E{(h16*)(ws + WS_UCAT), (h16*)(ws + WS_QKVG), (float*)(ws + WS_LOGIT)}; gemm_phase(ldsl, D, S, E); phase_logits(args); if (PROBE_PHASE == PH_WIN1) gemm_phase(ldsl, D, S, E); phase_logits(args); } SEAM(PH_WIN1);
    if (IN(PH_GPRE)) { GroupSched S{(const h16*)(ws + WS_UCAT), (const h16*)(ws + WS_EPAD), S5K, 512, 2, 1, 64, G, bx, (size_t)S5N * S5K, (size_t)256 * 512}; EpiEC E{(float*)(ws + WS_EC)}; gemm_phase(ldsl, 512, S, E);
                  if (G == 256) { phase_gdn_pre(args, lds, 0, 10752, 0); phase_gdn_pre(args, lds, 10752, M, 128); }
                  else phase_gdn_pre(args, lds, 0, M, 0); } SEAM(PH_GPRE);
    if (IN(PH_GLOC)) { REP(PH_GLOC) phase_gdn_local(args, lds); } SEAM(PH_GLOC);
    if (IN(PH_REC)) { REP(PH_REC) for (int job = bx; job < 80; job += G) { if (job < 64) gdn_recur_job(args, lds, job); else s5_scan_job(args, job - 64); }
                      if (G > 80) { if (bx >= 80) moe_convert(args, lds, MOE_CONV_LATE, NEXP, (bx - 80) * NWAVES + (tid >> 6), (G - 80) * NWAVES); }
                      else moe_convert(args, lds, MOE_CONV_LATE, NEXP, bx * NWAVES + (tid >> 6), G * NWAVES); } SEAM(PH_REC);
    if (IN(PH_S5Y)) { GroupSched S{(const h16*)(ws + WS_UCAT), (const h16*)(ws + WS_TCAT), S5K, S5K, 2, 2, 64, G, bx, (size_t)S5N * S5K, (size_t)512 * S5K}; EpiS5Y E{(const h16*)(ws + WS_UCAT), args.in[I_SSMD], (h16*)(ws + WS_Z)}; gemm_phase(ldsl, S5K, S, E); if (PROBE_PHASE == PH_S5Y) gemm_phase(ldsl, S5K, S, E);
                  phase_gdn_final(args); } SEAM(PH_S5Y);
    if (IN(PH_GLU)) { DenseSched S{(const h16*)(ws + WS_Z), (const h16*)(ws + WS_WGLU), 1024, 1024, M / 256, 4, G, bx}; EpiGLU E{(const h16*)(ws + WS_Z), args.in[I_GLUB], (h16*)(ws + WS_MIXIN)}; gemm_phase(ldsl, 1024, S, E); if (PROBE_PHASE == PH_S5Y) gemm_phase(ldsl, 1024, S, E); } SEAM(PH_GLU);
    if (IN(PH_WOUT1)) { DenseSched S{(const h16*)(ws + WS_MIXIN), (const h16*)(ws + WS_WOUT1), D, D, M / 256, D / 256, G, bx}; EpiRes E{XH, P, D}; gemm_phase(ldsl, D, S, E); } SEAM(PH_WOUT1);
    if (IN(PH_LN3)) { phase_ln<true>(args, lds, P, args.in[I_OLNMG], args.in[I_OLNMB]); } SEAM(PH_LN3);
    if (IN(PH_MUP)) { const MoeTiles mt = moe_tiles(args); MoeGatherSched S{ws + WS_XQ8, ws + WS_MOE13, D, D, 2 * DFE / 256, G, bx, mt.tp[1], mt.tp[2], mt.tp[3], mt.tp[4], mt.tp[5], mt.tp[6], mt.tp[7], mt.tp[8], 1};
                  moe_fill_toktab(args, ldsl, S, mt);
                  EpiSwiGLU8 E{(unsigned char*)(ws + WS_HMOE), DFE, 1.0f / (X8_SCALE * W8_SCALE)}; gemm_phase8(ldsl, D, S, E); if (PROBE_PHASE == PH_MUP) gemm_phase8(ldsl, D, S, E); } SEAM(PH_MUP);
    if (IN(PH_MDN)) { const MoeTiles mt = moe_tiles(args); const int nMt = mt.tp[8], R = (nMt * 8) % 256, pm0 = nMt - R / 8, sp = tail_split8(R); const float ysc = 1.0f / (H8_SCALE * W8_SCALE);
                  MoeSched S{ws + WS_HMOE, ws + WS_MOE2, DFE, DFE, D / 256, G, bx, mt.tp[1], mt.tp[2], mt.tp[3], mt.tp[4], mt.tp[5], mt.tp[6], mt.tp[7], pm0, 1};
                  EpiHs E{(h16*)(ws + WS_XG), D, ysc}; gemm_phase8(ldsl, DFE, S, E); if (PROBE_PHASE == PH_MDN) gemm_phase8(ldsl, DFE, S, E);
                  TailSched T{ws + WS_HMOE, ws + WS_MOE2, DFE, DFE, D / 256, G, bx, pm0, R, sp, DFE / sp, mt.tp[1], mt.tp[2], mt.tp[3], mt.tp[4], mt.tp[5], mt.tp[6], mt.tp[7], 1};
                  EpiSlab ES{(float*)(ws + WS_SLAB), ysc}; gemm_phase8(ldsl, DFE / sp, T, ES); if (PROBE_PHASE == PH_MDN) gemm_phase8(ldsl, DFE / sp, T, ES); } SEAM(PH_MDN);
    if (IN(PH_FINAL)) { const MoeTiles mt = moe_tiles(args); const int nMt = mt.tp[8], R = (nMt * 8) % 256; phase_final(args, nMt - R / 8, R, tail_split8(R), mt.tp[1], mt.tp[2], mt.tp[3], mt.tp[4], mt.tp[5], mt.tp[6], mt.tp[7]); }
#undef IN
#undef SEAM
}

extern "C" void kernel_launch(void* const* d_in, const int* in_sizes, int n_in, void* d_out, int out_size, void* d_ws, size_t ws_size, hipStream_t stream) {
    static int grid = 0;
    if (grid == 0) {
        if (n_in != 34 || out_size != M * D || ws_size < WS_END) { fprintf(stderr, "kernel_launch: unexpected shapes (n_in %d out %d ws %zu need %zu)\n", n_in, out_size, ws_size, (size_t)WS_END); grid = -1; return; }
        int dev = 0, cus = 0, per_cu = 0;
        if (hipGetDevice(&dev) != hipSuccess || hipDeviceGetAttribute(&cus, hipDeviceAttributeMultiprocessorCount, dev) != hipSuccess) { grid = -1; return; }
        if (hipFuncSetAttribute((const void*)hybrid_fwd, hipFuncAttributeMaxDynamicSharedMemorySize, LDS_BYTES) != hipSuccess) { fprintf(stderr, "kernel_launch: hipFuncSetAttribute failed\n"); grid = -1; return; }
        if (hipOccupancyMaxActiveBlocksPerMultiprocessor(&per_cu, (const void*)hybrid_fwd, NT, LDS_BYTES) != hipSuccess || per_cu < 1) fprintf(stderr, "kernel_launch: occupancy query says %d\n", per_cu);
        (void)hipGetLastError();
        grid = cus;
    }
    if (grid < 0) return;
    (void)hipMemsetAsync((char*)d_ws + WS_CTL, 0, CTL_BYTES, stream);
    Args a{};
    for (int i = 0; i < 34; ++i) a.in[i] = (const float*)d_in[i];
    a.out = (float*)d_out; a.ws = (unsigned char*)d_ws;
#if N_LAUNCH_MODE == 1
    a.ph_lo = 0; a.ph_hi = N_PHASES;
    hipLaunchKernelGGL(hybrid_fwd, dim3(grid), dim3(NT), LDS_BYTES, stream, a);
#else
    for (int p = 0; p < N_PHASES; ++p) { a.ph_lo = p; a.ph_hi = p + 1; hipLaunchKernelGGL(hybrid_fwd, dim3(grid), dim3(NT), LDS_BYTES, stream, a); }
#endif
}
```

```cpp
#include <hip/hip_runtime.h>
#include <stdint.h>
#include <stdio.h>

#define LAS __attribute__((address_space(3)))
#define GAS __attribute__((address_space(1)))
#define DI __device__ __forceinline__
typedef _Float16 h16;
typedef _Float16 h16x2 __attribute__((ext_vector_type(2)));
typedef _Float16 h16x4 __attribute__((ext_vector_type(4)));
typedef _Float16 h16x8 __attribute__((ext_vector_type(8)));
typedef float f32x2 __attribute__((ext_vector_type(2)));
typedef float f32x4 __attribute__((ext_vector_type(4)));
typedef unsigned u32x2 __attribute__((ext_vector_type(2)));
typedef unsigned u32x4 __attribute__((ext_vector_type(4)));
typedef short v4i16_t __attribute__((ext_vector_type(4)));

#ifndef N_LAUNCH_MODE
#define N_LAUNCH_MODE 1
#endif
#ifndef DBG_CHECK
#define DBG_CHECK 0
#endif

constexpr int NT = 512, NWAVES = 8;
constexpr int M = 16384, D = 2048, SEQ = 8192;
constexpr int IN0 = 6144, DFF = 5632, IN1 = 5136, IN1P = 5376, DFE = 7168, NEXP = 8;
constexpr float ALPHA = 1.41421356237309515f;
constexpr float QK_SCALE = 0.08838834764831845f;
constexpr int S5L = 32, S5NCH = SEQ / S5L, S5N = 2 * S5NCH  , S5K = 640  ;
constexpr int GDC = 64, GNCH = SEQ / GDC  , GUNITS = 2 * GNCH * 8  ;
constexpr int XG_ROWS = 2 * M + NEXP * 256;

constexpr size_t MiB = 1u << 20;
constexpr size_t WS_CTL = 0, CTL_BYTES = 1 * MiB;
constexpr size_t WS_MOE13 = 1 * MiB;
constexpr size_t WS_MOE2 = 449 * MiB;
constexpr size_t WS_X = 673 * MiB;
constexpr size_t WS_XH = 801 * MiB;
constexpr size_t WS_WIN0 = 865 * MiB;
constexpr size_t WS_WOUT0 = 889 * MiB;
constexpr size_t WS_WFF13 = 897 * MiB;
constexpr size_t WS_WFF2 = 941 * MiB;
constexpr size_t WS_WIN1 = 963 * MiB;
constexpr size_t WS_WGLU = 984 * MiB;
constexpr size_t WS_WOUT1 = 986 * MiB;
constexpr size_t WS_TCAT = 994 * MiB;
constexpr size_t WS_EPAD = 1034 * MiB;
constexpr size_t WS_SCR = 1050 * MiB;
constexpr size_t WS_END = 1792 * MiB;
constexpr size_t WS_H0 = WS_SCR;
constexpr size_t WS_OP = WS_SCR + 192 * MiB;
constexpr size_t WS_LSE = WS_SCR + 288 * MiB;
constexpr size_t WS_O0 = WS_SCR + 290 * MiB;
constexpr size_t WS_HFF = WS_SCR;
constexpr size_t WS_UCAT = WS_SCR;
constexpr size_t WS_QKVG = WS_SCR + 40 * MiB;
constexpr size_t WS_LOGIT = WS_SCR + 168 * MiB;
constexpr size_t WS_EC = WS_SCR + 169 * MiB;
constexpr size_t WS_GU = WS_SCR + 185 * MiB;
constexpr size_t WS_GW = WS_SCR + 217 * MiB;
constexpr size_t WS_GQD = WS_SCR + 249 * MiB;
constexpr size_t WS_GKDT = WS_SCR + 281 * MiB;
constexpr size_t WS_GINTRA = WS_SCR + 313 * MiB;
constexpr size_t WS_GLAST = WS_SCR + 329 * MiB;
constexpr size_t WS_OG = WS_SCR + 330 * MiB;
constexpr size_t WS_Z = WS_SCR + 362 * MiB;
constexpr size_t WS_MIXIN = WS_SCR + 394 * MiB;
constexpr size_t WS_QKVN = WS_SCR + 458 * MiB;
constexpr size_t WS_GB = WS_SCR + 554 * MiB;
constexpr size_t WS_HMOE = WS_SCR;
constexpr size_t WS_XG = WS_SCR + 476 * MiB;
constexpr size_t WS_TOK = WS_SCR + 612 * MiB;
constexpr size_t WS_SLAB = WS_SCR + 614 * MiB;
static_assert((size_t)XG_ROWS * DFE * 2 <= 476 * MiB && (size_t)XG_ROWS * D * 2 <= 136 * MiB && WS_TOK + 1 * MiB <= WS_END, "moe scratch");
static_assert(WS_SLAB + 64 * MiB <= WS_END && WS_MIXIN + 64 * MiB <= WS_END && WS_O0 + 64 * MiB <= WS_END, "scratch");
constexpr int CW_BAR = 0;
constexpr int CW_CNT = 4096;
constexpr int CW_DBG = 8192;

constexpr int MISC_OFF = 155648;
constexpr int LDS_BYTES = MISC_OFF + 1024;
constexpr int TOKTAB_OFF = 131072, TOKTAB_UNITS = 46;
constexpr size_t WS_XQ8 = WS_SCR + 240 * MiB;
constexpr size_t WS_LIST = WS_TOK + 512 * 1024;

DI unsigned pkh(float a, float b) { f32x2 v = {a, b}; return __builtin_bit_cast(unsigned, __builtin_convertvector(v, h16x2)); }
#ifndef WQ_DROP
#define WQ_DROP 4
#endif
#ifndef AQ_DROP
#define AQ_DROP 2
#endif
DI unsigned pka(float a, float b) { const unsigned u = pkh(a, b); if (AQ_DROP == 0) return u; constexpr unsigned H = (1u << (AQ_DROP - 1)) * 0x00010001u, Mk = ~(((1u << AQ_DROP) - 1u) * 0x00010001u); return (u + H) & Mk; }
DI unsigned rnd_drop(unsigned u, int drop) { if (drop <= 0) return u; const unsigned h = (1u << (drop - 1)) * 0x00010001u, mk = ~(((1u << drop) - 1u) * 0x00010001u); return (u + h) & mk; }
#ifndef WQ_MOE
#define WQ_MOE 5
#endif
#ifndef AQ_MOE
#define AQ_MOE 4
#endif
DI unsigned pkw(float a, float b) { const unsigned u = pkh(a, b); if (WQ_DROP == 0) return u; constexpr unsigned H = (1u << (WQ_DROP - 1)) * 0x00010001u, Mk = ~(((1u << WQ_DROP) - 1u) * 0x00010001u); return (u + H) & Mk; }
DI float wave_sum(float v) {
#pragma unroll
    for (int o = 32; o >= 1; o >>= 1) v += __shfl_xor(v, o);
    return v;
}
DI float fast_rcp(float x) { return __builtin_amdgcn_rcpf(x); }
DI float sigmoidf_(float x) { return fast_rcp(1.0f + __expf(-x)); }
DI float siluf_(float x) { return x * sigmoidf_(x); }
DI float softplusf_(float z) { return fmaxf(z, 0.f) + __logf(1.0f + __expf(-fabsf(z))); }
DI h16x8 mk8(h16x4 a, h16x4 b) { return __builtin_shufflevector(a, b, 0, 1, 2, 3, 4, 5, 6, 7); }
DI h16x4 trread(const char* p) { return __builtin_bit_cast(h16x4, __builtin_amdgcn_ds_read_tr16_b64_v4i16((LAS v4i16_t*)p)); }
#define MFMA16(a, b, c) __builtin_amdgcn_mfma_f32_16x16x32_f16((a), (b), (c), 0, 0, 0)
#define LBAR() do { asm volatile("s_waitcnt lgkmcnt(0)" ::: "memory"); __builtin_amdgcn_s_barrier(); asm volatile("" ::: "memory"); } while (0)

#define XB_TMO      128
#define XB_XCNT(j)  (256  + 64 * (j))
#define XB_XSUB(j)  (1280 + 64 * (j))
#define XB_XGEN(j)  (2304 + 64 * (j))
#define XB_TOP      3328
#define XB_TOPGEN   3392
#define XCD_BAR_WORDS 3456
#define XB_SPIN_CAP (1u << 22)
__device__ __forceinline__ unsigned xb_ld(unsigned* p)              { return __hip_atomic_load(p, __ATOMIC_RELAXED, __HIP_MEMORY_SCOPE_AGENT); }
__device__ __forceinline__ unsigned xb_add(unsigned* p, unsigned v) { return __hip_atomic_fetch_add(p, v, __ATOMIC_RELAXED, __HIP_MEMORY_SCOPE_AGENT); }
__device__ __forceinline__ unsigned xb_xcc_id() { return (unsigned)__builtin_amdgcn_s_getreg((3 << 11) | 20) & 0xFu; }
#define XB_SPIN(cond, bar) do { unsigned _sp = 0; while (cond) { __builtin_amdgcn_s_sleep(1); \
    if ((++_sp & 255u) == 0u) { if (xb_ld(&(bar)[XB_TMO])) break; if (_sp > XB_SPIN_CAP) { atomicAdd(&(bar)[XB_TMO], 1u); break; } } } } while (0)
struct XcdBarrier { unsigned* bar; unsigned x; volatile LAS unsigned* st; };
__device__ __forceinline__ XcdBarrier xcd_barrier_post(unsigned* bar, volatile LAS unsigned* st) {
    XcdBarrier b; b.bar = bar; b.x = xb_xcc_id(); b.st = st;
    if (threadIdx.x == 0) (void)xb_add(&bar[XB_XCNT(b.x)], 1u);
    return b;
}
__device__ __forceinline__ void xcd_barrier_complete(unsigned* bar, unsigned x, unsigned& nloc, unsigned& nx) {
    const unsigned G = gridDim.x * gridDim.y * gridDim.z;
    unsigned sum, cnt, mine, sp = 0u;
    for (;;) {
        sum = 0u; cnt = 0u; mine = 0u;
#pragma unroll
        for (unsigned j = 0; j < 16; ++j) { const unsigned c = xb_ld(&bar[XB_XCNT(j)]); sum += c; cnt += (c > 0u) ? 1u : 0u; mine = (j == x) ? c : mine; }
        if (sum == G) break;
        __builtin_amdgcn_s_sleep(1);
        if ((++sp & 255u) == 0u) { if (xb_ld(&bar[XB_TMO])) break; if (sp > XB_SPIN_CAP) { atomicAdd(&bar[XB_TMO], 1u); break; } }
    }
    nloc = mine > 0u ? mine : 1u; nx = cnt > 0u ? cnt : 1u;
}
__device__ __forceinline__ void xcd_barrier(const XcdBarrier& b) {
    asm volatile("s_waitcnt vmcnt(0)" ::: "memory");
    __syncthreads();
    if (threadIdx.x == 0) {
        unsigned* bar = b.bar;
        __builtin_amdgcn_s_waitcnt(0);
        unsigned nloc = b.st[0], nx = b.st[1];
        if (nloc == 0u) { xcd_barrier_complete(bar, b.x, nloc, nx); b.st[0] = nloc; b.st[1] = nx; }
        const unsigned old = xb_add(&bar[XB_XSUB(b.x)], 1u);
        const unsigned gen = old / nloc;
        if (old + 1u == (gen + 1u) * nloc) {
            __builtin_amdgcn_fence(__ATOMIC_RELEASE, "agent");
            asm volatile("s_waitcnt vmcnt(0)" ::: "memory");
            const unsigned og = xb_add(&bar[XB_TOP], 1u);
            const unsigned tg = og / nx;
            if (og + 1u == (tg + 1u) * nx) xb_add(&bar[XB_TOPGEN], 1u);
            else XB_SPIN(xb_ld(&bar[XB_TOPGEN]) == tg, bar);
            __builtin_amdgcn_fence(__ATOMIC_ACQUIRE, "agent");
            xb_add(&bar[XB_XGEN(b.x)], 1u);
            asm volatile("s_waitcnt vmcnt(0)" ::: "memory");
        } else {
            XB_SPIN(xb_ld(&bar[XB_XGEN(b.x)]) == gen, bar);
            __builtin_amdgcn_fence(__ATOMIC_ACQUIRE, "agent");
            asm volatile("s_waitcnt vmcnt(0)" ::: "memory");
        }
    }
    __syncthreads();
}

namespace pg8 {
constexpr int BM = 256, BK = 64, HALF = 128, HTB = HALF * BK * 2, STAGE_BYTES = 8 * HTB, NXCD = 8, WGM = 8;
__host__ __device__ __forceinline__ int lds_byte(int r, int c) { const int st = (r >> 4) * 2 + (c >> 5), rr = r & 15, cc = c & 31, ob = rr * 64 + cc * 2; return st * 1024 + (ob ^ (((ob >> 9) & 1) << 5)); }
__host__ __device__ __forceinline__ void stage_rc(int b, int& R, int& C) { const int st = b / 1024, sb = b % 1024, swz = sb ^ (((sb >> 9) & 1) << 5); R = (st >> 1) * 16 + swz / 64; C = (st & 1) * 32 + (swz % 64) / 2; }
__host__ __device__ __forceinline__ int perm32(int rho) { const int n = rho >> 4, i = rho & 15; return 8 * (i >> 2) + 4 * n + (i & 3); }
struct Unit { int pm, pn, pc, grp, aux; };
typedef __bf16 bf16x8_t __attribute__((ext_vector_type(8)));
typedef int v8i_t __attribute__((ext_vector_type(8)));
typedef int v4i_t __attribute__((ext_vector_type(4)));
DI v8i_t cat8(h16x8 a, h16x8 b) { const v4i_t x = __builtin_bit_cast(v4i_t, a), y = __builtin_bit_cast(v4i_t, b); return __builtin_shufflevector(x, y, 0, 1, 2, 3, 4, 5, 6, 7); }
template <bool BF16> DI f32x4 mma_op(h16x8 a, h16x8 b, f32x4 c) {
    if constexpr (BF16) return __builtin_amdgcn_mfma_f32_16x16x32_bf16(__builtin_bit_cast(bf16x8_t, a), __builtin_bit_cast(bf16x8_t, b), c, 0, 0, 0);
    else return __builtin_amdgcn_mfma_f32_16x16x32_f16(a, b, c, 0, 0, 0); }

DI bool tile_order(int i, int G, int c, int nM, int nN, int& pm, int& pn) {
    const int nwg = nM * nN; const long L = (long)i * G + c; if (L >= nwg) return false;
    int wgid = (int)L; { const int q = nwg / NXCD, r = nwg % NXCD, xcd = wgid % NXCD, off = wgid / NXCD; wgid = (xcd < r ? xcd * (q + 1) : r * (q + 1) + (xcd - r) * q) + off; }
    const int nig = WGM * nN, gid = wgid / nig, fm = gid * WGM, gsz = (nM - fm) < WGM ? (nM - fm) : WGM;
    pm = fm + ((wgid % nig) % gsz); pn = (wgid % nig) / gsz; return true;
}
struct DenseSched {
    static constexpr bool GATHER = false; const h16* A; const h16* Bt; int lda, ldb, nM, nN, G, c;
    DI bool next(int i, Unit& u) const { int pm, pn; if (!tile_order(i, G, c, nM, nN, pm, pn)) return false; u.pm = pm; u.pn = pn; u.pc = pn; u.grp = 0; return true; }
    DI const char* a_base(const Unit& u) const { return (const char*)A + (size_t)u.pm * 256 * lda * 2; }
    DI const char* b_base(const Unit& u) const { return (const char*)Bt + (size_t)u.pn * 256 * ldb * 2; }
};
struct GroupSched {
    static constexpr bool GATHER = false; const h16* A; const h16* Bt; int lda, ldb, nM, nN, ngrp, G, c; size_t strideA, strideB;
    DI bool next(int i, Unit& u) const { const long L = (long)i * G + c; const int per = nM * nN; if (L >= (long)per * ngrp) return false;
        const int g = (int)L / per, r = (int)L % per; u.grp = g; u.pm = r % nM; u.pn = r / nM; u.pc = u.pn; return true; }
    DI const char* a_base(const Unit& u) const { return (const char*)(A + (size_t)u.grp * strideA) + (size_t)u.pm * 256 * lda * 2; }
    DI const char* b_base(const Unit& u) const { return (const char*)(Bt + (size_t)u.grp * strideB) + (size_t)u.pn * 256 * ldb * 2; }
};
struct MoeSched {
    static constexpr bool GATHER = false; const void* A; const void* Bt; int lda, ldb, nN, G, c; int tp1, tp2, tp3, tp4, tp5, tp6, tp7, tp8; int esz;
    DI bool next(int i, Unit& u) const { int pm, pn; if (!tile_order(i, G, c, tp8, nN, pm, pn)) return false;
        const int e = (pm >= tp1) + (pm >= tp2) + (pm >= tp3) + (pm >= tp4) + (pm >= tp5) + (pm >= tp6) + (pm >= tp7);
        u.pm = pm; u.pc = pn; u.grp = e; u.pn = e * nN + pn; return true; }
    DI const char* a_base(const Unit& u) const { return (const char*)A + (size_t)u.pm * 256 * lda * esz; }
    DI const char* b_base(const Unit& u) const { return (const char*)Bt + (size_t)u.pn * 256 * ldb * esz; }
};

struct MoeGatherSched {
    static constexpr bool GATHER = true; const void* A; const void* Bt; int lda, ldb, nN, G, c; int tp1, tp2, tp3, tp4, tp5, tp6, tp7, tp8; int esz;
    DI bool next(int i, Unit& u) const { int pm, pn; if (!tile_order(i, G, c, tp8, nN, pm, pn)) return false;
        const int e = (pm >= tp1) + (pm >= tp2) + (pm >= tp3) + (pm >= tp4) + (pm >= tp5) + (pm >= tp6) + (pm >= tp7);
        u.pm = pm; u.pc = pn; u.grp = e; u.pn = e * nN + pn; return true; }
    DI const char* a_base(const Unit&) const { return (const char*)A; }
    DI const char* b_base(const Unit& u) const { return (const char*)Bt + (size_t)u.pn * 256 * ldb * esz; }
};
struct TailSched {
    static constexpr bool GATHER = false; const void* A; const void* Bt; int lda, ldb, nN, G, c, pm0, R, s, Ks; int tp1, tp2, tp3, tp4, tp5, tp6, tp7; int esz;
    DI bool next(int i, Unit& u) const { const long L = (long)i * G + c; if (L >= (long)R * s) return false; const int tile = (int)L / s, ks = (int)L % s, pm = pm0 + tile / nN, pn = tile % nN;
        const int e = (pm >= tp1) + (pm >= tp2) + (pm >= tp3) + (pm >= tp4) + (pm >= tp5) + (pm >= tp6) + (pm >= tp7);
        u.pm = pm; u.pc = pn; u.grp = e; u.pn = e * nN + pn; u.aux = ks * R + tile; return true; }
    DI const char* a_base(const Unit& u) const { return (const char*)A + (size_t)u.pm * 256 * lda * esz + (size_t)(u.aux / R) * Ks * esz; }
    DI const char* b_base(const Unit& u) const { return (const char*)Bt + (size_t)u.pn * 256 * ldb * esz + (size_t)(u.aux / R) * Ks * esz; }
};
DI int tail_split8(int R) { const int q = R > 0 ? 256 / R : 0; return q >= 14 ? 14 : q >= 7 ? 7 : q >= 4 ? 4 : q >= 2 ? 2 : 1; }
DI int tail_split(int R) { const int q = R > 0 ? 256 / R : 0; return q >= 28 ? 28 : q >= 14 ? 14 : q >= 8 ? 8 : q >= 7 ? 7 : q >= 4 ? 4 : q >= 2 ? 2 : 1; }

template <class Epi, class Sched, bool BF16 = false>
__device__ __forceinline__ void gemm_phase(LAS unsigned char* lds, const int K, const Sched& S, const Epi& E) {
    const int tid = threadIdx.x, wid = __builtin_amdgcn_readfirstlane(tid >> 6), lane = tid & 63, wr = wid >> 2, wc = wid & 3, fr = lane & 15, fq = lane >> 4;
    const int nt = K / BK; const int lda = S.lda, ldb = S.ldb;
    unsigned voffA[2], voffB[2]; int gR[2], gC[2];
#pragma unroll
    for (int i = 0; i < 2; ++i) { int R, C; stage_rc(tid * 16 + i * 8192, R, C); const int Rb = Epi::PERM ? ((R & ~31) + perm32(R & 31)) : R; gR[i] = R; gC[i] = C;
        voffA[i] = (unsigned)(R * lda + C) * 2u; voffB[i] = (unsigned)(Rb * ldb + C) * 2u; }
    const size_t kstep = (size_t)(BK * 2);
    const size_t hstepA = Sched::GATHER ? (size_t)0 : (size_t)HALF * lda * 2, hstepB = (size_t)HALF * ldb * 2;
    unsigned voC[2][2], voN[2][2];
#define PG8_GOFF(dst, unit_) do { if constexpr (Sched::GATHER) { const LAS unsigned short* tt_ = (const LAS unsigned short*)(lds + TOKTAB_OFF) + (unit_) * 256; _Pragma("unroll") for (int h_ = 0; h_ < 2; ++h_) _Pragma("unroll") for (int i_ = 0; i_ < 2; ++i_) \
        dst[h_][i_] = ((unsigned)tt_[128 * h_ + gR[i_]] * (unsigned)lda + (unsigned)gC[i_]) * 2u; } } while (0)
#define PG8_STAGE_A(b, h, gbase, vset) do { if constexpr (Sched::GATHER) { PG8_STAGE(PG8_SA(b, h), gbase, vset[h]); } else { PG8_STAGE(PG8_SA(b, h), (gbase) + (h) * hstepA, voffA); } } while (0)
    const unsigned ldsw = (unsigned)wid * 1024u;
    const int aoff = lds_byte(wr * 64 + fr, fq * 8), boff = lds_byte(wc * 32 + fr, fq * 8);
#define PG8_SA(b, h) (((b) * 2 + (h)) * HTB)
#define PG8_SB(b, h) ((4 + (b) * 2 + (h)) * HTB)
#define PG8_STAGE(bufoff, gbase, voff) do { _Pragma("unroll") for (int _i = 0; _i < 2; ++_i) \
        __builtin_amdgcn_global_load_lds((const unsigned*)((const char*)(gbase) + (voff)[_i]), (LAS unsigned*)(lds + (bufoff) + ldsw + _i * 8192), 16, 0, 0); } while (0)
#define PG8_LDA(dst, b, h) do { _Pragma("unroll") for (int m = 0; m < 4; ++m) _Pragma("unroll") for (int k = 0; k < 2; ++k) dst[m][k] = *(const LAS h16x8*)(lds + PG8_SA(b, h) + aoff + m * 2048 + k * 1024); } while (0)
#define PG8_LDB(dst, b, h) do { _Pragma("unroll") for (int n = 0; n < 2; ++n) _Pragma("unroll") for (int k = 0; k < 2; ++k) dst[n][k] = *(const LAS h16x8*)(lds + PG8_SB(b, h) + boff + n * 2048 + k * 1024); } while (0)
#define PG8_MMA(ai, bj, At, Bt) do { __builtin_amdgcn_s_setprio(1); _Pragma("unroll") for (int m = 0; m < 4; ++m) _Pragma("unroll") for (int n = 0; n < 2; ++n) _Pragma("unroll") for (int k = 0; k < 2; ++k) \
        acc[ai][bj][m][n] = mma_op<BF16>(Bt[n][k], At[m][k], acc[ai][bj][m][n]); __builtin_amdgcn_s_setprio(0); } while (0)
#define PG8_WAIT_V(n) asm volatile("s_waitcnt vmcnt(" #n ")" ::: "memory")
#define PG8_WAIT_L(n) asm volatile("s_waitcnt lgkmcnt(" #n ")" ::: "memory")
#define PG8_BAR __builtin_amdgcn_s_barrier()
#define PG8_SCHED __builtin_amdgcn_sched_barrier(0)
    Unit cur, nxt; int ui = 0;
    if (!S.next(0, cur)) return;
    f32x4 acc[2][2][4][2];
#pragma unroll
    for (int a = 0; a < 2; ++a)
#pragma unroll
        for (int b = 0; b < 2; ++b)
#pragma unroll
            for (int m = 0; m < 4; ++m)
#pragma unroll
                for (int n = 0; n < 2; ++n) acc[a][b][m][n] = (f32x4){0.f, 0.f, 0.f, 0.f};
    h16x8 At[4][2], B0[2][2], B1[2][2];
    const char* cA = S.a_base(cur); const char* cB = S.b_base(cur);
    PG8_GOFF(voC, 0);
    PG8_STAGE(PG8_SB(0, 0), cB, voffB); PG8_STAGE(PG8_SB(0, 1), cB + hstepB, voffB); PG8_STAGE_A(0, 0, cA, voC); PG8_STAGE_A(0, 1, cA, voC);
    if (wr == 1) PG8_BAR;
    PG8_WAIT_V(2); PG8_BAR;
    PG8_STAGE(PG8_SB(1, 0), cB + kstep, voffB); PG8_STAGE_A(1, 0, cA + kstep, voC); PG8_STAGE(PG8_SB(1, 1), cB + hstepB + kstep, voffB);
    PG8_WAIT_V(6); PG8_BAR;
    for (;;) {
        const bool has_next = S.next(ui + 1, nxt);
        const char* nA = has_next ? S.a_base(nxt) : cA; const char* nB = has_next ? S.b_base(nxt) : cB;
        PG8_GOFF(voN, has_next ? ui + 1 : ui);
        for (int t = 0; t < nt; t += 2) {
            const bool last = (t == nt - 2);
            unsigned vo2[2][2];
            if constexpr (Sched::GATHER) {
#pragma unroll
                for (int h_ = 0; h_ < 2; ++h_)
#pragma unroll
                    for (int i_ = 0; i_ < 2; ++i_) vo2[h_][i_] = last ? voN[h_][i_] : voC[h_][i_]; }
            const char* a1 = cA + (size_t)(t + 1) * kstep;
            const char* a2 = last ? nA : cA + (size_t)(t + 2) * kstep; const char* b2 = last ? nB : cB + (size_t)(t + 2) * kstep;
            const char* a3 = a2 + kstep; const char* b3 = b2 + kstep;
            PG8_LDB(B0, 0, 0); PG8_LDB(B1, 0, 1); PG8_SCHED; PG8_LDA(At, 0, 0); PG8_STAGE_A(1, 1, a1, voC);
            PG8_WAIT_V(8); PG8_WAIT_L(0); PG8_BAR; PG8_MMA(0, 0, At, B0); PG8_MMA(0, 1, At, B1); PG8_BAR; PG8_SCHED;
            PG8_LDA(At, 0, 1); PG8_STAGE(PG8_SB(0, 0), b2, voffB); PG8_STAGE(PG8_SB(0, 1), b2 + hstepB, voffB); PG8_STAGE_A(0, 0, a2, vo2);
            PG8_WAIT_V(8); PG8_WAIT_L(0); PG8_BAR; PG8_MMA(1, 0, At, B0); PG8_MMA(1, 1, At, B1); PG8_BAR; PG8_SCHED;
            PG8_LDB(B0, 1, 0); PG8_LDB(B1, 1, 1); PG8_SCHED; PG8_LDA(At, 1, 0); PG8_STAGE_A(0, 1, a2, vo2);
            PG8_WAIT_V(8); PG8_WAIT_L(0); PG8_BAR; PG8_MMA(0, 0, At, B0); PG8_MMA(0, 1, At, B1); PG8_BAR; PG8_SCHED;
            PG8_LDA(At, 1, 1); PG8_STAGE(PG8_SB(1, 0), b3, voffB); PG8_STAGE(PG8_SB(1, 1), b3 + hstepB, voffB); PG8_STAGE_A(1, 0, a3, vo2);
            PG8_WAIT_V(8); PG8_WAIT_L(0); PG8_BAR; PG8_MMA(1, 0, At, B0); PG8_MMA(1, 1, At, B1); PG8_BAR; PG8_SCHED;
        }
        if (wr == 0) PG8_BAR;
        E(acc, cur, wr, wc, fr, fq);
        if (!has_next) break;
#pragma unroll
        for (int a = 0; a < 2; ++a)
#pragma unroll
            for (int b = 0; b < 2; ++b)
#pragma unroll
                for (int m = 0; m < 4; ++m)
#pragma unroll
                    for (int n = 0; n < 2; ++n) acc[a][b][m][n] = (f32x4){0.f, 0.f, 0.f, 0.f};
        cur = nxt; cA = nA; cB = nB; ++ui;
        if constexpr (Sched::GATHER) {
#pragma unroll
            for (int h_ = 0; h_ < 2; ++h_)
#pragma unroll
                for (int i_ = 0; i_ < 2; ++i_) voC[h_][i_] = voN[h_][i_]; }
        if (wr == 1) PG8_BAR;
    }
    PG8_WAIT_V(0);
    PG8_BAR;
#undef PG8_SA
#undef PG8_GOFF
#undef PG8_STAGE_A
#undef PG8_SB
#undef PG8_STAGE
#undef PG8_LDA
#undef PG8_LDB
#undef PG8_MMA
#undef PG8_WAIT_V
#undef PG8_WAIT_L
#undef PG8_BAR
#undef PG8_SCHED
}
template <class Epi, class Sched>
__device__ __forceinline__ void gemm_phase8(LAS unsigned char* lds, const int K, const Sched& S, const Epi& E) {
    const int tid = threadIdx.x, wid = __builtin_amdgcn_readfirstlane(tid >> 6), lane = tid & 63, wr = wid >> 2, wc = wid & 3, fr = lane & 15, fq = lane >> 4;
    const int nt = K / (2 * BK); const int lda = S.lda, ldb = S.ldb;
    unsigned voffA[2], voffB[2]; int gR[2], gC[2];
#pragma unroll
    for (int i = 0; i < 2; ++i) { int R, C; stage_rc(tid * 16 + i * 8192, R, C); const int Rb = Epi::PERM ? ((R & ~31) + perm32(R & 31)) : R; gR[i] = R; gC[i] = C;
        voffA[i] = (unsigned)(R * lda + C * 2); voffB[i] = (unsigned)(Rb * ldb + C * 2); }
    const size_t kstep = (size_t)(BK * 2);
    const size_t hstepA = Sched::GATHER ? (size_t)0 : (size_t)HALF * lda, hstepB = (size_t)HALF * ldb;
    unsigned voC[2][2], voN[2][2];
#define PG8_GOFF(dst, unit_) do { if constexpr (Sched::GATHER) { const LAS unsigned short* tt_ = (const LAS unsigned short*)(lds + TOKTAB_OFF) + (unit_) * 256; _Pragma("unroll") for (int h_ = 0; h_ < 2; ++h_) _Pragma("unroll") for (int i_ = 0; i_ < 2; ++i_) \
        dst[h_][i_] = (unsigned)tt_[128 * h_ + gR[i_]] * (unsigned)lda + (unsigned)gC[i_] * 2u; } } while (0)
#define PG8_STAGE_A(b, h, gbase, vset) do { if constexpr (Sched::GATHER) { PG8_STAGE(PG8_SA(b, h), gbase, vset[h]); } else { PG8_STAGE(PG8_SA(b, h), (gbase) + (h) * hstepA, voffA); } } while (0)
    const unsigned ldsw = (unsigned)wid * 1024u;
    const int aoff = lds_byte(wr * 64 + fr, fq * 8), boff = lds_byte(wc * 32 + fr, fq * 8);
    int sc127 = 127; asm volatile("" : "+v"(sc127));
#define PG8_SA(b, h) (((b) * 2 + (h)) * HTB)
#define PG8_SB(b, h) ((4 + (b) * 2 + (h)) * HTB)
#define PG8_STAGE(bufoff, gbase, voff) do { _Pragma("unroll") for (int _i = 0; _i < 2; ++_i) \
        __builtin_amdgcn_global_load_lds((const unsigned*)((const char*)(gbase) + (voff)[_i]), (LAS unsigned*)(lds + (bufoff) + ldsw + _i * 8192), 16, 0, 0); } while (0)
#define PG8_LDA(dst, b, h) do { _Pragma("unroll") for (int m = 0; m < 4; ++m) _Pragma("unroll") for (int k = 0; k < 2; ++k) dst[m][k] = *(const LAS h16x8*)(lds + PG8_SA(b, h) + aoff + m * 2048 + k * 1024); } while (0)
#define PG8_LDB(dst, b, h) do { _Pragma("unroll") for (int n = 0; n < 2; ++n) _Pragma("unroll") for (int k = 0; k < 2; ++k) dst[n][k] = *(const LAS h16x8*)(lds + PG8_SB(b, h) + boff + n * 2048 + k * 1024); } while (0)
#define PG8_MMA(ai, bj, At, Bt) do { __builtin_amdgcn_s_setprio(1); _Pragma("unroll") for (int m = 0; m < 4; ++m) _Pragma("unroll") for (int n = 0; n < 2; ++n) \
        asm volatile("v_mfma_scale_f32_16x16x128_f8f6f4 %0, %1, %2, %0, %3, %3 op_sel_hi:[0,0,0]" : "+v"(acc[ai][bj][m][n]) : "v"(cat8(Bt[n][0], Bt[n][1])), "v"(cat8(At[m][0], At[m][1])), "v"(sc127)); \
        __builtin_amdgcn_s_setprio(0); } while (0)
#define PG8_WAIT_V(n) asm volatile("s_waitcnt vmcnt(" #n ")" ::: "memory")
#define PG8_WAIT_L(n) asm volatile("s_waitcnt lgkmcnt(" #n ")" ::: "memory")
#define PG8_BAR __builtin_amdgcn_s_barrier()
#define PG8_SCHED __builtin_amdgcn_sched_barrier(0)
    Unit cur, nxt; int ui = 0;
    if (!S.next(0, cur)) return;
    f32x4 acc[2][2][4][2];
#pragma unroll
    for (int a = 0; a < 2; ++a)
#pragma unroll
        for (int b = 0; b < 2; ++b)
#pragma unroll
            for (int m = 0; m < 4; ++m)
#pragma unroll
                for (int n = 0; n < 2; ++n) acc[a][b][m][n] = (f32x4){0.f, 0.f, 0.f, 0.f};
    h16x8 At[4][2], B0[2][2], B1[2][2];
    const char* cA = S.a_base(cur); const char* cB = S.b_base(cur);
    PG8_GOFF(voC, 0);
    PG8_STAGE(PG8_SB(0, 0), cB, voffB); PG8_STAGE(PG8_SB(0, 1), cB + hstepB, voffB); PG8_STAGE_A(0, 0, cA, voC); PG8_STAGE_A(0, 1, cA, voC);
    if (wr == 1) PG8_BAR;
    PG8_WAIT_V(2); PG8_BAR;
    PG8_STAGE(PG8_SB(1, 0), cB + kstep, voffB); PG8_STAGE_A(1, 0, cA + kstep, voC); PG8_STAGE(PG8_SB(1, 1), cB + hstepB + kstep, voffB);
    PG8_WAIT_V(6); PG8_BAR;
    for (;;) {
        const bool has_next = S.next(ui + 1, nxt);
        const char* nA = has_next ? S.a_base(nxt) : cA; const char* nB = has_next ? S.b_base(nxt) : cB;
        PG8_GOFF(voN, has_next ? ui + 1 : ui);
        for (int t = 0; t < nt; t += 2) {
            const bool last = (t == nt - 2);
            unsigned vo2[2][2];
            if constexpr (Sched::GATHER) {
#pragma unroll
                for (int h_ = 0; h_ < 2; ++h_)
#pragma unroll
                    for (int i_ = 0; i_ < 2; ++i_) vo2[h_][i_] = last ? voN[h_][i_] : voC[h_][i_]; }
            const char* a1 = cA + (size_t)(t + 1) * kstep;
            const char* a2 = last ? nA : cA + (size_t)(t + 2) * kstep; const char* b2 = last ? nB : cB + (size_t)(t + 2) * kstep;
            const char* a3 = a2 + kstep; const char* b3 = b2 + kstep;
            PG8_LDB(B0, 0, 0); PG8_LDB(B1, 0, 1); PG8_SCHED; PG8_LDA(At, 0, 0); PG8_STAGE_A(1, 1, a1, voC);
            PG8_WAIT_V(8); PG8_WAIT_L(0); PG8_BAR; PG8_MMA(0, 0, At, B0); PG8_MMA(0, 1, At, B1); PG8_BAR; PG8_SCHED;
            PG8_LDA(At, 0, 1); PG8_STAGE(PG8_SB(0, 0), b2, voffB); PG8_STAGE(PG8_SB(0, 1), b2 + hstepB, voffB); PG8_STAGE_A(0, 0, a2, vo2);
            PG8_WAIT_V(8); PG8_WAIT_L(0); PG8_BAR; PG8_MMA(1, 0, At, B0); PG8_MMA(1, 1, At, B1); PG8_BAR; PG8_SCHED;
            PG8_LDB(B0, 1, 0); PG8_LDB(B1, 1, 1); PG8_SCHED; PG8_LDA(At, 1, 0); PG8_STAGE_A(0, 1, a2, vo2);
            PG8_WAIT_V(8); PG8_WAIT_L(0); PG8_BAR; PG8_MMA(0, 0, At, B0); PG8_MMA(0, 1, At, B1); PG8_BAR; PG8_SCHED;
            PG8_LDA(At, 1, 1); PG8_STAGE(PG8_SB(1, 0), b3, voffB); PG8_STAGE(PG8_SB(1, 1), b3 + hstepB, voffB); PG8_STAGE_A(1, 0, a3, vo2);
            PG8_WAIT_V(8); PG8_WAIT_L(0); PG8_BAR; PG8_MMA(1, 0, At, B0); PG8_MMA(1, 1, At, B1); PG8_BAR; PG8_SCHED;
        }
        if (wr == 0) PG8_BAR;
        asm volatile("s_nop 15\n\ts_nop 15\n\ts_nop 15" ::: "memory");
#pragma unroll
        for (int ai_ = 0; ai_ < 2; ++ai_)
#pragma unroll
            for (int bj_ = 0; bj_ < 2; ++bj_) asm volatile("" : "+v"(acc[ai_][bj_][0][0]), "+v"(acc[ai_][bj_][0][1]), "+v"(acc[ai_][bj_][1][0]), "+v"(acc[ai_][bj_][1][1]), "+v"(acc[ai_][bj_][2][0]), "+v"(acc[ai_][bj_][2][1]), "+v"(acc[ai_][bj_][3][0]), "+v"(acc[ai_][bj_][3][1]));
        E(acc, cur, wr, wc, fr, fq);
        if (!has_next) break;
#pragma unroll
        for (int a = 0; a < 2; ++a)
#pragma unroll
            for (int b = 0; b < 2; ++b)
#pragma unroll
                for (int m = 0; m < 4; ++m)
#pragma unroll
                    for (int n = 0; n < 2; ++n) acc[a][b][m][n] = (f32x4){0.f, 0.f, 0.f, 0.f};
        cur = nxt; cA = nA; cB = nB; ++ui;
        if constexpr (Sched::GATHER) {
#pragma unroll
            for (int h_ = 0; h_ < 2; ++h_)
#pragma unroll
                for (int i_ = 0; i_ < 2; ++i_) voC[h_][i_] = voN[h_][i_]; }
        if (wr == 1) PG8_BAR;
    }
    PG8_WAIT_V(0);
    PG8_BAR;
#undef PG8_GOFF
#undef PG8_STAGE_A
#undef PG8_SA
#undef PG8_SB
#undef PG8_STAGE
#undef PG8_LDA
#undef PG8_LDB
#undef PG8_MMA
#undef PG8_WAIT_V
#undef PG8_WAIT_L
#undef PG8_BAR
#undef PG8_SCHED
}

#define EPI_ARGS const f32x4 (&acc)[2][2][4][2], const Unit& u, int wr, int wc, int fr, int fq
struct EpiH {
    static constexpr bool PERM = true;
    h16* O; int ldc;
    DI void operator()(EPI_ARGS) const {
        const int row0 = u.pm * 256 + wr * 64 + fr, col0 = u.pc * 256 + wc * 32 + 8 * fq;
#pragma unroll
        for (int ai = 0; ai < 2; ++ai)
#pragma unroll
            for (int m = 0; m < 4; ++m) { h16* rowp = O + (size_t)(row0 + ai * 128 + m * 16) * ldc + col0;
#pragma unroll
                for (int bj = 0; bj < 2; ++bj) { const f32x4 v0 = acc[ai][bj][m][0], v1 = acc[ai][bj][m][1];
                    u32x4 w; w.x = pkh(v0[0], v0[1]); w.y = pkh(v0[2], v0[3]); w.z = pkh(v1[0], v1[1]); w.w = pkh(v1[2], v1[3]);
                    *(u32x4*)(rowp + bj * 128) = w; } }
    }
};
struct EpiRes {
    static constexpr bool PERM = true;
    const h16* R; h16* O; int ldc;
    DI void operator()(EPI_ARGS) const {
        const int row0 = u.pm * 256 + wr * 64 + fr, col0 = u.pc * 256 + wc * 32 + 8 * fq;
#pragma unroll
        for (int ai = 0; ai < 2; ++ai)
#pragma unroll
            for (int m = 0; m < 4; ++m) { const size_t off = (size_t)(row0 + ai * 128 + m * 16) * ldc + col0;
#pragma unroll
                for (int bj = 0; bj < 2; ++bj) { const h16x8 r = *(const h16x8*)(R + off + bj * 128); const f32x4 v0 = acc[ai][bj][m][0], v1 = acc[ai][bj][m][1];
                    u32x4 w; w.x = pkh(ALPHA * (float)r[0] + v0[0], ALPHA * (float)r[1] + v0[1]); w.y = pkh(ALPHA * (float)r[2] + v0[2], ALPHA * (float)r[3] + v0[3]);
                    w.z = pkh(ALPHA * (float)r[4] + v1[0], ALPHA * (float)r[5] + v1[1]); w.w = pkh(ALPHA * (float)r[6] + v1[2], ALPHA * (float)r[7] + v1[3]);
                    *(u32x4*)(O + off + bj * 128) = w; }
                asm volatile("" ::: "memory"); }
    }
};
struct EpiSwiGLU {
    static constexpr bool PERM = true;
    h16* O; int ldc; int drop;
    DI void operator()(EPI_ARGS) const {
        const int row0 = u.pm * 256 + wr * 64 + fr, col0 = u.pc * 128 + wc * 32 + 8 * fq;
#pragma unroll
        for (int ai = 0; ai < 2; ++ai)
#pragma unroll
            for (int m = 0; m < 4; ++m) { h16* rowp = O + (size_t)(row0 + ai * 128 + m * 16) * ldc + col0;
                float r[8];
#pragma unroll
                for (int n = 0; n < 2; ++n)
#pragma unroll
                    for (int j = 0; j < 4; ++j) { const float g = acc[ai][0][m][n][j], up = acc[ai][1][m][n][j]; r[n * 4 + j] = siluf_(g) * up; }
                u32x4 w; w.x = rnd_drop(pkh(r[0], r[1]), drop); w.y = rnd_drop(pkh(r[2], r[3]), drop); w.z = rnd_drop(pkh(r[4], r[5]), drop); w.w = rnd_drop(pkh(r[6], r[7]), drop);
                *(u32x4*)rowp = w; }
    }
};
struct EpiIn1 {
    static constexpr bool PERM = true;
    h16* Ucat; h16* QKVG; float* LOGIT;
    DI void operator()(EPI_ARGS) const {
        const int row0 = u.pm * 256 + wr * 64 + fr;
#pragma unroll
        for (int ai = 0; ai < 2; ++ai)
#pragma unroll
            for (int m = 0; m < 4; ++m) { const int row = row0 + ai * 128 + m * 16;
#pragma unroll
                for (int bj = 0; bj < 2; ++bj) { const int col = u.pc * 256 + bj * 128 + wc * 32 + 8 * fq; const f32x4 v0 = acc[ai][bj][m][0], v1 = acc[ai][bj][m][1];
                    u32x4 w; w.x = pkh(v0[0], v0[1]); w.y = pkh(v0[2], v0[3]); w.z = pkh(v1[0], v1[1]); w.w = pkh(v1[2], v1[3]);
                    if (u.pc < 4) { const int g = col >> 4, hh = col & 15, b = row >> 13, t = row & 8191, ch = t >> 5, sg = t & 31;
                        *(u32x4*)(Ucat + ((size_t)(g * S5N + b * S5NCH + ch) * S5K + sg * 16 + hh)) = w; }
                    else { *(u32x4*)(QKVG + (size_t)row * 4096 + (col - 1024)) = w; } } }
    }
};
struct EpiS5Y {
    static constexpr bool PERM = true;
    const h16* Ucat; const float* Dskip; h16* Z;
    DI void operator()(EPI_ARGS) const {
        const int g = u.grp;
#pragma unroll
        for (int bj = 0; bj < 2; ++bj) { const int col = u.pc * 256 + bj * 128 + wc * 32 + 8 * fq, tau = col >> 4, hh = col & 15;
            const f32x4 d0 = *(const f32x4*)(Dskip + g * 16 + hh), d1 = *(const f32x4*)(Dskip + g * 16 + hh + 4);
#pragma unroll
            for (int ai = 0; ai < 2; ++ai)
#pragma unroll
                for (int m = 0; m < 4; ++m) { const int n = u.pm * 256 + ai * 128 + wr * 64 + m * 16 + fr, b = n >> 8, ch = n & 255;
                    const h16x8 uv = *(const h16x8*)(Ucat + ((size_t)(g * S5N + n) * S5K + col));
                    const f32x4 v0 = acc[ai][bj][m][0], v1 = acc[ai][bj][m][1]; float r[8];
#pragma unroll
                    for (int j = 0; j < 8; ++j) { const float a = (j < 4 ? v0[j & 3] : v1[j & 3]), dd = (j < 4 ? d0[j & 3] : d1[j & 3]); const float y = a + dd * (float)uv[j];
                        r[j] = y * fast_rcp(1.0f + __expf(-1.5957691216057308f * (y + 0.044715f * y * y * y))); }
                    u32x4 w; w.x = pkh(r[0], r[1]); w.y = pkh(r[2], r[3]); w.z = pkh(r[4], r[5]); w.w = pkh(r[6], r[7]);
                    *(u32x4*)(Z + (size_t)(b * SEQ + ch * S5L + tau) * 1024 + g * 16 + hh) = w; } }
    }
};
struct EpiGLU {
    static constexpr bool PERM = true;
    const h16* Z; const float* bias; h16* O;
    DI void operator()(EPI_ARGS) const {
        const int row0 = u.pm * 256 + wr * 64 + fr;
#pragma unroll
        for (int bj = 0; bj < 2; ++bj) { const int col = u.pc * 256 + bj * 128 + wc * 32 + 8 * fq;
            const f32x4 b0 = *(const f32x4*)(bias + col), b1 = *(const f32x4*)(bias + col + 4);
#pragma unroll
            for (int ai = 0; ai < 2; ++ai)
#pragma unroll
                for (int m = 0; m < 4; ++m) { const int row = row0 + ai * 128 + m * 16;
                    const h16x8 zv = *(const h16x8*)(Z + (size_t)row * 1024 + col);
                    const f32x4 v0 = acc[ai][bj][m][0], v1 = acc[ai][bj][m][1]; float r[8];
#pragma unroll
                    for (int j = 0; j < 8; ++j) { const float a = (j < 4 ? v0[j & 3] + b0[j & 3] : v1[j & 3] + b1[j & 3]); r[j] = (float)zv[j] * sigmoidf_(a); }
                    u32x4 w; w.x = pkh(r[0], r[1]); w.y = pkh(r[2], r[3]); w.z = pkh(r[4], r[5]); w.w = pkh(r[6], r[7]);
                    *(u32x4*)(O + (size_t)row * 2048 + col) = w; } }
    }
};
struct EpiEC {
    static constexpr bool PERM = false;
    float* EC;
    DI void operator()(EPI_ARGS) const {
        const int g = u.grp, col0 = wc * 32 + 4 * fq;
#pragma unroll
        for (int ai = 0; ai < 2; ++ai)
#pragma unroll
            for (int m = 0; m < 4; ++m) { const int n = u.pm * 256 + ai * 128 + wr * 64 + m * 16 + fr; float* rowp = EC + ((size_t)(g * S5N + n)) * 128 + col0;
#pragma unroll
                for (int nn = 0; nn < 2; ++nn) *(f32x4*)(rowp + nn * 16) = acc[ai][0][m][nn]; }
    }
};
DI unsigned pk_fp8x4(float a, float b, float c, float d) {
    a = fminf(fmaxf(a, -448.f), 448.f); b = fminf(fmaxf(b, -448.f), 448.f); c = fminf(fmaxf(c, -448.f), 448.f); d = fminf(fmaxf(d, -448.f), 448.f);
    unsigned w = 0u; w = __builtin_amdgcn_cvt_pk_fp8_f32(a, b, w, false); w = __builtin_amdgcn_cvt_pk_fp8_f32(c, d, w, true); return w; }
constexpr float H8_SCALE = 8.0f, W8_SCALE = 256.0f, X8_SCALE = 16.0f;
struct EpiSwiGLU8 {
    static constexpr bool PERM = true;
    unsigned char* O; int ldc; float isc;
    DI void operator()(EPI_ARGS) const {
        const int row0 = u.pm * 256 + wr * 64 + fr, col0 = u.pc * 128 + wc * 32 + 8 * fq;
#pragma unroll
        for (int ai = 0; ai < 2; ++ai)
#pragma unroll
            for (int m = 0; m < 4; ++m) { unsigned char* rowp = O + (size_t)(row0 + ai * 128 + m * 16) * ldc + col0;
                float r[8];
#pragma unroll
                for (int n = 0; n < 2; ++n)
#pragma unroll
                    for (int j = 0; j < 4; ++j) { const float g = acc[ai][0][m][n][j] * isc, up = acc[ai][1][m][n][j] * isc; r[n * 4 + j] = H8_SCALE * siluf_(g) * up; }
                u32x2 w; w.x = pk_fp8x4(r[0], r[1], r[2], r[3]); w.y = pk_fp8x4(r[4], r[5], r[6], r[7]);
                *(u32x2*)rowp = w; }
    }
};
struct EpiHs {
    static constexpr bool PERM = true;
    h16* O; int ldc; float scale;
    DI void operator()(EPI_ARGS) const {
        const int row0 = u.pm * 256 + wr * 64 + fr, col0 = u.pc * 256 + wc * 32 + 8 * fq;
#pragma unroll
        for (int ai = 0; ai < 2; ++ai)
#pragma unroll
            for (int m = 0; m < 4; ++m) { h16* rowp = O + (size_t)(row0 + ai * 128 + m * 16) * ldc + col0;
#pragma unroll
                for (int bj = 0; bj < 2; ++bj) { const f32x4 v0 = acc[ai][bj][m][0] * scale, v1 = acc[ai][bj][m][1] * scale;
                    u32x4 w; w.x = pkh(v0[0], v0[1]); w.y = pkh(v0[2], v0[3]); w.z = pkh(v1[0], v1[1]); w.w = pkh(v1[2], v1[3]);
                    *(u32x4*)(rowp + bj * 128) = w; } }
    }
};
struct EpiSlab {
    static constexpr bool PERM = false;
    float* SL; float scale;
    DI void operator()(EPI_ARGS) const {
        float* base = SL + (size_t)u.aux * 65536 + (size_t)(wr * 64 + fr) * 256 + wc * 32 + 4 * fq;
#pragma unroll
        for (int ai = 0; ai < 2; ++ai)
#pragma unroll
            for (int m = 0; m < 4; ++m)
#pragma unroll
                for (int bj = 0; bj < 2; ++bj)
#pragma unroll
                    for (int n = 0; n < 2; ++n) *(f32x4*)(base + (size_t)(ai * 128 + m * 16) * 256 + bj * 128 + n * 16) = acc[ai][bj][m][n] * scale;
    }
};
}

struct Args { const float* in[34]; float* out; unsigned char* ws; int ph_lo, ph_hi; };
enum { I_X = 0, I_EWIN, I_EWOUT, I_ELNMG, I_ELNMB, I_EW1, I_EW3, I_EW2, I_ELNFG, I_ELNFB, I_OWIN, I_LAMRE, I_LAMIM, I_LOGDT, I_BRE, I_BIM, I_CRE, I_CIM, I_SSMD,
       I_GLUW, I_GLUB, I_CONVW, I_ALOG, I_DTB, I_NORMW, I_OWOUT, I_OLNMG, I_OLNMB, I_ROUTER, I_MW1, I_MW3, I_MW2, I_OLNFG, I_OLNFB };

DI void tr_item(const float* W, int N, int k0, int n0, h16* WT, size_t drow0, int ldd, float* scr, int lane, int drop) {
    const int c4 = (lane & 15) * 4, r4 = lane >> 4;
    f32x4 v[16];
#pragma unroll
    for (int i = 0; i < 16; ++i) { const int kk = 4 * i + r4, col = n0 + c4; v[i] = (col < N) ? *(const f32x4*)(W + (size_t)(k0 + kk) * N + col) : (f32x4){0.f, 0.f, 0.f, 0.f}; }
#pragma unroll
    for (int i = 0; i < 16; ++i) { float* s = scr + (4 * i + r4) * 65 + c4; s[0] = v[i][0]; s[1] = v[i][1]; s[2] = v[i][2]; s[3] = v[i][3]; }
    asm volatile("s_waitcnt lgkmcnt(0)" ::: "memory");
    const int c = lane & 7, nb = lane >> 3;
#pragma unroll
    for (int j = 0; j < 8; ++j) { const int n = nb + 8 * j; const float* s = scr + (8 * c) * 65 + n;
        u32x4 o; o.x = rnd_drop(pkh(s[0], s[65]), drop); o.y = rnd_drop(pkh(s[130], s[195]), drop); o.z = rnd_drop(pkh(s[260], s[325]), drop); o.w = rnd_drop(pkh(s[390], s[455]), drop);
        *(u32x4*)(WT + (drow0 + n) * (size_t)ldd + k0 + 8 * c) = o; }
    asm volatile("s_waitcnt lgkmcnt(0)" ::: "memory");
}
DI void tr_item8(const float* W, int N, int k0, int n0, unsigned char* WT, size_t drow0, int ldd, float* scr, int lane) {
    const int c4 = (lane & 7) * 4, r8 = lane >> 3;
    f32x4 v[16];
#pragma unroll
    for (int i = 0; i < 16; ++i) v[i] = *(const f32x4*)(W + (size_t)(k0 + 8 * i + r8) * N + n0 + c4);
#pragma unroll
    for (int i = 0; i < 16; ++i) { float* s = scr + (8 * i + r8) * 33 + c4; s[0] = v[i][0]; s[1] = v[i][1]; s[2] = v[i][2]; s[3] = v[i][3]; }
    asm volatile("s_waitcnt lgkmcnt(0)" ::: "memory");
    const int c = lane & 7, nb = lane >> 3;
#pragma unroll
    for (int j = 0; j < 4; ++j) { const int n = nb + 8 * j; const float* s = scr + (16 * c) * 33 + n; const float ws_ = pg8::W8_SCALE;
        u32x4 o; o.x = pg8::pk_fp8x4(s[0] * ws_, s[33] * ws_, s[66] * ws_, s[99] * ws_); o.y = pg8::pk_fp8x4(s[132] * ws_, s[165] * ws_, s[198] * ws_, s[231] * ws_);
        o.z = pg8::pk_fp8x4(s[264] * ws_, s[297] * ws_, s[330] * ws_, s[363] * ws_); o.w = pg8::pk_fp8x4(s[396] * ws_, s[429] * ws_, s[462] * ws_, s[495] * ws_);
        *(u32x4*)(WT + (drow0 + n) * (size_t)ldd + k0 + 16 * c) = o; }
    asm volatile("s_waitcnt lgkmcnt(0)" ::: "memory");
}
DI void tr_matrix8(const float* W, int K, int N, unsigned char* WT, int ldd, size_t rowbase, int gw, int ngw, float* scr, int lane, int mode = 0) {
    const int nkb = K / 128, nnb = N / 32, nit = nkb * nnb;
    if (gw >= nit) return;
    const int c4 = (lane & 7) * 4, r8 = lane >> 3, c = lane & 7, nb = lane >> 3;
    f32x4 v[16];
    { const int kb = gw / nnb, n0 = (gw % nnb) * 32;
#pragma unroll
      for (int i = 0; i < 16; ++i) v[i] = *(const f32x4*)(W + (size_t)(kb * 128 + 8 * i + r8) * N + n0 + c4); }
    for (int it = gw; it < nit; it += ngw) { const int kb = it / nnb, n0 = (it % nnb) * 32, k0 = kb * 128;
        const size_t drow0 = mode ? rowbase + (size_t)(n0 >> 7) * 256 + (n0 & 127) : rowbase + n0;
#pragma unroll
        for (int i = 0; i < 16; ++i) { float* s = scr + (8 * i + r8) * 33 + c4; s[0] = v[i][0]; s[1] = v[i][1]; s[2] = v[i][2]; s[3] = v[i][3]; }
        { const int itn = it + ngw < nit ? it + ngw : it, kbn = itn / nnb, n0n = (itn % nnb) * 32;
#pragma unroll
          for (int i = 0; i < 16; ++i) v[i] = *(const f32x4*)(W + (size_t)(kbn * 128 + 8 * i + r8) * N + n0n + c4); }
        asm volatile("s_waitcnt lgkmcnt(0)" ::: "memory");
#pragma unroll
        for (int j = 0; j < 4; ++j) { const int n = nb + 8 * j; const float* s = scr + (16 * c) * 33 + n; const float ws_ = pg8::W8_SCALE;
            u32x4 o; o.x = pg8::pk_fp8x4(s[0] * ws_, s[33] * ws_, s[66] * ws_, s[99] * ws_); o.y = pg8::pk_fp8x4(s[132] * ws_, s[165] * ws_, s[198] * ws_, s[231] * ws_);
            o.z = pg8::pk_fp8x4(s[264] * ws_, s[297] * ws_, s[330] * ws_, s[363] * ws_); o.w = pg8::pk_fp8x4(s[396] * ws_, s[429] * ws_, s[462] * ws_, s[495] * ws_);
            *(u32x4*)(WT + (drow0 + n) * (size_t)ldd + k0 + 16 * c) = o; }
        asm volatile("s_waitcnt lgkmcnt(0)" ::: "memory");
    }
}
DI void tr_matrix(const float* W, int K, int N, int NP, h16* WT, int ldd, int mode, size_t rowbase, int gw, int ngw, float* scr, int lane, int drop = WQ_DROP) {
    const int nnb = NP / 64, nit = (K / 64) * nnb;
    const int nkb = K / 64;
    for (int it = gw; it < nit; it += ngw) { const int kb = it % nkb, n0 = (it / nkb) * 64;
        const size_t drow0 = mode ? rowbase + (size_t)(n0 >> 7) * 256 + (n0 & 127) : rowbase + n0;
        tr_item(W, N, kb * 64, n0, WT, drow0, ldd, scr, lane, drop); }
}
DI void s5_tables(const Args& a, char* lds, int g, int q4, int nq) {
    const int tid = threadIdx.x;
    f32x2* Lpow = (f32x2*)lds;
    f32x2* Bbar = Lpow + 33 * 64;
    f32x2* Cc = Bbar + 1024;
    f32x2* coef = Cc + 1024;
    float* Kern = (float*)(coef + 64);
    h16* TCAT = (h16*)(a.ws + WS_TCAT) + (size_t)g * 512 * S5K;
    h16* EPAD = (h16*)(a.ws + WS_EPAD) + (size_t)g * 256 * 512;
    __syncthreads();
    if (tid < 64) { const int p = tid; const float dt = expf(a.in[I_LOGDT][g]); const float lre = a.in[I_LAMRE][g * 64 + p], lim = a.in[I_LAMIM][g * 64 + p];
        const float mag = expf(lre * dt); float sn, cs; sincosf(lim * dt, &sn, &cs); const float l1r = mag * cs, l1i = mag * sn;
        float pr = 1.f, pi = 0.f; Lpow[p] = (f32x2){1.f, 0.f};
        for (int j = 1; j <= 32; ++j) { const float nr = pr * l1r - pi * l1i, ni = pr * l1i + pi * l1r; pr = nr; pi = ni; Lpow[j * 64 + p] = (f32x2){pr, pi}; }
        const float nr = l1r - 1.f, ni = l1i, den = lre * lre + lim * lim; coef[p] = (f32x2){(nr * lre + ni * lim) / den, (ni * lre - nr * lim) / den}; }
    __syncthreads();
    for (int i = tid; i < 1024; i += NT) { const int p = i >> 4; const float br = a.in[I_BRE][g * 1024 + i], bi = a.in[I_BIM][g * 1024 + i]; const f32x2 c = coef[p];
        Bbar[i] = (f32x2){c.x * br - c.y * bi, c.x * bi + c.y * br}; Cc[i] = (f32x2){a.in[I_CRE][g * 1024 + i], a.in[I_CIM][g * 1024 + i]}; }
    __syncthreads();
    const int r_lo = 512 * q4 / nq, r_hi = 512 * (q4 + 1) / nq, e_lo = 256 * q4 / nq, e_hi = 256 * (q4 + 1) / nq, nlag = ((r_hi - 1) >> 4) + 1;
    for (int i = tid; i < nlag * 256; i += NT) { const int j = i >> 8, h = (i >> 4) & 15, h2 = i & 15; float s = 0.f;
        for (int p = 0; p < 64; ++p) { const f32x2 c = Cc[h * 64 + p], l = Lpow[j * 64 + p], b = Bbar[p * 16 + h2]; const float mr = c.x * l.x - c.y * l.y, mi = c.x * l.y + c.y * l.x; s += mr * b.x - mi * b.y; }
        Kern[i] = s; }
    __syncthreads();
    for (int i = r_lo * 80 + tid; i < r_hi * 80; i += NT) { const int row = i / 80, ch = i % 80, tau = row >> 4, h = row & 15; float r[8];
        if (ch < 64) { const int sg = ch >> 1, h0 = (ch & 1) * 8, lag = tau - sg;
#pragma unroll
            for (int j = 0; j < 8; ++j) r[j] = lag >= 0 ? Kern[lag * 256 + h * 16 + h0 + j] : 0.f; }
        else { const int p0 = (ch - 64) * 4;
#pragma unroll
            for (int q = 0; q < 4; ++q) { const f32x2 c = Cc[h * 64 + p0 + q], l = Lpow[(tau + 1) * 64 + p0 + q]; r[2 * q] = c.x * l.x - c.y * l.y; r[2 * q + 1] = -(c.x * l.y + c.y * l.x); } }
        u32x4 w; w.x = pkh(r[0], r[1]); w.y = pkh(r[2], r[3]); w.z = pkh(r[4], r[5]); w.w = pkh(r[6], r[7]);
        *(u32x4*)(TCAT + (size_t)row * S5K + ch * 8) = w; }
    for (int i = e_lo * 64 + tid; i < e_hi * 64; i += NT) { const int row = i >> 6, ch = i & 63; float r[8];
        if (row < 128) { const int p = row >> 1, ri = row & 1, sg = ch >> 1, h0 = (ch & 1) * 8; const f32x2 l = Lpow[(31 - sg) * 64 + p];
#pragma unroll
            for (int j = 0; j < 8; ++j) { const f32x2 b = Bbar[p * 16 + h0 + j]; r[j] = ri ? (l.x * b.y + l.y * b.x) : (l.x * b.x - l.y * b.y); } }
        else {
#pragma unroll
            for (int j = 0; j < 8; ++j) r[j] = 0.f; }
        u32x4 w; w.x = pkh(r[0], r[1]); w.y = pkh(r[2], r[3]); w.z = pkh(r[4], r[5]); w.w = pkh(r[6], r[7]);
        *(u32x4*)(EPAD + (size_t)row * 512 + ch * 8) = w; }
}
#ifndef MOE_CONV_LATE
#define MOE_CONV_LATE 4
#endif
DI void moe_convert(const Args& a, char* lds, int e_lo, int e_hi, int gw, int ngw) {
    const int lane = threadIdx.x & 63, wave = threadIdx.x >> 6; float* scr = (float*)(lds + wave * 16896); unsigned char* ws = a.ws;
    for (int e = e_lo; e < e_hi; ++e) {
        tr_matrix8(a.in[I_MW1] + (size_t)e * D * DFE, D, DFE, (unsigned char*)(ws + WS_MOE13), D, (size_t)e * 2 * DFE, gw, ngw, scr, lane, 1);
        tr_matrix8(a.in[I_MW3] + (size_t)e * D * DFE, D, DFE, (unsigned char*)(ws + WS_MOE13), D, (size_t)e * 2 * DFE + 128, gw, ngw, scr, lane, 1);
        tr_matrix8(a.in[I_MW2] + (size_t)e * DFE * D, DFE, D, (unsigned char*)(ws + WS_MOE2), DFE, (size_t)e * D, gw, ngw, scr, lane);
    }
}
DI void phase_prologue(const Args& a, char* lds) {
    const int tid = threadIdx.x, lane = tid & 63, wave = tid >> 6, gw = blockIdx.x * NWAVES + wave, ngw = gridDim.x * NWAVES;
    float* scr = (float*)(lds + wave * 16896);
    unsigned char* ws = a.ws;
    moe_convert(a, lds, 0, MOE_CONV_LATE, gw, ngw);
    tr_matrix(a.in[I_OWOUT], D, D, D, (h16*)(ws + WS_WOUT1), D, 0, 0, gw, ngw, scr, lane);
    tr_matrix(a.in[I_GLUW], 1024, 1024, 1024, (h16*)(ws + WS_WGLU), 1024, 0, 0, gw, ngw, scr, lane);
    tr_matrix(a.in[I_OWIN], D, IN1, IN1P, (h16*)(ws + WS_WIN1), D, 0, 0, gw, ngw, scr, lane);
    tr_matrix(a.in[I_EW2], DFF, D, D, (h16*)(ws + WS_WFF2), DFF, 0, 0, gw, ngw, scr, lane);
    tr_matrix(a.in[I_EW1], D, DFF, DFF, (h16*)(ws + WS_WFF13), D, 1, 0, gw, ngw, scr, lane);
    tr_matrix(a.in[I_EW3], D, DFF, DFF, (h16*)(ws + WS_WFF13), D, 1, 128, gw, ngw, scr, lane);
    tr_matrix(a.in[I_EWOUT], D, D, D, (h16*)(ws + WS_WOUT0), D, 0, 0, gw, ngw, scr, lane);
    tr_matrix(a.in[I_EWIN], D, IN0, IN0, (h16*)(ws + WS_WIN0), D, 0, 0, gw, ngw, scr, lane);
    { const float* x = a.in[I_X]; h16* xh = (h16*)(ws + WS_XH);
      for (size_t i = (size_t)blockIdx.x * NT + tid; i < (size_t)M * D / 8; i += (size_t)gridDim.x * NT) { const f32x4 v0 = *(const f32x4*)(x + i * 8), v1 = *(const f32x4*)(x + i * 8 + 4);
          u32x4 w; w.x = pka(v0[0], v0[1]); w.y = pka(v0[2], v0[3]); w.z = pka(v1[0], v1[1]); w.w = pka(v1[2], v1[3]); *(u32x4*)(xh + i * 8) = w; } }
    __syncthreads();
    if (gridDim.x >= 256) { if (blockIdx.x < 256) s5_tables(a, lds, (int)blockIdx.x >> 2, (int)blockIdx.x & 3, 4); }
    else for (int g = blockIdx.x; g < 64; g += gridDim.x) s5_tables(a, lds, g, 0, 1);
}

DI void ln_normalize(float (&v)[32], const float* gam, const float* bet, int lane) {
    float s = 0.f;
#pragma unroll
    for (int i = 0; i < 32; ++i) s += v[i];
    const float mean = wave_sum(s) * (1.f / D); float s2 = 0.f;
#pragma unroll
    for (int i = 0; i < 32; ++i) { v[i] -= mean; s2 += v[i] * v[i]; }
    const float rstd = 1.0f / sqrtf(wave_sum(s2) * (1.f / D) + 1e-5f);
#pragma unroll
    for (int j = 0; j < 4; ++j) { const f32x4 g0 = *(const f32x4*)(gam + 8 * lane + 512 * j), g1 = *(const f32x4*)(gam + 8 * lane + 512 * j + 4), b0 = *(const f32x4*)(bet + 8 * lane + 512 * j), b1 = *(const f32x4*)(bet + 8 * lane + 512 * j + 4);
#pragma unroll
        for (int q = 0; q < 4; ++q) { v[8 * j + q] = v[8 * j + q] * rstd * g0[q] + b0[q]; v[8 * j + 4 + q] = v[8 * j + 4 + q] * rstd * g1[q] + b1[q]; } }
}
template <bool ROUTER>
DI void phase_ln(const Args& a, char* lds, const h16* Pin, const float* gam, const float* bet) {
    const int tid = threadIdx.x, lane = tid & 63, wave = tid >> 6, gw = blockIdx.x * NWAVES + wave, ngw = gridDim.x * NWAVES;
    h16* XH = (h16*)(a.ws + WS_XH);
    float* WrT = (float*)lds;
    if (ROUTER) { __syncthreads(); const float* rw = a.in[I_ROUTER]; for (int i = tid; i < D * 8; i += NT) WrT[(i & 7) * D + (i >> 3)] = rw[i]; __syncthreads(); }
    h16x8 pn[4];
    if (gw < M) {
#pragma unroll
        for (int j = 0; j < 4; ++j) pn[j] = *(const h16x8*)(Pin + (size_t)gw * D + 8 * lane + 512 * j); }
    for (int row = gw; row < M; row += ngw) {
        float v[32];
#pragma unroll
        for (int j = 0; j < 4; ++j) {
#pragma unroll
            for (int q = 0; q < 8; ++q) v[8 * j + q] = (float)pn[j][q]; }
        { const int nr = row + ngw < M ? row + ngw : row;
#pragma unroll
          for (int j = 0; j < 4; ++j) pn[j] = *(const h16x8*)(Pin + (size_t)nr * D + 8 * lane + 512 * j); }
        ln_normalize(v, gam, bet, lane);
#pragma unroll
        for (int j = 0; j < 4; ++j) { u32x4 w; w.x = pka(v[8 * j], v[8 * j + 1]); w.y = pka(v[8 * j + 2], v[8 * j + 3]); w.z = pka(v[8 * j + 4], v[8 * j + 5]); w.w = pka(v[8 * j + 6], v[8 * j + 7]);
            *(u32x4*)(XH + (size_t)row * D + 8 * lane + 512 * j) = w; }
        if (ROUTER) {
#pragma unroll
            for (int j = 0; j < 4; ++j) { u32x2 q; q.x = pg8::pk_fp8x4(v[8 * j] * pg8::X8_SCALE, v[8 * j + 1] * pg8::X8_SCALE, v[8 * j + 2] * pg8::X8_SCALE, v[8 * j + 3] * pg8::X8_SCALE);
                q.y = pg8::pk_fp8x4(v[8 * j + 4] * pg8::X8_SCALE, v[8 * j + 5] * pg8::X8_SCALE, v[8 * j + 6] * pg8::X8_SCALE, v[8 * j + 7] * pg8::X8_SCALE);
                *(u32x2*)(a.ws + WS_XQ8 + (size_t)row * D + 8 * lane + 512 * j) = q; }
            float lg[8];
#pragma unroll
            for (int e = 0; e < 8; ++e) { float s = 0.f;
#pragma unroll
                for (int j = 0; j < 4; ++j) { const f32x4 w0 = *(const f32x4*)(WrT + e * D + 8 * lane + 512 * j), w1 = *(const f32x4*)(WrT + e * D + 8 * lane + 512 * j + 4);
#pragma unroll
                    for (int q = 0; q < 4; ++q) s += v[8 * j + q] * w0[q] + v[8 * j + 4 + q] * w1[q]; }
                lg[e] = wave_sum(s); asm volatile("" ::: "memory"); }
            int i1 = 0; float v1 = lg[0];
#pragma unroll
            for (int e = 1; e < 8; ++e) if (lg[e] > v1) { v1 = lg[e]; i1 = e; }
            int i2 = -1; float v2 = -3.0e38f;
#pragma unroll
            for (int e = 0; e < 8; ++e) if (e != i1 && lg[e] > v2) { v2 = lg[e]; i2 = e; }
            const float g1 = 1.0f / (1.0f + expf(v2 - v1)), g2 = 1.0f - g1;
            if (lane == 0) { unsigned* cnt = (unsigned*)(a.ws + WS_CTL) + CW_CNT;
                const unsigned p1 = atomicAdd(cnt + i1, 1u), p2 = atomicAdd(cnt + i2, 1u);
                int* tk = (int*)(a.ws + WS_TOK) + (size_t)row * 8; tk[0] = i1; tk[1] = i2; tk[2] = (int)p1; tk[3] = (int)p2; ((float*)tk)[4] = g1; ((float*)tk)[5] = g2;
                int* lst = (int*)(a.ws + WS_LIST); lst[(i1 << 14) + (int)p1] = row; lst[(i2 << 14) + (int)p2] = row; }
        }
    }
}
DI void moe_y8(const h16* Y, const float* SL, int slot, int col, int pm0, int R, int sp, float (&y)[8]) {
    const int pm = slot >> 8;
    if (pm < pm0) { const h16x8 t = *(const h16x8*)(Y + (size_t)slot * D + col);
#pragma unroll
        for (int q = 0; q < 8; ++q) y[q] = (float)t[q]; }
    else { const int tile = (pm - pm0) * 8 + (col >> 8);
#pragma unroll
        for (int q = 0; q < 8; ++q) y[q] = 0.f;
        for (int ks = 0; ks < sp; ++ks) { const float* p = SL + (size_t)(ks * R + tile) * 65536 + (size_t)(slot & 255) * 256 + (col & 255); const f32x4 t0 = *(const f32x4*)p, t1 = *(const f32x4*)(p + 4);
#pragma unroll
            for (int q = 0; q < 4; ++q) { y[q] += t0[q]; y[4 + q] += t1[q]; } } }
}
DI void final_row_slow(const Args& a, int row, int s1, int s2, float g1, float g2, int pm0, int R, int sp, int lane) {
    const h16* XH = (const h16*)(a.ws + WS_XH); const h16* Y = (const h16*)(a.ws + WS_XG); const float* SL = (const float*)(a.ws + WS_SLAB);
    float v[32];
#pragma unroll
    for (int j = 0; j < 4; ++j) { const int col = 8 * lane + 512 * j; const h16x8 x = *(const h16x8*)(XH + (size_t)row * D + col); float y1[8], y2[8];
        moe_y8(Y, SL, s1, col, pm0, R, sp, y1); moe_y8(Y, SL, s2, col, pm0, R, sp, y2);
#pragma unroll
        for (int q = 0; q < 8; ++q) v[8 * j + q] = ALPHA * (float)x[q] + g1 * y1[q] + g2 * y2[q]; }
    ln_normalize(v, a.in[I_OLNFG], a.in[I_OLNFB], lane);
#pragma unroll
    for (int j = 0; j < 4; ++j) { *(f32x4*)(a.out + (size_t)row * D + 8 * lane + 512 * j) = (f32x4){v[8 * j], v[8 * j + 1], v[8 * j + 2], v[8 * j + 3]}; *(f32x4*)(a.out + (size_t)row * D + 8 * lane + 512 * j + 4) = (f32x4){v[8 * j + 4], v[8 * j + 5], v[8 * j + 6], v[8 * j + 7]}; }
}
DI void phase_final(const Args& a, int pm0, int R, int sp, int t1, int t2, int t3, int t4, int t5, int t6, int t7) {
#define FIN_SLOT(e_, p_) ((((e_) == 1 ? t1 : (e_) == 2 ? t2 : (e_) == 3 ? t3 : (e_) == 4 ? t4 : (e_) == 5 ? t5 : (e_) == 6 ? t6 : (e_) == 7 ? t7 : 0) << 8) + (p_))
    const int tid = threadIdx.x, lane = tid & 63, wave = __builtin_amdgcn_readfirstlane(tid >> 6), gw = blockIdx.x * NWAVES + wave, ngw = gridDim.x * NWAVES;
    const h16* XH = (const h16*)(a.ws + WS_XH); const h16* Y = (const h16*)(a.ws + WS_XG);
    for (int rowA = gw; rowA < M; rowA += 2 * ngw) {
        const int rowB = rowA + ngw < M ? rowA + ngw : rowA;
        const int* tkA = (const int*)(a.ws + WS_TOK) + (size_t)rowA * 8; const int* tkB = (const int*)(a.ws + WS_TOK) + (size_t)rowB * 8;
        const int a1 = FIN_SLOT(tkA[0], tkA[2]), a2 = FIN_SLOT(tkA[1], tkA[3]), b1 = FIN_SLOT(tkB[0], tkB[2]), b2 = FIN_SLOT(tkB[1], tkB[3]); const float ga1 = ((const float*)tkA)[4], ga2 = ((const float*)tkA)[5], gb1 = ((const float*)tkB)[4], gb2 = ((const float*)tkB)[5];
        const bool fast = (a1 >> 8) < pm0 && (a2 >> 8) < pm0 && (b1 >> 8) < pm0 && (b2 >> 8) < pm0;
        if (fast) {
            h16x8 xa[4], ya1[4], ya2[4], xb[4], yb1[4], yb2[4];
#pragma unroll
            for (int j = 0; j < 4; ++j) { const int col = 8 * lane + 512 * j; xa[j] = *(const h16x8*)(XH + (size_t)rowA * D + col); ya1[j] = *(const h16x8*)(Y + (size_t)a1 * D + col); ya2[j] = *(const h16x8*)(Y + (size_t)a2 * D + col);
                xb[j] = *(const h16x8*)(XH + (size_t)rowB * D + col); yb1[j] = *(const h16x8*)(Y + (size_t)b1 * D + col); yb2[j] = *(const h16x8*)(Y + (size_t)b2 * D + col); }
            float v[32];
#pragma unroll
            for (int j = 0; j < 4; ++j)
#pragma unroll
                for (int q = 0; q < 8; ++q) v[8 * j + q] = ALPHA * (float)xa[j][q] + ga1 * (float)ya1[j][q] + ga2 * (float)ya2[j][q];
            ln_normalize(v, a.in[I_OLNFG], a.in[I_OLNFB], lane);
#pragma unroll
            for (int j = 0; j < 4; ++j) { *(f32x4*)(a.out + (size_t)rowA * D + 8 * lane + 512 * j) = (f32x4){v[8 * j], v[8 * j + 1], v[8 * j + 2], v[8 * j + 3]}; *(f32x4*)(a.out + (size_t)rowA * D + 8 * lane + 512 * j + 4) = (f32x4){v[8 * j + 4], v[8 * j + 5], v[8 * j + 6], v[8 * j + 7]}; }
#pragma unroll
            for (int j = 0; j < 4; ++j)
#pragma unroll
                for (int q = 0; q < 8; ++q) v[8 * j + q] = ALPHA * (float)xb[j][q] + gb1 * (float)yb1[j][q] + gb2 * (float)yb2[j][q];
            ln_normalize(v, a.in[I_OLNFG], a.in[I_OLNFB], lane);
            if (rowB != rowA) {
#pragma unroll
                for (int j = 0; j < 4; ++j) { *(f32x4*)(a.out + (size_t)rowB * D + 8 * lane + 512 * j) = (f32x4){v[8 * j], v[8 * j + 1], v[8 * j + 2], v[8 * j + 3]}; *(f32x4*)(a.out + (size_t)rowB * D + 8 * lane + 512 * j + 4) = (f32x4){v[8 * j + 4], v[8 * j + 5], v[8 * j + 6], v[8 * j + 7]}; } }
        } else { final_row_slow(a, rowA, a1, a2, ga1, ga2, pm0, R, sp, lane); if (rowB != rowA) final_row_slow(a, rowB, b1, b2, gb1, gb2, pm0, R, sp, lane); }
    }
#undef FIN_SLOT
}

DI void phase_dilated(const Args& a, char* lds) {
    const int tid = threadIdx.x, lane = tid & 63, w = __builtin_amdgcn_readfirstlane(tid >> 6), g = lane >> 4, lq = lane & 15;
    const h16* H0 = (const h16*)(a.ws + WS_H0); h16* OP = (h16*)(a.ws + WS_OP); float* LSE = (float*)(a.ws + WS_LSE);
    char* Ks = lds; char* Vs = lds + 256 * 272;
    const int chunk = tid & 15, rr = tid >> 4;
    u32x4 kv[8], vv[8]; h16x8 qn[4];
#define DIL_LOAD(u_) do { const int pt_ = (u_) >> 10, rem_ = (u_) & 1023, bh_ = rem_ >> 6, blk_ = rem_ & 63, dsh_ = 2 * pt_, d_ = 1 << dsh_, r_ = blk_ >> (6 - dsh_), m0_ = (blk_ & ((64 >> dsh_) - 1)) * 128; \
        const h16* base_ = H0 + (size_t)((bh_ >> 3) * SEQ) * IN0 + (bh_ & 7) * 128; \
        _Pragma("unroll") for (int p = 0; p < 8; ++p) { const int mm = m0_ - 128 + p * 32 + rr; const int mc = mm >= 0 ? mm : 0; const h16* rp = base_ + (size_t)(mc * d_ + r_) * IN0 + chunk * 8; \
            kv[p] = *(const u32x4*)(rp + 4096); vv[p] = *(const u32x4*)(rp + 5120); if (mm < 0) { kv[p] = (u32x4){0u, 0u, 0u, 0u}; vv[p] = kv[p]; } } \
        const int tq_ = (m0_ + 16 * w + lq) * d_ + r_; \
        _Pragma("unroll") for (int kk = 0; kk < 4; ++kk) qn[kk] = *(const h16x8*)(base_ + (size_t)tq_ * IN0 + 3072 + 32 * kk + 8 * g); } while (0)
    const int G_ = gridDim.x, xg = (G_ % 8 == 0 && 3072 % G_ == 0) ? 1 : 0;
    const int ustart = xg ? ((int)blockIdx.x & 7) * (3072 / 8) + ((int)blockIdx.x >> 3) : (int)blockIdx.x, ustep = xg ? G_ / 8 : G_, uend = xg ? (((int)blockIdx.x & 7) + 1) * (3072 / 8) : 3072;
    __syncthreads();
    if (ustart < uend) DIL_LOAD(ustart);
    for (int u = ustart; u < uend; u += ustep) {
        const int pt = u >> 10, rem = u & 1023, bh = rem >> 6, blk = rem & 63, b = bh >> 3, h = bh & 7;
        const int dsh = 2 * pt, d = 1 << dsh, r = blk >> (6 - dsh), m0 = (blk & ((64 >> dsh) - 1)) * 128;
        LBAR();
#pragma unroll
        for (int p = 0; p < 8; ++p) { const int row = p * 32 + rr; *(u32x4*)(Ks + row * 272 + chunk * 16) = kv[p]; *(u32x4*)(Vs + row * 288 + chunk * 16) = vv[p]; }
        h16x8 qf[4];
#pragma unroll
        for (int kk = 0; kk < 4; ++kk) qf[kk] = qn[kk];
        { const int un = u + ustep < uend ? u + ustep : u; DIL_LOAD(un); }
        const int tq = (m0 + 16 * w + lq) * d + r;
        LBAR();
        f32x4 acc[9];
#pragma unroll
        for (int ti = 0; ti < 9; ++ti) { acc[ti] = (f32x4){0.f, 0.f, 0.f, 0.f};
#pragma unroll
            for (int kk = 0; kk < 4; ++kk) { const h16x8 kf = *(const h16x8*)(Ks + (16 * w + 16 * ti + lq) * 272 + (4 * kk + g) * 16); acc[ti] = MFMA16(kf, qf[kk], acc[ti]); } }
        const int kbase = m0 + 16 * w - 128;
        float mx = -1e30f;
#pragma unroll
        for (int ti = 0; ti < 9; ++ti)
#pragma unroll
            for (int i = 0; i < 4; ++i) { const int kr = 16 * ti + 4 * g + i; const bool valid = (kr >= lq) && (kr <= lq + 128) && (kbase + kr >= 0);
                const float sc = valid ? acc[ti][i] * QK_SCALE : -1e30f; acc[ti][i] = sc; mx = fmaxf(mx, sc); }
        mx = fmaxf(mx, __shfl_xor(mx, 16)); mx = fmaxf(mx, __shfl_xor(mx, 32));
        float sum = 0.f;
#pragma unroll
        for (int ti = 0; ti < 9; ++ti)
#pragma unroll
            for (int i = 0; i < 4; ++i) { const float p = __expf(acc[ti][i] - mx); acc[ti][i] = p; sum += p; }
        sum += __shfl_xor(sum, 16); sum += __shfl_xor(sum, 32);
        const float inv = 1.0f / sum;
        f32x4 o[8];
#pragma unroll
        for (int c = 0; c < 8; ++c) o[c] = (f32x4){0.f, 0.f, 0.f, 0.f};
#pragma unroll
        for (int s = 0; s < 5; ++s) {
            h16x8 pf;
#pragma unroll
            for (int j = 0; j < 4; ++j) { pf[j] = (h16)(acc[2 * s][j] * inv); pf[4 + j] = (s < 4) ? (h16)(acc[(s < 4) ? 2 * s + 1 : 0][j] * inv) : (h16)0.f; }
            const char* vb = Vs + (16 * w + 32 * s + 4 * g + (lq >> 2)) * 288 + (4 * (lq & 3)) * 2;
#pragma unroll
            for (int c = 0; c < 8; ++c) { const h16x4 t0 = trread(vb + c * 32); h16x4 t1 = (h16x4){(h16)0.f, (h16)0.f, (h16)0.f, (h16)0.f}; if (s < 4) t1 = trread(vb + 16 * 288 + c * 32);
                o[c] = MFMA16(mk8(t0, t1), pf, o[c]); }
        }
        h16* op = OP + ((size_t)pt * M + (size_t)(b * SEQ + tq)) * 1024 + h * 128 + 4 * g;
#pragma unroll
        for (int c = 0; c < 8; ++c) { u32x2 wv; wv.x = pkh(o[c][0], o[c][1]); wv.y = pkh(o[c][2], o[c][3]); *(u32x2*)(op + 16 * c) = wv; }
        if (g == 0) LSE[(size_t)(pt * 16 + bh) * SEQ + tq] = mx + __logf(sum);
    }
#undef DIL_LOAD
    __syncthreads();
}
DI void phase_combine(const Args& a) {
    const h16* OP = (const h16*)(a.ws + WS_OP); const float* LSE = (const float*)(a.ws + WS_LSE); h16* O0 = (h16*)(a.ws + WS_O0);
#pragma unroll 4
    for (size_t i = (size_t)blockIdx.x * NT + threadIdx.x; i < (size_t)M * 128; i += (size_t)gridDim.x * NT) {
        const int token = (int)(i >> 7), hc = (int)(i & 127), h = hc >> 4, b = token >> 13, t = token & 8191;
        const float l0 = LSE[(size_t)(0 * 16 + b * 8 + h) * SEQ + t], l1 = LSE[(size_t)(1 * 16 + b * 8 + h) * SEQ + t], l2 = LSE[(size_t)(2 * 16 + b * 8 + h) * SEQ + t];
        const float mx = fmaxf(l0, fmaxf(l1, l2)); float w0 = __expf(l0 - mx), w1 = __expf(l1 - mx), w2 = __expf(l2 - mx); const float inv = 1.0f / (w0 + w1 + w2); w0 *= inv; w1 *= inv; w2 *= inv;
        const size_t off = (size_t)token * 1024 + hc * 8;
        const h16x8 a0 = *(const h16x8*)(OP + off), a1 = *(const h16x8*)(OP + (size_t)M * 1024 + off), a2 = *(const h16x8*)(OP + (size_t)2 * M * 1024 + off);
        float r[8];
#pragma unroll
        for (int j = 0; j < 8; ++j) r[j] = w0 * (float)a0[j] + w1 * (float)a1[j] + w2 * (float)a2[j];
        u32x4 wv; wv.x = pkh(r[0], r[1]); wv.y = pkh(r[2], r[3]); wv.z = pkh(r[4], r[5]); wv.w = pkh(r[6], r[7]);
        *(u32x4*)(O0 + (size_t)token * 2048 + 1024 + hc * 8) = wv;
    }
}

DI void sb_tile(const f32x4& acc, int key0, int tq, int g, int lq, float& R, float (&wout)[4]) {
    float lk[4], lsz[4]; bool past[4];
#pragma unroll
    for (int i = 0; i < 4; ++i) { const int key = key0 + 4 * g + i; const float z = acc[i] * QK_SCALE; past[i] = (key < tq) && (key >= 0);
        const float sp = softplusf_(z); lk[i] = past[i] ? -sp : 0.f; lsz[i] = z - sp; }
    const float suf2 = lk[3], suf1 = suf2 + lk[2], suf0 = suf1 + lk[1], T = suf0 + lk[0];
    float IS = T; float t = __shfl_down(IS, 16); if (g < 3) IS += t; t = __shfl_down(IS, 32); if (g < 2) IS += t;
    const float G = IS - T, total = __shfl(IS, lq);
    const float base = R + G;
    wout[0] = past[0] ? __expf(lsz[0] + base + suf0) : 0.f; wout[1] = past[1] ? __expf(lsz[1] + base + suf1) : 0.f;
    wout[2] = past[2] ? __expf(lsz[2] + base + suf2) : 0.f; wout[3] = past[3] ? __expf(lsz[3] + base) : 0.f;
    R += total;
}
DI void phase_sb(const Args& a, char* lds) {
    const int tid = threadIdx.x, lane = tid & 63, w = __builtin_amdgcn_readfirstlane(tid >> 6), g = lane >> 4, lq = lane & 15;
    const h16* H0 = (const h16*)(a.ws + WS_H0); h16* O0 = (h16*)(a.ws + WS_O0);
    char* Vw = lds + w * 9216;
    const int G_ = gridDim.x, xg = (G_ % 8 == 0 && 1024 % G_ == 0) ? 1 : 0;
    const int bstart = xg ? ((int)blockIdx.x & 7) * 128 + ((int)blockIdx.x >> 3) : (int)blockIdx.x, bstep = xg ? G_ / 8 : G_, bend = xg ? (((int)blockIdx.x & 7) + 1) * 128 : 1024;
    for (int bu = bstart; bu < bend; bu += bstep) { const int wu = bu * NWAVES + w;
        const int bh = wu >> 9, qt = wu & 511, b = bh >> 3, h = bh & 7, q0 = 16 * qt, tq = q0 + lq;
        const h16* base = H0 + (size_t)(b * SEQ) * IN0 + h * 128;
        h16x8 qf[4];
#pragma unroll
        for (int kk = 0; kk < 4; ++kk) qf[kk] = *(const h16x8*)(base + (size_t)tq * IN0 + 32 * kk + 8 * g);
        float R = 0.f; f32x4 o[8];
#pragma unroll
        for (int c = 0; c < 8; ++c) o[c] = (f32x4){0.f, 0.f, 0.f, 0.f};
        for (int sb = q0 - 16; sb > -32; sb -= 32) {
            const int ra = max(sb + lq, 0), rb = sb + 16 + lq;
            h16x8 kfa[4], kfb[4];
#pragma unroll
            for (int kk = 0; kk < 4; ++kk) { kfa[kk] = *(const h16x8*)(base + (size_t)ra * IN0 + 1024 + 32 * kk + 8 * g); kfb[kk] = *(const h16x8*)(base + (size_t)rb * IN0 + 1024 + 32 * kk + 8 * g); }
            u32x4 vr[8];
#pragma unroll
            for (int i = 0; i < 8; ++i) { const int idx = lane + 64 * i, row = idx >> 4, chunk = idx & 15; vr[i] = *(const u32x4*)(base + (size_t)max(sb + row, 0) * IN0 + 2048 + chunk * 8); }
#pragma unroll
            for (int i = 0; i < 8; ++i) { const int idx = lane + 64 * i, row = idx >> 4, chunk = idx & 15; *(u32x4*)(Vw + row * 288 + chunk * 16) = vr[i]; }
            f32x4 accA = (f32x4){0.f, 0.f, 0.f, 0.f}, accB = accA;
#pragma unroll
            for (int kk = 0; kk < 4; ++kk) { accA = MFMA16(kfa[kk], qf[kk], accA); accB = MFMA16(kfb[kk], qf[kk], accB); }
            float wa[4], wb[4];
            sb_tile(accB, sb + 16, tq, g, lq, R, wb);
            sb_tile(accA, sb, tq, g, lq, R, wa);
            h16x8 pf;
#pragma unroll
            for (int j = 0; j < 4; ++j) { pf[j] = (h16)wa[j]; pf[4 + j] = (h16)wb[j]; }
            asm volatile("s_waitcnt lgkmcnt(0)" ::: "memory");
            const char* vb = Vw + (4 * g + (lq >> 2)) * 288 + (4 * (lq & 3)) * 2;
#pragma unroll
            for (int c = 0; c < 8; ++c) { const h16x4 t0 = trread(vb + c * 32), t1 = trread(vb + 16 * 288 + c * 32); o[c] = MFMA16(mk8(t0, t1), pf, o[c]); }
            asm volatile("s_waitcnt lgkmcnt(0)" ::: "memory");
            if (__all(R < -50.0f)) break;
        }
        h16* op = O0 + (size_t)(b * SEQ + tq) * 2048 + h * 128 + 4 * g;
#pragma unroll
        for (int c = 0; c < 8; ++c) { u32x2 wv; wv.x = pkh(o[c][0], o[c][1]); wv.y = pkh(o[c][2], o[c][3]); *(u32x2*)(op + 16 * c) = wv; }
    }
}

DI void phase_gdn_pre(const Args& a, char* lds, int row_lo, int row_hi, int first_block) {
    const int tid = threadIdx.x, lane = tid & 63, wave = tid >> 6, gw = ((int)blockIdx.x - first_block) * NWAVES + wave, ngw = ((int)gridDim.x - first_block) * NWAVES;
    if ((int)blockIdx.x < first_block) return;
    const h16* QKVG = (const h16*)(a.ws + WS_QKVG); const float* LOGIT = (const float*)(a.ws + WS_LOGIT); h16* QKVN = (h16*)(a.ws + WS_QKVN); float* GB = (float*)(a.ws + WS_GB);
    float* cw = (float*)lds;
    __syncthreads();
    for (int i = tid; i < 3072; i += NT) ((f32x4*)cw)[i] = ((const f32x4*)a.in[I_CONVW])[i];
    __syncthreads();
    for (int row = row_lo + gw; row < row_hi; row += ngw) { const int t = row & (SEQ - 1);
        float acc[6][8];
#pragma unroll
        for (int j = 0; j < 6; ++j)
#pragma unroll
            for (int q = 0; q < 8; ++q) acc[j][q] = 0.f;
#pragma unroll
        for (int i = 0; i < 4; ++i) { if (t - 3 + i >= 0) {
#pragma unroll
            for (int j = 0; j < 6; ++j) { const int c8 = 8 * (lane + 64 * j); const h16x8 xv = *(const h16x8*)(QKVG + (size_t)(row - 3 + i) * 4096 + c8);
                const f32x4 w0 = *(const f32x4*)(cw + i * 3072 + c8), w1 = *(const f32x4*)(cw + i * 3072 + c8 + 4);
#pragma unroll
                for (int q = 0; q < 8; ++q) acc[j][q] += (q < 4 ? w0[q & 3] : w1[q & 3]) * (float)xv[q]; } } }
#pragma unroll
        for (int j = 0; j < 6; ++j) { float ss = 0.f;
#pragma unroll
            for (int q = 0; q < 8; ++q) { acc[j][q] = siluf_(acc[j][q]); ss += acc[j][q] * acc[j][q]; }
            if (j < 4) { ss += __shfl_xor(ss, 1); ss += __shfl_xor(ss, 2); ss += __shfl_xor(ss, 4); ss += __shfl_xor(ss, 8); float rinv = 1.0f / sqrtf(ss + 1e-6f); if (j < 2) rinv *= QK_SCALE;
#pragma unroll
                for (int q = 0; q < 8; ++q) acc[j][q] *= rinv; }
            u32x4 wv; wv.x = pkh(acc[j][0], acc[j][1]); wv.y = pkh(acc[j][2], acc[j][3]); wv.z = pkh(acc[j][4], acc[j][5]); wv.w = pkh(acc[j][6], acc[j][7]);
            *(u32x4*)(QKVN + (size_t)row * 3072 + 8 * (lane + 64 * j)) = wv; }
        if (lane < 8) { const float bl = LOGIT[(size_t)row * 16 + lane], al = LOGIT[(size_t)row * 16 + 8 + lane];
            GB[(size_t)row * 16 + lane] = sigmoidf_(bl); GB[(size_t)row * 16 + 8 + lane] = -expf(a.in[I_ALOG][lane]) * softplusf_(al + a.in[I_DTB][lane]); }
    }
}
DI void phase_gdn_local(const Args& a, char* lds) {
    const int tid = threadIdx.x, lane = tid & 63, w = __builtin_amdgcn_readfirstlane(tid >> 6), g = lane >> 4, lq = lane & 15;
    const h16* QKVN = (const h16*)(a.ws + WS_QKVN); const float* GB = (const float*)(a.ws + WS_GB);
    constexpr int TB = 52224;
    int off_lm = 2 * TB, off_gc = 2 * TB + 16384; asm volatile("" : "+v"(off_lm)); asm volatile("" : "+v"(off_gc));
    float* Lm = (float*)(lds + off_lm);
    float* gcb = (float*)(lds + off_gc);
    float* Dinv = gcb + 384;
    int t2 = tid - 256;
    u32x4 pre[6]; float pg = 0.f, pb = 0.f;
#define GL_LOAD(un) do { const int b_ = (un) >> 10, n_ = ((un) >> 3) & 127, h_ = (un) & 7; const size_t row0_ = (size_t)b_ * SEQ + n_ * 64; const int tq_ = t2 + 256; \
        _Pragma("unroll") for (int k = 0; k < 6; ++k) { const int idx = tq_ + 512 * k, part = idx >> 10, r = (idx >> 4) & 63, ch = idx & 15; pre[k] = *(const u32x4*)(QKVN + (row0_ + r) * 3072 + part * 1024 + h_ * 128 + ch * 8); } \
        if (tq_ < 64) { pb = GB[(row0_ + tq_) * 16 + h_]; pg = GB[(row0_ + tq_) * 16 + 8 + h_]; } } while (0)
#define GL_STORE(buf) do { char* tb_ = lds + (buf) * TB; const int tq_ = t2 + 256; \
        _Pragma("unroll") for (int k = 0; k < 6; ++k) { const int idx = tq_ + 512 * k, part = idx >> 10, r = (idx >> 4) & 63, ch = idx & 15; *(u32x4*)(tb_ + part * 17408 + r * 272 + ch * 16) = pre[k]; } \
        if (tq_ < 64) { float s_ = pg; _Pragma("unroll") for (int o = 1; o < 64; o <<= 1) { const float t_ = __shfl_up(s_, o); if (lane >= o) s_ += t_; } \
            float* gq_ = gcb + (buf) * 192; gq_[tq_] = s_; gq_[64 + tq_] = pb; gq_[128 + tq_] = __expf(s_); } } while (0)
    __syncthreads();
    if ((int)blockIdx.x < GUNITS) { GL_LOAD((int)blockIdx.x); GL_STORE(0); }
    int cur = 0;
    for (int unit = blockIdx.x; unit < GUNITS; unit += gridDim.x, cur ^= 1) {
        asm volatile("" : "+v"(t2));
        const char* qh = lds + cur * TB; const char* kh = qh + 17408; const char* vh = qh + 34816;
        const float* gc = gcb + cur * 192; const float* bt = gc + 64; const float* eg = gc + 128;
        LBAR();
        { const int nu_ = unit + (int)gridDim.x < GUNITS ? unit + (int)gridDim.x : unit; GL_LOAD(nu_); }
        { const int which = w >> 2, ti = w & 3; const char* Ah = which ? qh : kh; h16* INTRA = (h16*)(a.ws + WS_GINTRA) + (size_t)unit * 4096;
#pragma unroll
          for (int tj = 0; tj < 4; ++tj) {
              if (tj <= ti) { f32x4 acc = (f32x4){0.f, 0.f, 0.f, 0.f};
#pragma unroll
                  for (int kk = 0; kk < 4; ++kk) { const h16x8 af = *(const h16x8*)(Ah + (16 * ti + lq) * 272 + (4 * kk + g) * 16), bf = *(const h16x8*)(kh + (16 * tj + lq) * 272 + (4 * kk + g) * 16); acc = MFMA16(af, bf, acc); }
#pragma unroll
                  for (int e = 0; e < 4; ++e) { const int i = 16 * ti + 4 * g + e, j = 16 * tj + lq; const float dec = (j <= i) ? __expf(gc[i] - gc[j]) : 0.f;
                      if (which == 0) Lm[i * 64 + j] = (j < i) ? -(acc[e] * bt[i] * dec) : 0.f; else INTRA[i * 64 + j] = (h16)(acc[e] * dec); } }
              else if (which) {
#pragma unroll
                  for (int e = 0; e < 4; ++e) INTRA[(16 * ti + 4 * g + e) * 64 + 16 * tj + lq] = (h16)0.f; } } }
        LBAR();
        if (tid < 256) { const int bb = w, c = lq; float nn[16];
#pragma unroll
            for (int i = 0; i < 16; ++i) { float sacc = (i == c) ? 1.f : 0.f;
#pragma unroll
                for (int j4 = 0; j4 < (i + 3) / 4; ++j4) { const f32x4 l = *(const f32x4*)(Lm + (16 * bb + i) * 64 + 16 * bb + 4 * j4);
#pragma unroll
                    for (int q = 0; q < 4; ++q) if (4 * j4 + q < i) sacc += l[q] * nn[4 * j4 + q]; }
                nn[i] = sacc; if (lane < 16) Dinv[bb * 256 + i * 16 + c] = sacc; } }
        else {
            h16* QD = (h16*)(a.ws + WS_GQD) + (size_t)unit * 8192; h16* KDT = (h16*)(a.ws + WS_GKDT) + (size_t)unit * 8192; const float gl = gc[63];
            for (int it = t2; it < 1024; it += 256) { const int i = it >> 4, c8 = (it & 15) * 8; const float e = eg[i]; const h16x8 qv = *(const h16x8*)(qh + i * 272 + c8 * 2);
                u32x4 wv; wv.x = pkh((float)qv[0] * e, (float)qv[1] * e); wv.y = pkh((float)qv[2] * e, (float)qv[3] * e); wv.z = pkh((float)qv[4] * e, (float)qv[5] * e); wv.w = pkh((float)qv[6] * e, (float)qv[7] * e); *(u32x4*)(QD + i * 128 + c8) = wv; }
            for (int it = t2; it < 1024; it += 256) { const int dk = it & 127, c0 = (it >> 7) * 8; float r[8];
#pragma unroll
                for (int j = 0; j < 8; ++j) r[j] = (float)((const h16*)kh)[(c0 + j) * 136 + dk] * __expf(gl - gc[c0 + j]);
                u32x4 wv; wv.x = pkh(r[0], r[1]); wv.y = pkh(r[2], r[3]); wv.z = pkh(r[4], r[5]); wv.w = pkh(r[6], r[7]); *(u32x4*)(KDT + dk * 64 + c0) = wv; }
            if (t2 == 0) ((float*)(a.ws + WS_GLAST))[unit] = __expf(gl); }
        LBAR();
#pragma unroll
        for (int cc = 0; cc < 2; ++cc) { const int ctile = 2 * w + cc, c = 16 * ctile + lq; const bool isv = ctile < 8; const h16* src = (const h16*)(isv ? vh : kh) + (c & 127);
            h16* dst = (h16*)(a.ws + (isv ? WS_GU : WS_GW)) + (size_t)unit * 8192 + (c & 127);
            f32x4 X[4];
#pragma unroll
            for (int bb = 0; bb < 4; ++bb) { f32x4 T;
#pragma unroll
                for (int i = 0; i < 4; ++i) { const int row = 16 * bb + 4 * g + i; float r = (float)src[row * 136] * bt[row]; if (!isv) r *= eg[row]; T[i] = r; }
#pragma unroll
                for (int b2 = 0; b2 < 4; ++b2) if (b2 < bb) { const f32x4 lv = *(const f32x4*)(Lm + (16 * bb + lq) * 64 + 16 * b2 + 4 * g);
#pragma unroll
                    for (int i = 0; i < 4; ++i) T = __builtin_amdgcn_mfma_f32_16x16x4f32(lv[i], X[b2][i], T, 0, 0, 0); }
                const f32x4 dv = *(const f32x4*)(Dinv + bb * 256 + lq * 16 + 4 * g); f32x4 Xb = (f32x4){0.f, 0.f, 0.f, 0.f};
#pragma unroll
                for (int i = 0; i < 4; ++i) Xb = __builtin_amdgcn_mfma_f32_16x16x4f32(dv[i], T[i], Xb, 0, 0, 0);
                X[bb] = Xb;
#pragma unroll
                for (int i = 0; i < 4; ++i) dst[(16 * bb + 4 * g + i) * 128] = (h16)Xb[i]; } }
        GL_STORE(cur ^ 1);
    }
#undef GL_LOAD
#undef GL_STORE
    __syncthreads();
}

struct GdnRegs { u32x4 rW[2], rQ[2], rI, rK[2]; h16 rU[4]; float rGl; };
DI void gdn_recur_job(const Args& a, char* lds, int job) {
    const int tid = threadIdx.x, lane = tid & 63, w = __builtin_amdgcn_readfirstlane(tid >> 6), g = lane >> 4, lq = lane & 15;
    const int bh = job >> 2, dv0 = (job & 3) * 32, b = bh >> 3, h = bh & 7;
    constexpr int OPB = 62464, O_QD = 17408, O_IN = 34816, O_KDT = 44032, O_SH = 2 * OPB, SHB = 8448, O_VN = O_SH + 2 * SHB;
    int zoff = 0; asm volatile("" : "+v"(zoff)); char* L = lds + zoff;
    const h16* GU = (const h16*)(a.ws + WS_GU); const h16* GW = (const h16*)(a.ws + WS_GW); const h16* GQD = (const h16*)(a.ws + WS_GQD);
    const h16* GKDT = (const h16*)(a.ws + WS_GKDT); const h16* GIN = (const h16*)(a.ws + WS_GINTRA); const float* GLAST = (const float*)(a.ws + WS_GLAST);
    h16* OG = (h16*)(a.ws + WS_OG);
    const int ct = w >> 1, dt = w & 1;
    f32x4 S0 = (f32x4){0.f, 0.f, 0.f, 0.f}, S1 = S0;
    GdnRegs RA, RB;
#define GDN_LOAD(R, nn) do { const size_t un = (size_t)((b * GNCH + (nn)) * 8 + h); \
        _Pragma("unroll") for (int k = 0; k < 2; ++k) { const int idx = tid + 512 * k; R.rW[k] = *(const u32x4*)(GW + un * 8192 + idx * 8); R.rQ[k] = *(const u32x4*)(GQD + un * 8192 + idx * 8); R.rK[k] = *(const u32x4*)(GKDT + un * 8192 + idx * 8); } \
        R.rI = *(const u32x4*)(GIN + un * 4096 + tid * 8); \
        _Pragma("unroll") for (int i = 0; i < 4; ++i) R.rU[i] = GU[un * 8192 + (16 * ct + 4 * g + i) * 128 + dv0 + 16 * dt + lq]; \
        R.rGl = GLAST[un + zoff]; } while (0)
#define GDN_STORE(R, buf) do { char* ob_ = L + (buf) * OPB; \
        _Pragma("unroll") for (int k = 0; k < 2; ++k) { const int idx = tid + 512 * k; *(u32x4*)(ob_ + (idx >> 4) * 272 + (idx & 15) * 16) = R.rW[k]; *(u32x4*)(ob_ + O_QD + (idx >> 4) * 272 + (idx & 15) * 16) = R.rQ[k]; \
            *(u32x4*)(ob_ + O_KDT + (idx >> 3) * 144 + (idx & 7) * 16) = R.rK[k]; } \
        *(u32x4*)(ob_ + O_IN + (tid >> 3) * 144 + (tid & 7) * 16) = R.rI; } while (0)
#define FR8(p) mk8(*(const h16x4*)(p), *(const h16x4*)((p) + 32))
#define GDN_STEP(n, cur, RN, RF) do { \
        const char* ob = L + (cur) * OPB; const char* sh = L + O_SH + (cur) * SHB; char* shn = L + O_SH + ((cur) ^ 1) * SHB; char* VN = L + O_VN; \
        GDN_LOAD(RF, ((n) + 2 < GNCH ? (n) + 2 : GNCH - 1));     \
        f32x4 a0 = (f32x4){0.f, 0.f, 0.f, 0.f}, a1 = a0; \
        _Pragma("unroll") for (int kk = 0; kk < 4; kk += 2) { const char* ap = ob + (16 * ct + lq) * 272 + (32 * kk + 4 * g) * 2; const char* bp = sh + (16 * dt + lq) * 264 + (32 * kk + 4 * g) * 2; \
            a0 = MFMA16(FR8(ap), FR8(bp), a0); a1 = MFMA16(FR8(ap + 64), FR8(bp + 64), a1); } \
        { h16x4 vn; _Pragma("unroll") for (int i = 0; i < 4; ++i) vn[i] = (h16)(uv[i] - (a0[i] + a1[i])); \
          *(h16x4*)(VN + (16 * dt + lq) * 136 + (16 * ct + 4 * g) * 2) = vn; } \
        f32x4 o0 = (f32x4){0.f, 0.f, 0.f, 0.f}, o1 = o0; \
        _Pragma("unroll") for (int kk = 0; kk < 4; kk += 2) { const char* ap = ob + O_QD + (16 * ct + lq) * 272 + (32 * kk + 4 * g) * 2; const char* bp = sh + (16 * dt + lq) * 264 + (32 * kk + 4 * g) * 2; \
            o0 = MFMA16(FR8(ap), FR8(bp), o0); o1 = MFMA16(FR8(ap + 64), FR8(bp + 64), o1); } \
        LBAR(); \
        { const char* ap = ob + O_IN + (16 * ct + lq) * 144 + (4 * g) * 2; const char* bp = VN + (16 * dt + lq) * 136 + (4 * g) * 2; \
          o0 = MFMA16(FR8(ap), FR8(bp), o0); o1 = MFMA16(FR8(ap + 64), FR8(bp + 64), o1); } \
        S0 = S0 * gl; S1 = S1 * gl; \
        _Pragma("unroll") for (int kk = 0; kk < 2; ++kk) { const char* ap = ob + O_KDT + (16 * w + lq) * 144 + (32 * kk + 4 * g) * 2; const h16x8 af = FR8(ap); \
            const char* b0 = VN + (lq) * 136 + (32 * kk + 4 * g) * 2; const char* b1 = VN + (16 + lq) * 136 + (32 * kk + 4 * g) * 2; \
            S0 = MFMA16(af, FR8(b0), S0); S1 = MFMA16(af, FR8(b1), S1); } \
        { h16* op = OG + (size_t)(b * SEQ + (n) * 64 + 16 * ct + 4 * g) * 1024 + h * 128 + dv0 + 16 * dt + lq; \
          _Pragma("unroll") for (int i = 0; i < 4; ++i) op[(size_t)i * 1024] = (h16)(o0[i] + o1[i]); } \
        { h16x4 s0, s1; _Pragma("unroll") for (int i = 0; i < 4; ++i) { s0[i] = (h16)S0[i]; s1[i] = (h16)S1[i]; } \
          *(h16x4*)(shn + (lq) * 264 + (16 * w + 4 * g) * 2) = s0; *(h16x4*)(shn + (16 + lq) * 264 + (16 * w + 4 * g) * 2) = s1; } \
        { GDN_STORE(RN, (cur) ^ 1); _Pragma("unroll") for (int i = 0; i < 4; ++i) uv[i] = (float)RN.rU[i]; gl = RN.rGl; } \
        LBAR(); } while (0)
    __syncthreads();
    GDN_LOAD(RA, 0); GDN_LOAD(RB, 1);
    { const h16x4 z = (h16x4){(h16)0.f, (h16)0.f, (h16)0.f, (h16)0.f}; *(h16x4*)(L + O_SH + (lq) * 264 + (16 * w + 4 * g) * 2) = z; *(h16x4*)(L + O_SH + (16 + lq) * 264 + (16 * w + 4 * g) * 2) = z; }
    GDN_STORE(RA, 0);
    float uv[4];
#pragma unroll
    for (int i = 0; i < 4; ++i) uv[i] = (float)RA.rU[i];
    float gl = RA.rGl;
    LBAR();
    for (int n = 0; n < GNCH; n += 2) { GDN_STEP(n, 0, RB, RA); GDN_STEP(n + 1, 1, RA, RB); }
#undef GDN_LOAD
#undef GDN_STORE
#undef GDN_STEP
#undef FR8
    __syncthreads();
}
DI void s5_scan_job(const Args& a, int j) {
    const int T = j * NT + threadIdx.x, b = T >> 12, g = (T >> 6) & 63, p = T & 63;
    const float dt = expf(a.in[I_LOGDT][g]); const float lre = a.in[I_LAMRE][g * 64 + p], lim = a.in[I_LAMIM][g * 64 + p];
    const float mag = expf(lre * dt); float sn, cs; sincosf(lim * dt, &sn, &cs); float lr = mag * cs, li = mag * sn;
#pragma unroll
    for (int i = 0; i < 5; ++i) { const float nr = lr * lr - li * li, ni = 2.f * lr * li; lr = nr; li = ni; }
    const float* EC = (const float*)(a.ws + WS_EC) + ((size_t)(g * S5N + b * S5NCH)) * 128 + 2 * p;
    h16* UC = (h16*)(a.ws + WS_UCAT) + ((size_t)(g * S5N + b * S5NCH)) * S5K + 512 + 2 * p;
    float cr = 0.f, ci = 0.f;
    for (int c0 = 0; c0 < S5NCH; c0 += 16) { f32x2 e[16];
#pragma unroll
        for (int k = 0; k < 16; ++k) e[k] = *(const f32x2*)(EC + (size_t)(c0 + k) * 128);
#pragma unroll
        for (int k = 0; k < 16; ++k) { *(unsigned*)(UC + (size_t)(c0 + k) * S5K) = pkh(cr, ci); const float nr = lr * cr - li * ci + e[k].x, ni = lr * ci + li * cr + e[k].y; cr = nr; ci = ni; } }
}
DI void phase_gdn_final(const Args& a) {
    const int tid = threadIdx.x, lane = tid & 63, wave = tid >> 6, gw = blockIdx.x * NWAVES + wave, ngw = gridDim.x * NWAVES;
    const h16* OG = (const h16*)(a.ws + WS_OG); const h16* QKVG = (const h16*)(a.ws + WS_QKVG); h16* MIX = (h16*)(a.ws + WS_MIXIN); const float* nw = a.in[I_NORMW] + ((16 * lane) & 127);
    float nwv[16];
#pragma unroll
    for (int j = 0; j < 16; ++j) nwv[j] = nw[j];
    for (int tA = gw; tA < M; tA += 2 * ngw) { const int tB = tA + ngw < M ? tA + ngw : tA;
        h16x8 o[2][2], gt[2][2];
#pragma unroll
        for (int r = 0; r < 2; ++r) { const size_t t = r ? tB : tA;
#pragma unroll
            for (int q = 0; q < 2; ++q) { o[r][q] = *(const h16x8*)(OG + t * 1024 + 16 * lane + 8 * q); gt[r][q] = *(const h16x8*)(QKVG + t * 4096 + 3072 + 16 * lane + 8 * q); } }
#pragma unroll
        for (int r = 0; r < 2; ++r) { const size_t t = r ? tB : tA; float ss = 0.f;
#pragma unroll
            for (int q = 0; q < 2; ++q)
#pragma unroll
                for (int j = 0; j < 8; ++j) { const float v = (float)o[r][q][j]; ss += v * v; }
            ss += __shfl_xor(ss, 1); ss += __shfl_xor(ss, 2); ss += __shfl_xor(ss, 4);
            const float rinv = 1.0f / sqrtf(ss * (1.f / 128.f) + 1e-6f);
            if (r == 0 || tB != tA) {
#pragma unroll
                for (int q = 0; q < 2; ++q) { float y[8];
#pragma unroll
                    for (int j = 0; j < 8; ++j) y[j] = (float)o[r][q][j] * rinv * nwv[8 * q + j] * siluf_((float)gt[r][q][j]);
                    u32x4 wv; wv.x = pkh(y[0], y[1]); wv.y = pkh(y[2], y[3]); wv.z = pkh(y[4], y[5]); wv.w = pkh(y[6], y[7]);
                    *(u32x4*)(MIX + t * 2048 + 1024 + 16 * lane + 8 * q) = wv; } } }
    }
}

DI void phase_logits(const Args& a) {
    const int tid = threadIdx.x, lane = tid & 63, wave = tid >> 6, g = lane >> 4, lq = lane & 15;
    const h16* XH = (const h16*)(a.ws + WS_XH); const h16* WT = (const h16*)(a.ws + WS_WIN1) + (size_t)5120 * D; float* LOGIT = (float*)(a.ws + WS_LOGIT);
    for (int wu = blockIdx.x * NWAVES + wave; wu < M / 16; wu += gridDim.x * NWAVES) {
        const h16* ap = XH + (size_t)(wu * 16 + lq) * D + 8 * g; const h16* bp = WT + (size_t)lq * D + 8 * g;
        f32x4 c0 = (f32x4){0.f, 0.f, 0.f, 0.f}, c1 = c0;
#pragma unroll 2
        for (int k8 = 0; k8 < 64; k8 += 8) { h16x8 af[8], bf[8];
#pragma unroll
            for (int j = 0; j < 8; ++j) { af[j] = *(const h16x8*)(ap + 32 * (k8 + j)); bf[j] = *(const h16x8*)(bp + 32 * (k8 + j)); }
#pragma unroll
            for (int j = 0; j < 8; j += 2) { c0 = MFMA16(af[j], bf[j], c0); c1 = MFMA16(af[j + 1], bf[j + 1], c1); } }
#pragma unroll
        for (int i = 0; i < 4; ++i) LOGIT[(size_t)(wu * 16 + 4 * g + i) * 16 + lq] = c0[i] + c1[i];
    }
}

struct MoeTiles { int tp[9]; int cnt[8]; };
DI MoeTiles moe_tiles(const Args& a) { MoeTiles t; const unsigned* cnt = (const unsigned*)(a.ws + WS_CTL) + CW_CNT; t.tp[0] = 0;
#pragma unroll
    for (int e = 0; e < 8; ++e) { const int c = (int)__builtin_amdgcn_readfirstlane((int)cnt[e]); t.cnt[e] = c; t.tp[e + 1] = t.tp[e] + ((c + 255) >> 8); }
    return t; }
template <class Sched>
DI void moe_fill_toktab(const Args& a, LAS unsigned char* lds, const Sched& S, const MoeTiles& mt) {
    const int tid = threadIdx.x;
    LAS unsigned short* tt = (LAS unsigned short*)(lds + TOKTAB_OFF); LAS int* info = (LAS int*)(lds + TOKTAB_OFF + TOKTAB_UNITS * 512);
    const int* lst = (const int*)(a.ws + WS_LIST);
    __syncthreads();
    if (tid < TOKTAB_UNITS) { pg8::Unit u; int base = 0, rem = 0;
        if (S.next(tid, u)) { int st = 0, cn = 0;
#pragma unroll
            for (int q = 0; q < 8; ++q) if (q == u.grp) { st = mt.tp[q]; cn = mt.cnt[q]; }
            base = (u.grp << 14) + (u.pm - st) * 256; rem = cn - (u.pm - st) * 256; }
        info[2 * tid] = base; info[2 * tid + 1] = rem; }
    __syncthreads();
    int tok[TOKTAB_UNITS / 2];
#pragma unroll
    for (int k = 0; k < TOKTAB_UNITS / 2; ++k) { const int q = tid + NT * k, i = q >> 8, r = q & 255; const int base = info[2 * i], rem = info[2 * i + 1]; tok[k] = lst[base + (r < rem ? r : 0)]; if (r >= rem) tok[k] = 0; }
#pragma unroll
    for (int k = 0; k < TOKTAB_UNITS / 2; ++k) tt[tid + NT * k] = (unsigned short)tok[k];
    __syncthreads();
}

enum { PH_PRO, PH_H0, PH_DIL, PH_SB, PH_WOUT0, PH_LN1, PH_FFUP, PH_FFDN, PH_LN2, PH_WIN1, PH_GPRE, PH_GLOC, PH_REC, PH_S5Y, PH_GLU, PH_WOUT1, PH_LN3, PH_MUP, PH_MDN, PH_FINAL, N_PHASES };
#ifndef SKIP_EC
#define SKIP_EC 0
#endif
#ifndef SKIP_GL
#define SKIP_GL 0
#endif
__global__ void __launch_bounds__(NT, 2) hybrid_fwd(Args args) {
    extern __shared__ __attribute__((aligned(16))) unsigned char lds_raw[];
    char* lds = (char*)lds_raw;
    LAS unsigned char* ldsl = (LAS unsigned char*)lds_raw;
    const int tid = threadIdx.x;
    volatile LAS unsigned* MISC = (volatile LAS unsigned*)(ldsl + MISC_OFF);
    if (tid < 64) MISC[tid] = 0u;
    __syncthreads();
    unsigned char* ws = args.ws;
    XcdBarrier bar; bar.bar = (unsigned*)(ws + WS_CTL) + CW_BAR; bar.x = 0; bar.st = nullptr;
    if (N_LAUNCH_MODE == 1) bar = xcd_barrier_post((unsigned*)(ws + WS_CTL) + CW_BAR, MISC + 8);
    const int lo = args.ph_lo, hi = args.ph_hi, G = gridDim.x, bx = blockIdx.x;
#ifndef PH_MASK
#define PH_MASK 0xFFFFFFFu
#endif
#define IN(k) (((PH_MASK >> (k)) & 1u) && lo <= (k) && (k) < hi)
#define SEAM(k) do { if (IN(k) && IN((k) + 1)) xcd_barrier(bar); } while (0)
#ifndef PROBE_PHASE
#define PROBE_PHASE (-1)
#endif
#ifndef PROBE_REPS
#define PROBE_REPS 2
#endif
#define REP(k) _Pragma("unroll 1") for (int _r = 0; _r < ((PROBE_PHASE == (k)) ? PROBE_REPS : 1); ++_r)
    using namespace pg8;
    h16* XH = (h16*)(ws + WS_XH); h16* P = (h16*)args.out;

    if (IN(PH_PRO)) { REP(PH_PRO) phase_prologue(args, lds); } SEAM(PH_PRO);
    if (IN(PH_H0)) { DenseSched S{XH, (const h16*)(ws + WS_WIN0), D, D, M / 256, IN0 / 256, G, bx}; EpiH E{(h16*)(ws + WS_H0), IN0}; gemm_phase(ldsl, D, S, E); if (PROBE_PHASE == PH_H0) gemm_phase(ldsl, D, S, E); } SEAM(PH_H0);
    if (IN(PH_DIL)) { phase_dilated(args, lds); if (PROBE_PHASE == PH_DIL) phase_dilated(args, lds); } SEAM(PH_DIL);
    if (IN(PH_SB)) { REP(PH_SB) phase_sb(args, lds); phase_combine(args); } SEAM(PH_SB);
    if (IN(PH_WOUT0)) { DenseSched S{(const h16*)(ws + WS_O0), (const h16*)(ws + WS_WOUT0), D, D, M / 256, D / 256, G, bx}; EpiRes E{XH, P, D}; gemm_phase(ldsl, D, S, E); } SEAM(PH_WOUT0);
    if (IN(PH_LN1)) { phase_ln<false>(args, lds, P, args.in[I_ELNMG], args.in[I_ELNMB]); if (PROBE_PHASE == PH_LN1) phase_ln<false>(args, lds, P, args.in[I_ELNMG], args.in[I_ELNMB]); } SEAM(PH_LN1);
    if (IN(PH_FFUP)) { DenseSched S{XH, (const h16*)(ws + WS_WFF13), D, D, M / 256, 2 * DFF / 256, G, bx}; EpiSwiGLU E{(h16*)(ws + WS_HFF), DFF, AQ_DROP}; gemm_phase(ldsl, D, S, E); if (PROBE_PHASE == PH_FFUP) gemm_phase(ldsl, D, S, E); } SEAM(PH_FFUP);
    if (IN(PH_FFDN)) { DenseSched S{(const h16*)(ws + WS_HFF), (const h16*)(ws + WS_WFF2), DFF, DFF, M / 256, D / 256, G, bx}; EpiRes E{XH, P, D}; gemm_phase(ldsl, DFF, S, E); if (PROBE_PHASE == PH_FFDN) { EpiRes E{XH, P, D}; gemm_phase(ldsl, DFF, S, E); } } SEAM(PH_FFDN);
    if (IN(PH_LN2)) { phase_ln<false>(args, lds, P, args.in[I_ELNFG], args.in[I_ELNFB]); } SEAM(PH_LN2);
    if (IN(PH_WIN1)) { DenseSched S{XH, (const h16*)(ws + WS_WIN1), D, D, M / 256, 20, G, bx}; EpiIn1 E{(h16*)(ws + WS_UCAT), (h16*)(ws + WS_QKVG), (float*)(ws + WS_LOGIT)}; gemm_phase(ldsl, D, S, E); phase_logits(args); if (PROBE_PHASE == PH_WIN1) gemm_phase(ldsl, D, S, E); phase_logits(args); } SEAM(PH_WIN1);
    if (IN(PH_GPRE)) { GroupSched S{(const h16*)(ws + WS_UCAT), (const h16*)(ws + WS_EPAD), S5K, 512, 2, 1, 64, G, bx, (size_t)S5N * S5K, (size_t)256 * 512}; EpiEC E{(float*)(ws + WS_EC)}; gemm_phase(ldsl, 512, S, E);
                  if (G == 256) { phase_gdn_pre(args, lds, 0, 10752, 0); phase_gdn_pre(args, lds, 10752, M, 128); }
                  else phase_gdn_pre(args, lds, 0, M, 0); } SEAM(PH_GPRE);
    if (IN(PH_GLOC)) { REP(PH_GLOC) phase_gdn_local(args, lds); } SEAM(PH_GLOC);
    if (IN(PH_REC)) { REP(PH_REC) for (int job = bx; job < 80; job += G) { if (job < 64) gdn_recur_job(args, lds, job); else s5_scan_job(args, job - 64); }
                      if (G > 80) { if (bx >= 80) moe_convert(args, lds, MOE_CONV_LATE, NEXP, (bx - 80) * NWAVES + (tid >> 6), (G - 80) * NWAVES); }
                      else moe_convert(args, lds, MOE_CONV_LATE, NEXP, bx * NWAVES + (tid >> 6), G * NWAVES); } SEAM(PH_REC);
    if (IN(PH_S5Y)) { GroupSched S{(const h16*)(ws + WS_UCAT), (const h16*)(ws + WS_TCAT), S5K, S5K, 2, 2, 64, G, bx, (size_t)S5N * S5K, (size_t)512 * S5K}; EpiS5Y E{(const h16*)(ws + WS_UCAT), args.in[I_SSMD], (h16*)(ws + WS_Z)}; gemm_phase(ldsl, S5K, S, E); if (PROBE_PHASE == PH_S5Y) gemm_phase(ldsl, S5K, S, E);
                  phase_gdn_final(args); } SEAM(PH_S5Y);
    if (IN(PH_GLU)) { DenseSched S{(const h16*)(ws + WS_Z), (const h16*)(ws + WS_WGLU), 1024, 1024, M / 256, 4, G, bx}; EpiGLU E{(const h16*)(ws + WS_Z), args.in[I_GLUB], (h16*)(ws + WS_MIXIN)}; gemm_phase(ldsl, 1024, S, E); if (PROBE_PHASE == PH_S5Y) gemm_phase(ldsl, 1024, S, E); } SEAM(PH_GLU);
    if (IN(PH_WOUT1)) { DenseSched S{(const h16*)(ws + WS_MIXIN), (const h16*)(ws + WS_WOUT1), D, D, M / 256, D / 256, G, bx}; EpiRes E{XH, P, D}; gemm_phase(ldsl, D, S, E); } SEAM(PH_WOUT1);
    if (IN(PH_LN3)) { phase_ln<true>(args, lds, P, args.in[I_OLNMG], args.in[I_OLNMB]); } SEAM(PH_LN3);
    if (IN(PH_MUP)) { const MoeTiles mt = moe_tiles(args); MoeGatherSched S{ws + WS_XQ8, ws + WS_MOE13, D, D, 2 * DFE / 256, G, bx, mt.tp[1], mt.tp[2], mt.tp[3], mt.tp[4], mt.tp[5], mt.tp[6], mt.tp[7], mt.tp[8], 1};
                  moe_fill_toktab(args, ldsl, S, mt);
                  EpiSwiGLU8 E{(unsigned char*)(ws + WS_HMOE), DFE, 1.0f / (X8_SCALE * W8_SCALE)}; gemm_phase8(ldsl, D, S, E); if (PROBE_PHASE == PH_MUP) gemm_phase8(ldsl, D, S, E); } SEAM(PH_MUP);
    if (IN(PH_MDN)) { const MoeTiles mt = moe_tiles(args); const int nMt = mt.tp[8], R = (nMt * 8) % 256, pm0 = nMt - R / 8, sp = tail_split8(R); const float ysc = 1.0f / (H8_SCALE * W8_SCALE);
                  MoeSched S{ws + WS_HMOE, ws + WS_MOE2, DFE, DFE, D / 256, G, bx, mt.tp[1], mt.tp[2], mt.tp[3], mt.tp[4], mt.tp[5], mt.tp[6], mt.tp[7], pm0, 1};
                  EpiHs E{(h16*)(ws + WS_XG), D, ysc}; gemm_phase8(ldsl, DFE, S, E); if (PROBE_PHASE == PH_MDN) gemm_phase8(ldsl, DFE, S, E);
                  TailSched T{ws + WS_HMOE, ws + WS_MOE2, DFE, DFE, D / 256, G, bx, pm0, R, sp, DFE / sp, mt.tp[1], mt.tp[2], mt.tp[3], mt.tp[4], mt.tp[5], mt.tp[6], mt.tp[7], 1};
                  EpiSlab ES{(float*)(ws + WS_SLAB), ysc}; gemm_phase8(ldsl, DFE / sp, T, ES); if (PROBE_PHASE == PH_MDN) gemm_phase8(ldsl, DFE / sp, T, ES); } SEAM(PH_MDN);
    if (IN(PH_FINAL)) { const MoeTiles mt = moe_tiles(args); const int nMt = mt.tp[8], R = (nMt * 8) % 256; phase_final(args, nMt - R / 8, R, tail_split8(R), mt.tp[1], mt.tp[2], mt.tp[3], mt.tp[4], mt.tp[5], mt.tp[6], mt.tp[7]); }
#undef IN
#undef SEAM
}

extern "C" void kernel_launch(void* const* d_in, const int* in_sizes, int n_in, void* d_out, int out_size, void* d_ws, size_t ws_size, hipStream_t stream) {
    static int grid = 0;
    if (grid == 0) {
        if (n_in != 34 || out_size != M * D || ws_size < WS_END) { fprintf(stderr, "kernel_launch: unexpected shapes (n_in %d out %d ws %zu need %zu)\n", n_in, out_size, ws_size, (size_t)WS_END); grid = -1; return; }
        int dev = 0, cus = 0, per_cu = 0;
        if (hipGetDevice(&dev) != hipSuccess || hipDeviceGetAttribute(&cus, hipDeviceAttributeMultiprocessorCount, dev) != hipSuccess) { grid = -1; return; }
        if (hipFuncSetAttribute((const void*)hybrid_fwd, hipFuncAttributeMaxDynamicSharedMemorySize, LDS_BYTES) != hipSuccess) { fprintf(stderr, "kernel_launch: hipFuncSetAttribute failed\n"); grid = -1; return; }
        if (hipOccupancyMaxActiveBlocksPerMultiprocessor(&per_cu, (const void*)hybrid_fwd, NT, LDS_BYTES) != hipSuccess || per_cu < 1) fprintf(stderr, "kernel_launch: occupancy query says %d\n", per_cu);
        (void)hipGetLastError();
        grid = cus;
    }
    if (grid < 0) return;
    (void)hipMemsetAsync((char*)d_ws + WS_CTL, 0, CTL_BYTES, stream);
    Args a{};
    for (int i = 0; i < 34; ++i) a.in[i] = (const float*)d_in[i];
    a.out = (float*)d_out; a.ws = (unsigned char*)d_ws;
#if N_LAUNCH_MODE == 1
    a.ph_lo = 0; a.ph_hi = N_PHASES;
    hipLaunchKernelGGL(hybrid_fwd, dim3(grid), dim3(NT), LDS_BYTES, stream, a);
#else
    for (int p = 0; p < N_PHASES; ++p) { a.ph_lo = p; a.ph_hi = p + 1; hipLaunchKernelGGL(hybrid_fwd, dim3(grid), dim3(NT), LDS_BYTES, stream, a); }
#endif
}
```
